# Optimizing an MI355X kernel written in HIP

```python
import jax, jax.numpy as jnp
from jax import lax
import numpy as np

D_MODEL = 2048
BATCH = 8
SEQ = 2048
DEPTH = 1

GRID_W = 64
CTX_LEN = 256
D_MIX = D_MODEL
D_FOURIER = D_MIX // 2
N_FOURIER_GROUPS = 4
FOURIER_GROUP = D_FOURIER // N_FOURIER_GROUPS
D_LRU = D_MIX - D_FOURIER
N_LRU_HEADS = 8
LRU_HEAD = D_LRU // N_LRU_HEADS
LRU_CONV = 4
LRU_C = 8.0
D_FF = 5632
FFN_CONV = 3
N_MOD = 6
EPS = 1e-6
POS_BASE = 10000.0

kernel_name = "hybrid_fourier_rglru_dit_block"


def rms_norm(x, g):
    xf = x.astype(jnp.float32)
    y = xf * lax.rsqrt(jnp.mean(xf * xf, axis=-1, keepdims=True) + EPS)
    return (y * g.astype(jnp.float32)).astype(x.dtype)


def depthwise_conv(x, w, b, left):
    k_w = w.shape[0]
    n = x.shape[1]
    xp = jnp.pad(x, ((0, 0), (left, k_w - 1 - left), (0, 0)))
    y = b
    for k in range(k_w):
        y = y + xp[:, k:k + n] * w[k]
    return y


def grid_pos_embed(n_tokens, dtype):
    rows = n_tokens // GRID_W
    row = jnp.repeat(jnp.arange(rows, dtype=jnp.float32), GRID_W)
    col = jnp.tile(jnp.arange(GRID_W, dtype=jnp.float32), rows)
    quarter = D_MODEL // 4
    freqs = POS_BASE ** (-jnp.arange(quarter, dtype=jnp.float32) / quarter)

    def enc(p):
        ang = p[:, None] * freqs[None, :]
        return jnp.concatenate([jnp.sin(ang), jnp.cos(ang)], axis=-1)

    return jnp.concatenate([enc(row), enc(col)], axis=-1).astype(dtype)


def modulation(cond, w_ada, b_ada):
    m = jax.nn.silu(cond) @ w_ada + b_ada
    return [t[:, None, :] for t in jnp.split(m, N_MOD, axis=-1)]


def modulate(h, shift, scale):
    return h * (1 + scale) + shift


def mixer_inputs(h, w_in, conv_w, conv_b):
    proj = h @ w_in
    u_f, u_x, u_g = jnp.split(proj, [D_FOURIER, D_FOURIER + D_LRU], axis=-1)
    x_c = depthwise_conv(u_x, conv_w, conv_b, LRU_CONV // 2)
    return u_f, x_c, u_g


def lru_coeffs(x_c, w_a, b_a, w_x, b_x, lam):
    bsz, n, _ = x_c.shape
    xh = x_c.reshape(bsz, n, N_LRU_HEADS, LRU_HEAD)
    r = jax.nn.sigmoid((jnp.einsum('blhi,hij->blhj', xh, w_a).reshape(bsz, n, D_LRU) + b_a).astype(jnp.float32))
    i = jax.nn.sigmoid((jnp.einsum('blhi,hij->blhj', xh, w_x).reshape(bsz, n, D_LRU) + b_x).astype(jnp.float32))
    log_a = LRU_C * r * jax.nn.log_sigmoid(lam.astype(jnp.float32))
    a = jnp.exp(log_a)
    inp = jnp.sqrt(-jnp.expm1(2.0 * log_a)) * i * x_c.astype(jnp.float32)
    return a, inp


def linear_scan(a, b, h0, reverse):
    if h0 is not None:
        if reverse:
            b = b.at[:, -1].add(a[:, -1] * h0)
        else:
            b = b.at[:, 0].add(a[:, 0] * h0)

    def combine(e1, e2):
        a1, b1 = e1
        a2, b2 = e2
        return a1 * a2, a2 * b1 + b2

    _, h = lax.associative_scan(combine, (a, b), reverse=reverse, axis=1)
    return h


def bi_rglru(x_c, w_a, b_a, w_x, b_x, lam, h0_fwd, h0_bwd):
    a_f, i_f = lru_coeffs(x_c, w_a[0], b_a[0], w_x[0], b_x[0], lam[0])
    h_f = linear_scan(a_f, i_f, h0_fwd, reverse=False)
    a_b, i_b = lru_coeffs(x_c, w_a[1], b_a[1], w_x[1], b_x[1], lam[1])
    h_b = linear_scan(a_b, i_b, h0_bwd, reverse=True)
    return h_f, h_b


def fourier_mix(u_f, w_f, b_f):
    bsz, n, _ = u_f.shape
    ug = u_f.reshape(bsz, n, N_FOURIER_GROUPS, FOURIER_GROUP).astype(jnp.float32)
    f = jnp.fft.fft2(ug, axes=(1, 3), norm="ortho").real.astype(u_f.dtype)
    y = jnp.einsum('blgc,gcd->blgd', f, w_f).reshape(bsz, n, D_FOURIER)
    return y + b_f


def mixer_output(u_f, h_f, h_b, u_g, w_f, b_f, w_out):
    y_fourier = fourier_mix(u_f, w_f, b_f)
    y_lru = (h_f + h_b).astype(u_g.dtype) * jax.nn.gelu(u_g, approximate=True)
    return jnp.concatenate([y_fourier, y_lru], axis=-1) @ w_out


def conv_ffn(h, w_up, conv_w, conv_b, w_down):
    up = depthwise_conv(h @ w_up, conv_w, conv_b, FFN_CONV // 2)
    g, v = jnp.split(up, 2, axis=-1)
    return (jax.nn.gelu(g, approximate=True) * v) @ w_down


def setup_inputs(seed: int = 0) -> dict:
    key = jax.random.key(seed)
    ks = jax.random.split(key, 32)
    f32 = jnp.float32
    nrm = lambda k, shape, s: jax.random.normal(k, shape, f32) * s
    u = jax.random.uniform(ks[16], (DEPTH, 2, D_LRU), f32, 0.9, 0.999)
    a_base = u ** (1.0 / LRU_C)
    lam = jnp.log(a_base) - jnp.log1p(-a_base)
    return {
        "x": nrm(ks[0], (BATCH, SEQ, D_MODEL), 1.0),
        "c": nrm(ks[1], (BATCH, D_MODEL), 1.0),
        "ctx": nrm(ks[2], (BATCH, CTX_LEN, D_MODEL), 1.0),
        "c_ctx": nrm(ks[3], (D_MODEL,), 1.0),
        "w_ada": nrm(ks[4], (DEPTH, D_MODEL, N_MOD * D_MODEL), 0.5 * D_MODEL ** -0.5),
        "b_ada": nrm(ks[5], (DEPTH, N_MOD * D_MODEL), 0.01),
        "g_mix_pre": 1.0 + nrm(ks[6], (DEPTH, D_MODEL), 0.02),
        "g_mix_post": 1.0 + nrm(ks[7], (DEPTH, D_MODEL), 0.02),
        "g_ffn_pre": 1.0 + nrm(ks[8], (DEPTH, D_MODEL), 0.02),
        "g_ffn_post": 1.0 + nrm(ks[9], (DEPTH, D_MODEL), 0.02),
        "w_in": nrm(ks[10], (DEPTH, D_MODEL, D_FOURIER + 2 * D_LRU), D_MODEL ** -0.5),
        "conv_lru_w": nrm(ks[11], (DEPTH, LRU_CONV, D_LRU), LRU_CONV ** -0.5),
        "conv_lru_b": nrm(ks[12], (DEPTH, D_LRU), 0.01),
        "w_rec_gate": nrm(ks[13], (DEPTH, 2, N_LRU_HEADS, LRU_HEAD, LRU_HEAD), LRU_HEAD ** -0.5),
        "b_rec_gate": nrm(ks[14], (DEPTH, 2, D_LRU), 0.01),
        "w_in_gate": nrm(ks[15], (DEPTH, 2, N_LRU_HEADS, LRU_HEAD, LRU_HEAD), LRU_HEAD ** -0.5),
        "b_in_gate": nrm(ks[17], (DEPTH, 2, D_LRU), 0.01),
        "lru_lambda": lam,
        "w_fourier": nrm(ks[18], (DEPTH, N_FOURIER_GROUPS, FOURIER_GROUP, FOURIER_GROUP), FOURIER_GROUP ** -0.5),
        "b_fourier": nrm(ks[19], (DEPTH, D_FOURIER), 0.01),
        "w_out": nrm(ks[20], (DEPTH, D_MIX, D_MODEL), D_MIX ** -0.5),
        "w_up": nrm(ks[21], (DEPTH, D_MODEL, 2 * D_FF), D_MODEL ** -0.5),
        "conv_ffn_w": nrm(ks[22], (DEPTH, FFN_CONV, 2 * D_FF), FFN_CONV ** -0.5),
        "conv_ffn_b": nrm(ks[23], (DEPTH, 2 * D_FF), 0.01),
        "w_down": nrm(ks[24], (DEPTH, D_FF, D_MODEL), D_FF ** -0.5),
    }


def reference(x, c, ctx, c_ctx, w_ada, b_ada, g_mix_pre, g_mix_post, g_ffn_pre, g_ffn_post,
              w_in, conv_lru_w, conv_lru_b, w_rec_gate, b_rec_gate, w_in_gate, b_in_gate,
              lru_lambda, w_fourier, b_fourier, w_out, w_up, conv_ffn_w, conv_ffn_b, w_down):
    n_lat = x.shape[1]
    x = x + grid_pos_embed(n_lat, x.dtype)[None]
    for l in range(DEPTH):
        last = l == DEPTH - 1
        sh1, sc1, gt1, sh2, sc2, gt2 = modulation(c, w_ada[l], b_ada[l])
        csh1, csc1, cgt1, csh2, csc2, cgt2 = modulation(c_ctx[None], w_ada[l], b_ada[l])
        lru_p = (w_rec_gate[l], b_rec_gate[l], w_in_gate[l], b_in_gate[l], lru_lambda[l])

        hc = modulate(rms_norm(ctx, g_mix_pre[l]), csh1, csc1)
        uf_c, xc_c, ug_c = mixer_inputs(hc, w_in[l], conv_lru_w[l], conv_lru_b[l])
        hf_c, hb_c = bi_rglru(xc_c, *lru_p, None, None)

        hx = modulate(rms_norm(x, g_mix_pre[l]), sh1, sc1)
        uf_x, xc_x, ug_x = mixer_inputs(hx, w_in[l], conv_lru_w[l], conv_lru_b[l])
        hf_x, hb_x = bi_rglru(xc_x, *lru_p, hf_c[:, -1], hb_c[:, 0])
        y_x = mixer_output(uf_x, hf_x, hb_x, ug_x, w_fourier[l], b_fourier[l], w_out[l])
        x = x + gt1 * rms_norm(y_x, g_mix_post[l])

        hx2 = modulate(rms_norm(x, g_ffn_pre[l]), sh2, sc2)
        x = x + gt2 * rms_norm(conv_ffn(hx2, w_up[l], conv_ffn_w[l], conv_ffn_b[l], w_down[l]), g_ffn_post[l])

        if not last:
            y_c = mixer_output(uf_c, hf_c, hb_c, ug_c, w_fourier[l], b_fourier[l], w_out[l])
            ctx = ctx + cgt1 * rms_norm(y_c, g_mix_post[l])
            hc2 = modulate(rms_norm(ctx, g_ffn_pre[l]), csh2, csc2)
            ctx = ctx + cgt2 * rms_norm(conv_ffn(hc2, w_up[l], conv_ffn_w[l], conv_ffn_b[l], w_down[l]), g_ffn_post[l])
    return x
```

```cpp
#include <hip/hip_runtime.h>
#include <hip/hip_cooperative_groups.h>
#include <cstdio>
#include <cstdint>
namespace cg = cooperative_groups;

#ifndef N_LAUNCH_MODE
#define N_LAUNCH_MODE 1
#endif

#define LAS __attribute__((address_space(3)))
typedef unsigned short bf16_t;
typedef short bf16x8 __attribute__((ext_vector_type(8)));
typedef float f32x4 __attribute__((ext_vector_type(4)));
typedef float f32x2 __attribute__((ext_vector_type(2)));
typedef unsigned u32x4 __attribute__((ext_vector_type(4)));
typedef unsigned u32x2 __attribute__((ext_vector_type(2)));

constexpr int D = 2048, NB = 8, SEQ = 2048, CTXL = 256, DFF = 5632, DFF2 = 11264;
constexpr int MLAT = NB * SEQ, MCTX = NB * CTXL, MALL = MLAT + MCTX;
constexpr int DLRU = 1024, DFOU = 1024, NPROJ = 3072;
constexpr int NCHUNK = 36;
constexpr float EPS = 1e-6f;

constexpr size_t MiB = 1u << 20;
constexpr size_t WS_MOD = 1 * MiB;
constexpr size_t WS_POS = 2 * MiB;
constexpr size_t WS_RSS1 = 3 * MiB;
constexpr size_t WS_RSS2 = 5 * MiB;
constexpr size_t WS_AGG = 7 * MiB;
constexpr size_t WS_Y1024 = 11 * MiB + 512 * 1024;
constexpr size_t WS_K2 = 11 * MiB + 768 * 1024;
constexpr size_t WS_WUP = 12 * MiB;
constexpr size_t WS_WDOWN = 56 * MiB;
constexpr size_t WS_WIN = 78 * MiB;
constexpr size_t WS_WOUT = 90 * MiB;
constexpr size_t WS_CTAB = 98 * MiB;
constexpr size_t WS_STAB = 102 * MiB;
constexpr size_t WS_WG = 106 * MiB;
constexpr size_t WS_WCS = 107 * MiB;
constexpr size_t WS_H = 108 * MiB;
constexpr size_t WS_UF = 180 * MiB;
constexpr size_t WS_UX = 212 * MiB;
constexpr size_t WS_UG = 248 * MiB;
constexpr size_t WS_S = 280 * MiB;
constexpr size_t WS_PF = 312 * MiB;
constexpr size_t WS_PB = 344 * MiB;
constexpr size_t WS_PQT = 108 * MiB;
constexpr size_t WS_CPSQ = 376 * MiB;
constexpr size_t WS_YA = 108 * MiB;
constexpr size_t WS_Y = 384 * MiB;
constexpr size_t WS_H2 = 78 * MiB;
constexpr size_t WS_ACT = 142 * MiB;
constexpr size_t WS_EDGE = 318 * MiB;
constexpr size_t WS_Y2 = 448 * MiB;
constexpr size_t WS_NEED = 512 * MiB;

constexpr int LDS_BAR = 152576;
constexpr int LDS_BYTES = 152576 + 64;
static_assert(WS_UX - WS_UF == 32 * MiB && WS_UG - WS_UF == 68 * MiB && WS_STAB - WS_CTAB == 4 * MiB, "pointer arithmetic in EpiWin / SchedDFT");

#define LDS_BARRIER() do { asm volatile("s_waitcnt lgkmcnt(0)" ::: "memory"); __builtin_amdgcn_s_barrier(); asm volatile("" ::: "memory"); } while (0)
__device__ __forceinline__ unsigned cvt_pk_bf16(float lo, float hi) { unsigned r; asm volatile("v_cvt_pk_bf16_f32 %0, %1, %2" : "=v"(r) : "v"(lo), "v"(hi)); return r; }
__device__ __forceinline__ float bf_lo(unsigned w) { return __uint_as_float(w << 16); }
__device__ __forceinline__ float bf_hi(unsigned w) { return __uint_as_float(w & 0xffff0000u); }
__device__ __forceinline__ float fast_sigmoid(float z) { return __builtin_amdgcn_rcpf(1.0f + __builtin_amdgcn_exp2f(-1.44269504f * z)); }
__device__ __forceinline__ float gelu_tanh(float x) { const float u = x * (1.0f + 0.044715f * x * x); return x * __builtin_amdgcn_rcpf(1.0f + __builtin_amdgcn_exp2f(-2.302208198f * u)); }
__device__ __forceinline__ float wave_sum(float v) { for (int o = 32; o >= 1; o >>= 1) v += __shfl_xor(v, o); return v; }
__device__ __forceinline__ u32x4 pack8(const float (&v)[8]) { u32x4 w; w.x = cvt_pk_bf16(v[0], v[1]); w.y = cvt_pk_bf16(v[2], v[3]); w.z = cvt_pk_bf16(v[4], v[5]); w.w = cvt_pk_bf16(v[6], v[7]); return w; }
__device__ __forceinline__ void unpack8(const u32x4 w, float (&v)[8]) { v[0] = bf_lo(w.x); v[1] = bf_hi(w.x); v[2] = bf_lo(w.y); v[3] = bf_hi(w.y); v[4] = bf_lo(w.z); v[5] = bf_hi(w.z); v[6] = bf_lo(w.w); v[7] = bf_hi(w.w); }

namespace pg8 {
constexpr int BM = 256, BK = 64, HALF = 128, HTB = HALF * BK * 2, STAGE_BYTES = 8 * HTB, NXCD = 8;
__host__ __device__ __forceinline__ int lds_byte(int r, int c) { const int st = (r >> 4) * 2 + (c >> 5), rr = r & 15, cc = c & 31, ob = rr * 64 + cc * 2; return st * 1024 + (ob ^ (((ob >> 9) & 1) << 5)); }
__host__ __device__ __forceinline__ void stage_rc(int b, int& R, int& C) { const int st = b / 1024, sb = b % 1024, swz = sb ^ (((sb >> 9) & 1) << 5); R = (st >> 1) * 16 + swz / 64; C = (st & 1) * 32 + (swz % 64) / 2; }
__host__ __device__ __forceinline__ int perm32(int rho) { const int n = rho >> 4, i = rho & 15; return 8 * (i >> 2) + 4 * n + (i & 3); }

struct Unit { int pm, pn, z; };
struct Gemm { int lda, ldb, K; size_t hstepA, hstepB; };

__device__ __forceinline__ void std_order(int L, int nM, int nN, int& pm, int& pn, const int WGM = 8) {
    const int nwg = nM * nN; int wgid = L;
    { const int q = nwg / NXCD, r = nwg % NXCD, xcd = wgid % NXCD, off = wgid / NXCD; wgid = (xcd < r ? xcd * (q + 1) : r * (q + 1) + (xcd - r) * q) + off; }
    const int nig = WGM * nN, gid = wgid / nig, fm = gid * WGM, gsz = (nM - fm) < WGM ? (nM - fm) : WGM;
    pm = fm + ((wgid % nig) % gsz); pn = (wgid % nig) / gsz;
}

__device__ __forceinline__ void store_tile_bf16(const f32x4 (&acc)[2][2][4][2], bf16_t* tile, size_t ldc, int wr, int wc, int fr, int fq) {
    bf16_t* p0 = tile + (size_t)(wr * 64 + fr) * ldc + wc * 32 + 8 * fq;
#pragma unroll
    for (int ai = 0; ai < 2; ++ai)
#pragma unroll
        for (int m = 0; m < 4; ++m) { bf16_t* rowp = p0 + (size_t)(ai * HALF + m * 16) * ldc;
#pragma unroll
            for (int bj = 0; bj < 2; ++bj) { const f32x4 v0 = acc[ai][bj][m][0], v1 = acc[ai][bj][m][1];
                u32x4 w; w.x = cvt_pk_bf16(v0[0], v0[1]); w.y = cvt_pk_bf16(v0[2], v0[3]); w.z = cvt_pk_bf16(v1[0], v1[1]); w.w = cvt_pk_bf16(v1[2], v1[3]);
                *(u32x4*)(rowp + bj * HALF) = w; } }
}
__device__ __forceinline__ void store_tile_f32(const f32x4 (&acc)[2][2][4][2], float* tile, size_t ldc, int wr, int wc, int fr, int fq) {
    float* p0 = tile + (size_t)(wr * 64 + fr) * ldc + wc * 32 + 4 * fq;
#pragma unroll
    for (int ai = 0; ai < 2; ++ai)
#pragma unroll
        for (int m = 0; m < 4; ++m) { float* rowp = p0 + (size_t)(ai * HALF + m * 16) * ldc;
#pragma unroll
            for (int bj = 0; bj < 2; ++bj)
#pragma unroll
                for (int n = 0; n < 2; ++n) *(f32x4*)(rowp + bj * HALF + n * 16) = acc[ai][bj][m][n]; }
}

template <class Epi, class Sched>
__device__ __forceinline__ void gemm_phase(LAS unsigned char* lds, const Gemm g, const Sched& S, const Epi& E) {
    const int tid = threadIdx.x, wid = __builtin_amdgcn_readfirstlane(tid >> 6), lane = tid & 63, wr = wid >> 2, wc = wid & 3, fr = lane & 15, fq = lane >> 4;
    const int K = g.K, nt = K / BK;
    unsigned voffA[2], voffB[2];
#pragma unroll
    for (int i = 0; i < 2; ++i) { int R, C; stage_rc(tid * 16 + i * 8192, R, C); const int Rb = Epi::PERM ? ((R & ~31) + perm32(R & 31)) : R;
        const int Ra = Epi::PERMA ? ((R & ~63) + 4 * (R & 15) + ((R >> 4) & 3)) : R;
        voffA[i] = (unsigned)(Ra * g.lda + C) * 2u; voffB[i] = (unsigned)(Rb * g.ldb + C) * 2u; }
    const size_t kstep = (size_t)(BK * 2);
    const size_t hstepA = g.hstepA, hstepB = g.hstepB;
    const unsigned ldsw = (unsigned)wid * 1024u;
    const int aoff = lds_byte(wr * 64 + fr, fq * 8), boff = lds_byte(wc * 32 + fr, fq * 8);
#define PG8_SA(b, h) (((b) * 2 + (h)) * HTB)
#define PG8_SB(b, h) ((4 + (b) * 2 + (h)) * HTB)
#define PG8_STAGE(bufoff, gbase, voff) do { _Pragma("unroll") for (int _i = 0; _i < 2; ++_i) \
        __builtin_amdgcn_global_load_lds((const unsigned*)((const char*)(gbase) + (voff)[_i]), (LAS unsigned*)(lds + (bufoff) + ldsw + _i * 8192), 16, 0, 0); } while (0)
#define PG8_LDA(dst, b, h) do { _Pragma("unroll") for (int m = 0; m < 4; ++m) _Pragma("unroll") for (int k = 0; k < 2; ++k) dst[m][k] = *(const LAS bf16x8*)(lds + PG8_SA(b, h) + aoff + m * 2048 + k * 1024); } while (0)
#define PG8_LDB(dst, b, h) do { _Pragma("unroll") for (int n = 0; n < 2; ++n) _Pragma("unroll") for (int k = 0; k < 2; ++k) dst[n][k] = *(const LAS bf16x8*)(lds + PG8_SB(b, h) + boff + n * 2048 + k * 1024); } while (0)
#define PG8_MMA(ai, bj, At, Bt) do { __builtin_amdgcn_s_setprio(1); _Pragma("unroll") for (int m = 0; m < 4; ++m) _Pragma("unroll") for (int n = 0; n < 2; ++n) _Pragma("unroll") for (int k = 0; k < 2; ++k) \
        acc[ai][bj][m][n] = __builtin_amdgcn_mfma_f32_16x16x32_bf16(Bt[n][k], At[m][k], acc[ai][bj][m][n], 0, 0, 0); __builtin_amdgcn_s_setprio(0); } while (0)
#define PG8_WAIT_V(n) asm volatile("s_waitcnt vmcnt(" #n ")" ::: "memory")
#define PG8_WAIT_L(n) asm volatile("s_waitcnt lgkmcnt(" #n ")" ::: "memory")
#define PG8_BAR __builtin_amdgcn_s_barrier()
#define PG8_SCHED __builtin_amdgcn_sched_barrier(0)
    Unit cur, nxt; int ui = 0;
    if (!S.next(0, cur)) return;
    f32x4 acc[2][2][4][2];
#pragma unroll
    for (int a = 0; a < 2; ++a)
#pragma unroll
        for (int b = 0; b < 2; ++b)
#pragma unroll
            for (int m = 0; m < 4; ++m)
#pragma unroll
                for (int n = 0; n < 2; ++n) acc[a][b][m][n] = (f32x4){0.f, 0.f, 0.f, 0.f};
    bf16x8 At[4][2], B0[2][2], B1[2][2];
    const char* cA; const char* cB; S.ptrs(cur, cA, cB);
    PG8_STAGE(PG8_SB(0, 0), cB, voffB); PG8_STAGE(PG8_SB(0, 1), cB + hstepB, voffB); PG8_STAGE(PG8_SA(0, 0), cA, voffA); PG8_STAGE(PG8_SA(0, 1), cA + hstepA, voffA);
    if (wr == 1) PG8_BAR;
    PG8_WAIT_V(2); PG8_BAR;
    PG8_STAGE(PG8_SB(1, 0), cB + kstep, voffB); PG8_STAGE(PG8_SA(1, 0), cA + kstep, voffA); PG8_STAGE(PG8_SB(1, 1), cB + hstepB + kstep, voffB);
    PG8_WAIT_V(6); PG8_BAR;
    for (;;) {
        const bool has_next = S.next(ui + 1, nxt);
        const char* nA = cA; const char* nB = cB; if (has_next) S.ptrs(nxt, nA, nB);
#pragma unroll 1
        for (int t = 0; t < nt; t += 2) {
            const bool last = (t == nt - 2);
            const char* a1 = cA + (size_t)(t + 1) * kstep;
            const char* a2 = last ? nA : cA + (size_t)(t + 2) * kstep; const char* b2 = last ? nB : cB + (size_t)(t + 2) * kstep;
            const char* a3 = a2 + kstep; const char* b3 = b2 + kstep;
            PG8_LDB(B0, 0, 0); PG8_LDB(B1, 0, 1); PG8_SCHED; PG8_LDA(At, 0, 0); PG8_STAGE(PG8_SA(1, 1), a1 + hstepA, voffA);
            PG8_WAIT_V(8); PG8_WAIT_L(0); PG8_BAR; PG8_MMA(0, 0, At, B0); PG8_MMA(0, 1, At, B1); PG8_BAR; PG8_SCHED;
            PG8_LDA(At, 0, 1); PG8_STAGE(PG8_SB(0, 0), b2, voffB); PG8_STAGE(PG8_SB(0, 1), b2 + hstepB, voffB); PG8_STAGE(PG8_SA(0, 0), a2, voffA);
            PG8_WAIT_V(8); PG8_WAIT_L(0); PG8_BAR; PG8_MMA(1, 0, At, B0); PG8_MMA(1, 1, At, B1); PG8_BAR; PG8_SCHED;
            PG8_LDB(B0, 1, 0); PG8_LDB(B1, 1, 1); PG8_SCHED; PG8_LDA(At, 1, 0); PG8_STAGE(PG8_SA(0, 1), a2 + hstepA, voffA);
            PG8_WAIT_V(8); PG8_WAIT_L(0); PG8_BAR; PG8_MMA(0, 0, At, B0); PG8_MMA(0, 1, At, B1); PG8_BAR; PG8_SCHED;
            PG8_LDA(At, 1, 1); PG8_STAGE(PG8_SB(1, 0), b3, voffB); PG8_STAGE(PG8_SB(1, 1), b3 + hstepB, voffB); PG8_STAGE(PG8_SA(1, 0), a3, voffA);
            PG8_WAIT_V(8); PG8_WAIT_L(0); PG8_BAR; PG8_MMA(1, 0, At, B0); PG8_MMA(1, 1, At, B1); PG8_BAR; PG8_SCHED;
        }
        if (wr == 0) PG8_BAR;
        E(acc, cur, wr, wc, fr, fq);
        if (!has_next) break;
#pragma unroll
        for (int a = 0; a < 2; ++a)
#pragma unroll
            for (int b = 0; b < 2; ++b)
#pragma unroll
                for (int m = 0; m < 4; ++m)
#pragma unroll
                    for (int n = 0; n < 2; ++n) acc[a][b][m][n] = (f32x4){0.f, 0.f, 0.f, 0.f};
        cur = nxt; cA = nA; cB = nB; ++ui;
        if (wr == 1) PG8_BAR;
    }
    PG8_WAIT_V(0);
    PG8_BAR;
#undef PG8_SA
#undef PG8_SB
#undef PG8_STAGE
#undef PG8_LDA
#undef PG8_LDB
#undef PG8_MMA
#undef PG8_WAIT_V
#undef PG8_WAIT_L
#undef PG8_BAR
#undef PG8_SCHED
}
}

#define XB_TMO      128
#define XB_XCNT(j)  (256  + 64 * (j))
#define XB_XSUB(j)  (1280 + 64 * (j))
#define XB_XGEN(j)  (2304 + 64 * (j))
#define XB_TOP      3328
#define XB_TOPGEN   3392
#define XCD_BAR_WORDS 3456
#define XB_SPIN_CAP (1u << 18)
__device__ __forceinline__ unsigned xb_ld(unsigned* p)              { return __hip_atomic_load(p, __ATOMIC_RELAXED, __HIP_MEMORY_SCOPE_AGENT); }
__device__ __forceinline__ unsigned xb_add(unsigned* p, unsigned v) { return __hip_atomic_fetch_add(p, v, __ATOMIC_RELAXED, __HIP_MEMORY_SCOPE_AGENT); }
__device__ __forceinline__ unsigned xb_xcc_id() { return (unsigned)__builtin_amdgcn_s_getreg((3 << 11) | 20) & 0xFu; }
#define XB_SPIN(cond, bar) do { unsigned _sp = 0; while (cond) { __builtin_amdgcn_s_sleep(1); \
    if ((++_sp & 255u) == 0u) { if (xb_ld(&(bar)[XB_TMO])) break; if (_sp > XB_SPIN_CAP) { atomicAdd(&(bar)[XB_TMO], 1u); break; } } } } while (0)
struct XcdBarrier { unsigned* bar; unsigned x; volatile LAS unsigned* st; };
__device__ __forceinline__ XcdBarrier xcd_barrier_post(unsigned* bar, volatile LAS unsigned* st) {
    XcdBarrier b; b.bar = bar; b.x = xb_xcc_id(); b.st = st;
    if (threadIdx.x == 0) (void)xb_add(&bar[XB_XCNT(b.x)], 1u);
    return b;
}
__device__ __forceinline__ void xcd_barrier_complete(unsigned* bar, unsigned x, unsigned& nloc, unsigned& nx) {
    const unsigned G = gridDim.x * gridDim.y * gridDim.z;
    unsigned sum, cnt, mine, sp = 0u;
    for (;;) {
        sum = 0u; cnt = 0u; mine = 0u;
#pragma unroll
        for (unsigned j = 0; j < 16; ++j) { const unsigned c = xb_ld(&bar[XB_XCNT(j)]); sum += c; cnt += (c > 0u) ? 1u : 0u; mine = (j == x) ? c : mine; }
        if (sum == G) break;
        __builtin_amdgcn_s_sleep(1);
        if ((++sp & 255u) == 0u) { if (xb_ld(&bar[XB_TMO])) break; if (sp > XB_SPIN_CAP) { atomicAdd(&bar[XB_TMO], 1u); break; } }
    }
    nloc = mine > 0u ? mine : 1u; nx = cnt > 0u ? cnt : 1u;
}
__device__ __forceinline__ void xcd_barrier(const XcdBarrier& b) {
    asm volatile("s_waitcnt vmcnt(0)" ::: "memory");
    __syncthreads();
    if (threadIdx.x == 0) {
        unsigned* bar = b.bar;
        __builtin_amdgcn_s_waitcnt(0);
        unsigned nloc = b.st[0], nx = b.st[1];
        if (nloc == 0u) { xcd_barrier_complete(bar, b.x, nloc, nx); b.st[0] = nloc; b.st[1] = nx; }
        const unsigned old = xb_add(&bar[XB_XSUB(b.x)], 1u);
        const unsigned gen = old / nloc;
        if (old + 1u == (gen + 1u) * nloc) {
            __builtin_amdgcn_fence(__ATOMIC_RELEASE, "agent");
            asm volatile("s_waitcnt vmcnt(0)" ::: "memory");
            const unsigned og = xb_add(&bar[XB_TOP], 1u);
            const unsigned tg = og / nx;
            if (og + 1u == (tg + 1u) * nx) xb_add(&bar[XB_TOPGEN], 1u);
            else XB_SPIN(xb_ld(&bar[XB_TOPGEN]) == tg, bar);
            __builtin_amdgcn_fence(__ATOMIC_ACQUIRE, "agent");
            xb_add(&bar[XB_XGEN(b.x)], 1u);
            asm volatile("s_waitcnt vmcnt(0)" ::: "memory");
        } else {
            XB_SPIN(xb_ld(&bar[XB_XGEN(b.x)]) == gen, bar);
            __builtin_amdgcn_fence(__ATOMIC_ACQUIRE, "agent");
            asm volatile("s_waitcnt vmcnt(0)" ::: "memory");
        }
    }
    __syncthreads();
}

struct Args { const float* in[25]; float* out; unsigned char* ws; int ph_lo, ph_hi; };
struct Frame {
    const float* const* in; float* out; unsigned char* ws; LAS unsigned char* lds; int tid, lane, wave, G, bid;
};
enum { I_X = 0, I_C, I_CTX, I_CCTX, I_WADA, I_BADA, I_GMIXPRE, I_GMIXPOST, I_GFFNPRE, I_GFFNPOST, I_WIN, I_CLW, I_CLB, I_WREC, I_BREC, I_WING, I_BING, I_LAM, I_WFOU, I_BFOU, I_WOUT, I_WUP, I_CFW, I_CFB, I_WDOWN };

constexpr int IT_MOD = 192;
constexpr int IT_TR_WIN = 16 * 48, IT_TR_WOUT = 16 * 32, IT_TR_WUP = 16 * 176, IT_TR_WDOWN = 44 * 32, IT_TR_G = 64;
constexpr int IT_TR = IT_TR_WIN + IT_TR_WOUT + IT_TR_WUP + IT_TR_WDOWN + IT_TR_G;
constexpr int IT_TAB = 128, IT_WCS = 256, IT_POS = 96;

__device__ __forceinline__ void mod_item(const Frame& F, int it) {
    LAS float* sil = (LAS float*)F.lds;
    LAS float* red = (LAS float*)(F.lds + 73728);
    const float* c = F.in[I_C]; const float* cc = F.in[I_CCTX];
    for (int idx = F.tid; idx < 9 * 2048; idx += 512) { const int bb = idx >> 11, k = idx & 2047; const float v = bb < 8 ? c[bb * 2048 + k] : cc[k]; sil[idx] = v * fast_sigmoid(v); }
    __syncthreads();
    const int n0 = it * 64, rg = F.tid >> 4, l16 = F.tid & 15;
    const float* w = F.in[I_WADA] + n0 + l16 * 4;
    f32x4 acc[9];
#pragma unroll
    for (int b = 0; b < 9; ++b) acc[b] = (f32x4){0.f, 0.f, 0.f, 0.f};
    for (int i0 = 0; i0 < 64; i0 += 8) { f32x4 wv[8];
#pragma unroll
        for (int i = 0; i < 8; ++i) wv[i] = *(const f32x4*)(w + (size_t)(rg + 32 * (i0 + i)) * 12288);
#pragma unroll
        for (int i = 0; i < 8; ++i) { const int k = rg + 32 * (i0 + i);
#pragma unroll
            for (int b = 0; b < 9; ++b) acc[b] += sil[b * 2048 + k] * wv[i]; } }
#pragma unroll
    for (int b = 0; b < 9; ++b) *(LAS f32x4*)(red + (rg * 9 + b) * 64 + l16 * 4) = acc[b];
    __syncthreads();
    for (int o = F.tid; o < 576; o += 512) { const int bb = o >> 6, col = o & 63; float s = 0.f; for (int r = 0; r < 32; ++r) s += red[(r * 9 + bb) * 64 + col];
        ((float*)(F.ws + WS_MOD))[bb * 12288 + n0 + col] = s + F.in[I_BADA][n0 + col]; }
    __syncthreads();
}

struct TrDesc { const float* src; bf16_t* dst; int N, ldd, k0, n0; };
__device__ __forceinline__ TrDesc tr_decode(const Frame& F, int it) {
    TrDesc t;
    if (it < IT_TR_WIN) { t.src = F.in[I_WIN]; t.N = NPROJ; t.dst = (bf16_t*)(F.ws + WS_WIN); t.ldd = D; t.k0 = (it % 16) * 128; t.n0 = (it / 16) * 64; return t; }
    it -= IT_TR_WIN;
    if (it < IT_TR_WOUT) { t.src = F.in[I_WOUT]; t.N = D; t.dst = (bf16_t*)(F.ws + WS_WOUT); t.ldd = D; t.k0 = (it % 16) * 128; t.n0 = (it / 16) * 64; return t; }
    it -= IT_TR_WOUT;
    if (it < IT_TR_WUP) { t.src = F.in[I_WUP]; t.N = DFF2; t.dst = (bf16_t*)(F.ws + WS_WUP); t.ldd = D; t.k0 = (it % 16) * 128; t.n0 = (it / 16) * 64; return t; }
    it -= IT_TR_WUP;
    if (it < IT_TR_WDOWN) { t.src = F.in[I_WDOWN]; t.N = D; t.dst = (bf16_t*)(F.ws + WS_WDOWN); t.ldd = DFF; t.k0 = (it % 44) * 128; t.n0 = (it / 44) * 64; return t; }
    it -= IT_TR_WDOWN;
    { const int half = it & 1, mat = it >> 1, type = mat & 1, dir = (mat >> 1) & 1, h = mat >> 2;
      t.src = (type ? F.in[I_WING] : F.in[I_WREC]) + (size_t)(dir * 8 + h) * 128 * 128; t.N = 128;
      t.dst = (bf16_t*)(F.ws + WS_WG) + (size_t)(h * 512 + (dir * 2 + type) * 128) * 128; t.ldd = 128; t.k0 = 0; t.n0 = half * 64; }
    return t;
}
__device__ __forceinline__ void tr_load(const Frame& F, int it, f32x4 (&v)[4]) {
    const TrDesc t = tr_decode(F, it); const int kr0 = F.tid >> 4, c4 = F.tid & 15;
#pragma unroll
    for (int i = 0; i < 4; ++i) v[i] = *(const f32x4*)(t.src + (size_t)(t.k0 + kr0 + 32 * i) * t.N + t.n0 + c4 * 4);
}
__device__ __forceinline__ void tr_store(const Frame& F, int it, const f32x4 (&v)[4]) {
    const TrDesc t = tr_decode(F, it);
    LAS bf16_t* T = (LAS bf16_t*)F.lds;
    const int kr0 = F.tid >> 4, c4 = F.tid & 15;
#pragma unroll
    for (int i = 0; i < 4; ++i) { const int kr = kr0 + 32 * i;
        const unsigned p0 = cvt_pk_bf16(v[i][0], v[i][1]), p1 = cvt_pk_bf16(v[i][2], v[i][3]);
        T[(c4 * 4 + 0) * 136 + kr] = (bf16_t)(p0 & 0xffff); T[(c4 * 4 + 1) * 136 + kr] = (bf16_t)(p0 >> 16);
        T[(c4 * 4 + 2) * 136 + kr] = (bf16_t)(p1 & 0xffff); T[(c4 * 4 + 3) * 136 + kr] = (bf16_t)(p1 >> 16); }
    LDS_BARRIER();
#pragma unroll
    for (int i = 0; i < 2; ++i) { const int n = (F.tid >> 4) + 32 * i, kg = F.tid & 15;
        const u32x4 w = *(const LAS u32x4*)(T + n * 136 + kg * 8);
        *(u32x4*)(t.dst + (size_t)(t.n0 + n) * t.ldd + t.k0 + kg * 8) = w; }
    LDS_BARRIER();
}

__device__ __forceinline__ void tr_range(const Frame& F, int lo, int hi, int b, int nb) {
    int it = lo + b; if (it >= hi) return;
    f32x4 A[4], B[4];
    tr_load(F, it, A);
    for (;;) {
        const int i1 = it + nb; tr_load(F, i1 < hi ? i1 : hi - 1, B);
        tr_store(F, it, A);
        if (i1 >= hi) break;
        const int i2 = i1 + nb; tr_load(F, i2 < hi ? i2 : hi - 1, A);
        tr_store(F, i1, B);
        if (i2 >= hi) break;
        it = i2;
    }
}

__device__ __forceinline__ void tab_items(const Frame& F, int b, int nb) {
    if (b >= IT_TAB) return;
    LAS float* tc = (LAS float*)F.lds; LAS float* ts = tc + 2048;
    const float sc = 0.02209708691f;
    for (int j = F.tid; j < 2048; j += 512) { float s, c; sincospif((float)j * (1.0f / 1024.0f), &s, &c); tc[j] = c * sc; ts[j] = s * sc; }
    __syncthreads();
    bf16_t* ct = (bf16_t*)(F.ws + WS_CTAB); bf16_t* st = (bf16_t*)(F.ws + WS_STAB);
    for (int it = b; it < IT_TAB; it += nb)
        for (int r = 0; r < 8; ++r) { const int k = it * 8 + r; const int n = F.tid * 4; float cv[4], sv[4];
#pragma unroll
            for (int j = 0; j < 4; ++j) { const int idx = (k * (n + j)) & 2047; cv[j] = tc[idx]; sv[j] = ts[idx]; }
            u32x2 cw, sw; cw.x = cvt_pk_bf16(cv[0], cv[1]); cw.y = cvt_pk_bf16(cv[2], cv[3]); sw.x = cvt_pk_bf16(sv[0], sv[1]); sw.y = cvt_pk_bf16(sv[2], sv[3]);
            *(u32x2*)(ct + (size_t)k * 2048 + n) = cw; *(u32x2*)(st + (size_t)k * 2048 + n) = sw; }
    __syncthreads();
}

__device__ __forceinline__ void wcs_items(const Frame& F, int b, int nb) {
    LAS float* tab = (LAS float*)F.lds;
    if (F.tid < 256) { float s, c; sincospif((float)F.tid * (1.0f / 128.0f), &s, &c); tab[F.tid] = c; tab[256 + F.tid] = s; }
    __syncthreads();
    for (int it = b; it < IT_WCS; it += nb) {
        const int g = it >> 6, c0 = (it & 63) * 4, d = F.tid & 255, s = F.tid >> 8;
        const float* wf = F.in[I_WFOU] + (size_t)g * 65536 + d; const LAS float* tb = tab + s * 256;
        const float sg = s ? -1.0f : 1.0f;
        float a0 = 0.f, a1 = 0.f, a2 = 0.f, a3 = 0.f;
        for (int m0 = 1; m0 < 128; m0 += 8) { float e[8];
#pragma unroll
            for (int j = 0; j < 8; ++j) { const int m = m0 + j; e[j] = m < 128 ? wf[m * 256] + sg * wf[(256 - m) * 256] : 0.f; }
#pragma unroll
            for (int j = 0; j < 8; ++j) { const int m = m0 + j;
                a0 += tb[(m * (c0 + 0)) & 255] * e[j]; a1 += tb[(m * (c0 + 1)) & 255] * e[j]; a2 += tb[(m * (c0 + 2)) & 255] * e[j]; a3 += tb[(m * (c0 + 3)) & 255] * e[j]; } }
        if (s == 0) { const float w0 = wf[0], w128 = wf[128 * 256]; a0 += w0 + w128; a1 += w0 - w128; a2 += w0 + w128; a3 += w0 - w128; }
        u32x2 w; w.x = cvt_pk_bf16(a0 * 0.0625f, a1 * 0.0625f); w.y = cvt_pk_bf16(a2 * 0.0625f, a3 * 0.0625f);
        *(u32x2*)((bf16_t*)(F.ws + WS_WCS) + (size_t)(g * 512 + s * 256 + d) * 256 + c0) = w;
    }
    __syncthreads();
}

__device__ __forceinline__ void pos_item(const Frame& F, int p) {
    float* pt = (float*)(F.ws + WS_POS) + (size_t)p * 1024;
    const float pe = (float)(p < 32 ? p : p - 32);
    for (int e = F.tid; e < 1024; e += 512) { const int half = e >> 9, i = e & 511;
        const float f = powf(10000.0f, -(float)i / 512.0f); const float ang = pe * f;
        pt[e] = half ? cosf(ang) : sinf(ang); }
}

__device__ __forceinline__ void p0_prologue(const Frame& F) {
    const int NC = F.G >= 128 ? 64 : 0;
    const bool comp = NC == 0 || F.bid < NC, mem = NC == 0 || F.bid >= NC;
    const int cb = F.bid, cn = NC ? NC : F.G, mb = F.bid - NC, mn = F.G - NC;
    if (mem) {
        for (int it = mb; it < IT_MOD; it += mn) mod_item(F, it);
        tr_range(F, 0, IT_TR, mb, mn);
        __syncthreads();
    }
    if (comp) {
        wcs_items(F, cb, cn);
        tab_items(F, cb, cn);
        for (int it = cb; it < IT_POS; it += cn) pos_item(F, it);
        if (cb == 0) for (int e = F.tid; e < 2048; e += 512) ((float*)(F.ws + WS_K2))[e] = -8.0f * 1.44269504f * log1pf(expf(-F.in[I_LAM][e]));
    }
}

__device__ __forceinline__ f32x4 pos4(const float* pt, int t, int col) {
    const float* p = col < 1024 ? pt + (size_t)(t >> 6) * 1024 + col : pt + (size_t)(32 + (t & 63)) * 1024 + (col - 1024);
    return *(const f32x4*)p;
}
__device__ __forceinline__ void p1_norm(const Frame& F, int r_lo, int r_hi, int b0, int nb) {
    const float* pt = (const float*)(F.ws + WS_POS); const float* mod = (const float*)(F.ws + WS_MOD);
    const float* g = F.in[I_GMIXPRE]; bf16_t* H = (bf16_t*)(F.ws + WS_H);
    for (int r = r_lo + (F.bid - b0) * 8 + F.wave; r < r_hi; r += nb * 8) {
        const bool lat = r < MLAT; const int b = lat ? (r >> 11) : ((r - MLAT) >> 8), t = r & 2047;
        const float* src = lat ? F.in[I_X] + (size_t)r * D : F.in[I_CTX] + (size_t)(r - MLAT) * D;
        const float* mrow = mod + (size_t)(lat ? b : 8) * 12288;
        f32x4 v[8]; float ss = 0.f;
#pragma unroll
        for (int i = 0; i < 8; ++i) { const int col = (i * 64 + F.lane) * 4; v[i] = *(const f32x4*)(src + col); if (lat) v[i] += pos4(pt, t, col);
            ss += v[i][0] * v[i][0] + v[i][1] * v[i][1] + v[i][2] * v[i][2] + v[i][3] * v[i][3]; }
        ss = wave_sum(ss); const float rstd = rsqrtf(ss * (1.0f / D) + EPS);
#pragma unroll
        for (int i = 0; i < 8; ++i) { const int col = (i * 64 + F.lane) * 4; const f32x4 gg = *(const f32x4*)(g + col), sh = *(const f32x4*)(mrow + col), sc = *(const f32x4*)(mrow + 2048 + col);
            const f32x4 h = (v[i] * rstd * gg) * (1.0f + sc) + sh; u32x2 w; w.x = cvt_pk_bf16(h[0], h[1]); w.y = cvt_pk_bf16(h[2], h[3]);
            *(u32x2*)(H + (size_t)r * D + col) = w; }
    }
}

__device__ __forceinline__ void p1_latent_staged(const Frame& F, int b0, int nb) {
    const float* pt = (const float*)(F.ws + WS_POS); const float* mod = (const float*)(F.ws + WS_MOD);
    const float* g = F.in[I_GMIXPRE]; bf16_t* H = (bf16_t*)(F.ws + WS_H);
    const int j = F.bid - b0, per = nb >> 3, b = j / per, jb = j - b * per;
    LAS float* L = (LAS float*)F.lds;
    const float* mrow = mod + (size_t)b * 12288;
    __syncthreads();
    for (int e = F.tid; e < 512; e += 512) { const int c4 = e * 4;
        *(LAS f32x4*)(L + c4) = (1.0f + *(const f32x4*)(mrow + 2048 + c4)) * *(const f32x4*)(g + c4);
        *(LAS f32x4*)(L + 2048 + c4) = *(const f32x4*)(mrow + c4); }
    __syncthreads();
    const int step = per * 8;
    for (int t0 = jb * 8 + F.wave; t0 < SEQ; t0 += 2 * step) {
        f32x4 v[2][8]; float ss[2] = {0.f, 0.f};
#pragma unroll
        for (int q = 0; q < 2; ++q) { const int t = t0 + q * step < SEQ ? t0 + q * step : t0; const size_t r = (size_t)b * SEQ + t;
#pragma unroll
            for (int i = 0; i < 8; ++i) v[q][i] = *(const f32x4*)(F.in[I_X] + r * D + (i * 64 + F.lane) * 4); }
#pragma unroll
        for (int q = 0; q < 2; ++q) { const int t = t0 + q * step < SEQ ? t0 + q * step : t0;
#pragma unroll
            for (int i = 0; i < 8; ++i) { v[q][i] += pos4(pt, t, (i * 64 + F.lane) * 4); ss[q] += v[q][i][0] * v[q][i][0] + v[q][i][1] * v[q][i][1] + v[q][i][2] * v[q][i][2] + v[q][i][3] * v[q][i][3]; } }
#pragma unroll
        for (int q = 0; q < 2; ++q) { const int t = t0 + q * step; if (t >= SEQ) break; const size_t r = (size_t)b * SEQ + t;
            const float rstd = rsqrtf(wave_sum(ss[q]) * (1.0f / D) + EPS);
#pragma unroll
            for (int i = 0; i < 8; ++i) { const int col = (i * 64 + F.lane) * 4;
                const f32x4 h = (v[q][i] * rstd) * *(const LAS f32x4*)(L + col) + *(const LAS f32x4*)(L + 2048 + col);
                u32x2 w; w.x = cvt_pk_bf16(h[0], h[1]); w.y = cvt_pk_bf16(h[2], h[3]);
                *(u32x2*)(H + r * D + col) = w; } }
    }
    __syncthreads();
}
struct SchedWin {
    const bf16_t* A; const bf16_t* B; int G, c;
    int lo, hi;
    __device__ __forceinline__ bool next(int i, pg8::Unit& u) const { const int L = lo + i * G + c; if (L >= hi) return false;
        if (L < 768) pg8::std_order(L, 64, 12, u.pm, u.pn, 4); else { const int l = L - 768; u.pm = 64 + (l >> 2); u.pn = 4 + (l & 3); } u.z = 0; return true; }
    __device__ __forceinline__ void ptrs(const pg8::Unit& u, const char*& a, const char*& b) const { a = (const char*)(A + (size_t)u.pm * 256 * D); b = (const char*)(B + (size_t)u.pn * 256 * D); }
};
struct EpiWin { static constexpr bool PERM = true, PERMA = false; bf16_t* uf;
    __device__ __forceinline__ void operator()(const f32x4 (&acc)[2][2][4][2], const pg8::Unit& u, int wr, int wc, int fr, int fq) const {
        const int seg = u.pn >> 2; bf16_t* base = uf + (size_t)seg * (16u << 20) + (size_t)(seg >> 1) * (2u << 20);
        pg8::store_tile_bf16(acc, base + (size_t)u.pm * 256 * 1024 + (u.pn & 3) * 256, 1024, wr, wc, fr, fq); }
};
struct SchedPQ {
    const bf16_t* A; const bf16_t* B; int G, c;
    __device__ __forceinline__ bool next(int i, pg8::Unit& u) const { const int L = i * G + c; if (L >= 512) return false; u.z = L >> 4; u.pm = (L >> 3) & 1; u.pn = L & 7; return true; }
    __device__ __forceinline__ void ptrs(const pg8::Unit& u, const char*& a, const char*& b) const { const int bb = u.z >> 2, g = u.z & 3;
        a = (const char*)(A + (size_t)(g * 512 + u.pm * 256) * 256); b = (const char*)(B + (size_t)(bb * 2048 + u.pn * 256) * 1024 + g * 256); }
};
struct EpiPQ { static constexpr bool PERM = true, PERMA = false; bf16_t* o;
    __device__ __forceinline__ void operator()(const f32x4 (&acc)[2][2][4][2], const pg8::Unit& u, int wr, int wc, int fr, int fq) const {
        pg8::store_tile_bf16(acc, o + (size_t)(u.z * 512 + u.pm * 256) * 2048 + u.pn * 256, 2048, wr, wc, fr, fq); }
};
struct SchedDFT {
    const bf16_t* ct; const bf16_t* st; const bf16_t* B; int G, c;
    __device__ __forceinline__ bool next(int i, pg8::Unit& u) const { const int L = i * G + c; if (L >= 256) return false; u.pm = L & 3; u.pn = (L >> 2) & 1; u.z = L >> 3; return true; }
    __device__ __forceinline__ void ptrs(const pg8::Unit& u, const char*& a, const char*& b) const {
        a = (const char*)(ct + (size_t)u.pn * (2u << 20) + (size_t)u.pm * 256 * 2048); b = (const char*)(B + (size_t)(u.z * 512 + u.pn * 256) * 2048); }
};
struct EpiDFT { static constexpr bool PERM = true, PERMA = false; bf16_t* o;
    __device__ __forceinline__ void operator()(const f32x4 (&acc)[2][2][4][2], const pg8::Unit& u, int wr, int wc, int fr, int fq) const { const int bb = u.z >> 2, g = u.z & 3;
        pg8::store_tile_bf16(acc, o + (size_t)u.pn * 8192 * 1024 + (size_t)(bb * 1024 + u.pm * 256) * 1024 + g * 256, 1024, wr, wc, fr, fq); }
};
struct SchedStd {
    const bf16_t* A; const bf16_t* B; int nM, nN, lda, ldb, G, c, nrep;
    __device__ __forceinline__ bool next(int i, pg8::Unit& u) const { int L = i * G + c; if (L >= nM * nN * nrep) return false; L %= nM * nN; pg8::std_order(L, nM, nN, u.pm, u.pn, 4); u.z = 0; return true; }
    __device__ __forceinline__ void ptrs(const pg8::Unit& u, const char*& a, const char*& b) const { a = (const char*)(A + (size_t)u.pm * 256 * lda); b = (const char*)(B + (size_t)u.pn * 256 * ldb); }
};
struct EpiY { static constexpr bool PERM = true, PERMA = false; bf16_t* y; float* rss;
    __device__ __forceinline__ void operator()(const f32x4 (&acc)[2][2][4][2], const pg8::Unit& u, int wr, int wc, int fr, int fq) const {
        pg8::store_tile_bf16(acc, y + (size_t)u.pm * 256 * D + u.pn * 256, D, wr, wc, fr, fq);
#pragma unroll
        for (int ai = 0; ai < 2; ++ai)
#pragma unroll
            for (int m = 0; m < 4; ++m) { float s = 0.f;
#pragma unroll
                for (int bj = 0; bj < 2; ++bj)
#pragma unroll
                    for (int n = 0; n < 2; ++n) { const f32x4 v = acc[ai][bj][m][n]; s += (v[0] * v[0] + v[1] * v[1]) + (v[2] * v[2] + v[3] * v[3]); }
                s += __shfl_xor(s, 16); s += __shfl_xor(s, 32);
                if (fq == 0) rss[(size_t)(u.pm * 256 + ai * 128 + wr * 64 + m * 16 + fr) * 32 + u.pn * 4 + wc] = s; }
    }
};
template <int CTRL> __device__ __forceinline__ float dpp_f(float old, float src) { return __int_as_float(__builtin_amdgcn_update_dpp(__float_as_int(old), __float_as_int(src), CTRL, 0xF, 0xF, false)); }
constexpr int DPP_SHL1 = 0x101, DPP_SHR1 = 0x111, DPP_ROR1 = 0x121, DPP_ROR15 = 0x12F;
constexpr int LDS_EDGE = 131072;
#ifndef OUTREP
#define OUTREP 1
#endif
#ifndef DOWNREP
#define DOWNREP 1
#endif
#ifndef UPREP
#define UPREP 1
#endif
struct SchedUp {
    const bf16_t* A; const bf16_t* B; int G, c;
    __device__ __forceinline__ bool next(int i, pg8::Unit& u) const { int L = i * G + c; if (L >= 64 * 44 * UPREP) return false; L %= 64 * 44; pg8::std_order(L, 64, 44, u.pm, u.pn, 4); u.z = 0; return true; }
    __device__ __forceinline__ void ptrs(const pg8::Unit& u, const char*& a, const char*& b) const { a = (const char*)(A + (size_t)u.pm * 256 * D); b = (const char*)(B + (size_t)u.pn * 128 * D); }
};
struct EpiUpConv { static constexpr bool PERM = true, PERMA = true; bf16_t* act; float* edge; const float* cw; const float* cb; LAS unsigned char* lds;
    __device__ __forceinline__ void operator()(f32x4 (&acc)[2][2][4][2], const pg8::Unit& u, int wr, int wc, int fr, int fq) const {
        const int colw = 32 * wc + 8 * fq;
        LAS float* E = (LAS float*)(lds + LDS_EDGE) + wr * 512 + colw;
#pragma unroll
        for (int ai = 0; ai < 2; ++ai)
#pragma unroll
            for (int bj = 0; bj < 2; ++bj)
#pragma unroll
                for (int n = 0; n < 2; ++n) {
                    if (fr == 0) *(LAS f32x4*)(E + (4 * ai + 1) * 256 + bj * 128 + 4 * n) = acc[ai][bj][0][n];
                    if (fr == 15) *(LAS f32x4*)(E + (4 * ai + 2) * 256 + bj * 128 + 4 * n) = acc[ai][bj][3][n]; }
        { float* eg = edge + (size_t)u.pm * 4 * DFF2 + u.pn * 128 + colw;
          if (wr == 0) { if (fr == 0) {
#pragma unroll
              for (int bj = 0; bj < 2; ++bj)
#pragma unroll
                  for (int n = 0; n < 2; ++n) { *(f32x4*)(eg + bj * DFF + 4 * n) = acc[0][bj][0][n]; *(f32x4*)(eg + DFF2 + bj * DFF + 4 * n) = acc[0][bj][1][n]; } } }
          else { if (fr == 15) {
#pragma unroll
              for (int bj = 0; bj < 2; ++bj)
#pragma unroll
                  for (int n = 0; n < 2; ++n) { *(f32x4*)(eg + 2 * DFF2 + bj * DFF + 4 * n) = acc[1][bj][2][n]; *(f32x4*)(eg + 3 * DFF2 + bj * DFF + 4 * n) = acc[1][bj][3][n]; } } } }
        const float* cwp = cw + u.pn * 128 + colw; const float* cbp = cb + u.pn * 128 + colw;
        f32x4 W[2][8];
#pragma unroll
        for (int n = 0; n < 2; ++n) { W[n][0] = *(const f32x4*)(cwp + 4 * n); W[n][1] = *(const f32x4*)(cwp + DFF2 + 4 * n); W[n][2] = *(const f32x4*)(cwp + 2 * DFF2 + 4 * n); W[n][3] = *(const f32x4*)(cbp + 4 * n);
            W[n][4] = *(const f32x4*)(cwp + DFF + 4 * n); W[n][5] = *(const f32x4*)(cwp + DFF2 + DFF + 4 * n); W[n][6] = *(const f32x4*)(cwp + 2 * DFF2 + DFF + 4 * n); W[n][7] = *(const f32x4*)(cbp + DFF + 4 * n); }
        asm volatile("s_waitcnt lgkmcnt(0)" ::: "memory"); __builtin_amdgcn_s_barrier(); __builtin_amdgcn_s_barrier(); asm volatile("" ::: "memory");
#pragma unroll
        for (int n = 0; n < 2; ++n) {
            f32x4 wg0 = W[n][0], wg1 = W[n][1], wg2 = W[n][2], bg = W[n][3], wv0 = W[n][4], wv1 = W[n][5], wv2 = W[n][6], bv = W[n][7];
            asm volatile("" : "+v"(wg0), "+v"(wg1), "+v"(wg2), "+v"(bg), "+v"(wv0), "+v"(wv1), "+v"(wv2), "+v"(bv));
#pragma unroll
            for (int ai = 0; ai < 2; ++ai) {
                f32x4 ep0 = *(const LAS f32x4*)(E + (4 * ai) * 256 + 4 * n), ep1 = *(const LAS f32x4*)(E + (4 * ai) * 256 + 128 + 4 * n);
                f32x4 en0 = *(const LAS f32x4*)(E + (4 * ai + 3) * 256 + 4 * n), en1 = *(const LAS f32x4*)(E + (4 * ai + 3) * 256 + 128 + 4 * n);
                asm volatile("" : "+v"(ep0), "+v"(ep1), "+v"(en0), "+v"(en1));
                f32x4 T[4];
#pragma unroll
                for (int m = 0; m < 4; ++m) {
                    asm volatile("" : "+v"(acc[ai][0][m][n]), "+v"(acc[ai][1][m][n]));
#pragma unroll
                    for (int q = 0; q < 4; q += 2) {
                        f32x2 g, v, gp, vp, gn, vn;
#pragma unroll
                        for (int e = 0; e < 2; ++e) { const int qq = q + e;
                            g[e] = acc[ai][0][m][n][qq]; v[e] = acc[ai][1][m][n][qq];
                            gp[e] = m > 0 ? acc[ai][0][m > 0 ? m - 1 : 0][n][qq] : dpp_f<DPP_SHR1>(ep0[qq], acc[ai][0][3][n][qq]);
                            vp[e] = m > 0 ? acc[ai][1][m > 0 ? m - 1 : 0][n][qq] : dpp_f<DPP_SHR1>(ep1[qq], acc[ai][1][3][n][qq]);
                            gn[e] = m < 3 ? acc[ai][0][m < 3 ? m + 1 : 3][n][qq] : dpp_f<DPP_SHL1>(en0[qq], acc[ai][0][0][n][qq]);
                            vn[e] = m < 3 ? acc[ai][1][m < 3 ? m + 1 : 3][n][qq] : dpp_f<DPP_SHL1>(en1[qq], acc[ai][1][0][n][qq]); }
                        const f32x2 w0g = (f32x2){wg0[q], wg0[q + 1]}, w1g = (f32x2){wg1[q], wg1[q + 1]}, w2g = (f32x2){wg2[q], wg2[q + 1]}, b0g = (f32x2){bg[q], bg[q + 1]};
                        const f32x2 w0v = (f32x2){wv0[q], wv0[q + 1]}, w1v = (f32x2){wv1[q], wv1[q + 1]}, w2v = (f32x2){wv2[q], wv2[q + 1]}, b0v = (f32x2){bv[q], bv[q + 1]};
                        const f32x2 gg = b0g + w0g * gp + w1g * g + w2g * gn;
                        const f32x2 vv = b0v + w0v * vp + w1v * v + w2v * vn;
                        const f32x2 arg = gg * ((gg * gg) * (-2.302208198f * 0.044715f) + (-2.302208198f));
                        f32x2 d; d.x = __builtin_amdgcn_exp2f(arg.x); d.y = __builtin_amdgcn_exp2f(arg.y); d = d + 1.0f;
                        f32x2 r; r.x = __builtin_amdgcn_rcpf(d.x); r.y = __builtin_amdgcn_rcpf(d.y);
                        const f32x2 o = (gg * vv) * r;
                        T[m][q] = o.x; T[m][q + 1] = o.y; }
                    asm volatile("" : "+v"(T[m])); }
#pragma unroll
                for (int m = 0; m < 4; ++m) acc[ai][0][m][n] = T[m]; } }
        bf16_t* p0 = act + (size_t)(u.pm * 256 + wr * 64 + 4 * fr) * DFF + u.pn * 128 + colw;
#pragma unroll
        for (int ai = 0; ai < 2; ++ai)
#pragma unroll
            for (int m = 0; m < 4; ++m) { const f32x4 v0 = acc[ai][0][m][0], v1 = acc[ai][0][m][1];
                u32x4 w; w.x = cvt_pk_bf16(v0[0], v0[1]); w.y = cvt_pk_bf16(v0[2], v0[3]); w.z = cvt_pk_bf16(v1[0], v1[1]); w.w = cvt_pk_bf16(v1[2], v1[3]);
                *(u32x4*)(p0 + (size_t)(ai * 128 + m) * DFF) = w; }
    }
};

constexpr int XB_STRIDE = 136, AR_STRIDE = 132;
constexpr int LDS_XB = 0, LDS_AF = 17408, LDS_IF = LDS_AF + 33792, LDS_AB = LDS_IF + 33792, LDS_IB = LDS_AB + 33792;
static_assert(LDS_IB + 33792 <= LDS_BAR, "lds");

__device__ __forceinline__ void lru_load(const Frame& F, int L, u32x4 (&U)[2][4]) {
    const bf16_t* Ux = (const bf16_t*)(F.ws + WS_UX);
    const int h = L & 7, s = L >> 3, b = s / NCHUNK, j = s % NCHUNK;
    const bool isctx = j < 4; const int rowbase = isctx ? MLAT + b * CTXL : b * SEQ, t0 = isctx ? j * 64 : (j - 4) * 64, len = isctx ? CTXL : SEQ;
#pragma unroll
    for (int i = 0; i < 2; ++i) { const int idx = F.tid + 512 * i, tok = idx >> 4, cg8 = idx & 15;
#pragma unroll
        for (int k = 0; k < 4; ++k) { int tt = t0 + tok + k - 2; tt = tt < 0 ? 0 : (tt >= len ? len - 1 : tt);
            U[i][k] = *(const u32x4*)(Ux + (size_t)(rowbase + tt) * 1024 + h * 128 + cg8 * 8); } }
}
__device__ __forceinline__ void lru_phase(const Frame& F) {
    const bf16_t* WgT = (const bf16_t*)(F.ws + WS_WG);
    bf16_t* So = (bf16_t*)(F.ws + WS_S); bf16_t* Pfo = (bf16_t*)(F.ws + WS_PF); bf16_t* Pbo = (bf16_t*)(F.ws + WS_PB);
    float* agg = (float*)(F.ws + WS_AGG);
    LAS bf16_t* XB = (LAS bf16_t*)(F.lds + LDS_XB);
    const int w = F.wave, fr = F.lane & 15, fq = F.lane >> 4;
    constexpr int NU = NB * NCHUNK * 8;
    int cur_h = -1;
    bf16x8 Wf[4][4];
    int L = F.bid; if (L >= NU) return;
    u32x4 U[2][4];
    lru_load(F, L, U);
    for (;;) {
        const int h = L & 7, s = L >> 3, b = s / NCHUNK, j = s % NCHUNK;
        if (h != cur_h) { cur_h = h;
#pragma unroll
            for (int g4 = 0; g4 < 4; ++g4)
#pragma unroll
                for (int kk = 0; kk < 4; ++kk) Wf[g4][kk] = *(const bf16x8*)(WgT + (size_t)(h * 512 + g4 * 128 + 16 * w + fr) * 128 + kk * 32 + fq * 8);
        }
        const bool isctx = j < 4; const int rowbase = isctx ? MLAT + b * CTXL : b * SEQ, t0 = isctx ? j * 64 : (j - 4) * 64, len = isctx ? CTXL : SEQ;
#pragma unroll
        for (int i = 0; i < 2; ++i) { const int idx = F.tid + 512 * i, tok = idx >> 4, cg8 = idx & 15; const int ch = h * 128 + cg8 * 8;
            float o[8]; { const f32x4 b0 = *(const f32x4*)(F.in[I_CLB] + ch), b1 = *(const f32x4*)(F.in[I_CLB] + ch + 4);
                o[0] = b0[0]; o[1] = b0[1]; o[2] = b0[2]; o[3] = b0[3]; o[4] = b1[0]; o[5] = b1[1]; o[6] = b1[2]; o[7] = b1[3]; }
#pragma unroll
            for (int k = 0; k < 4; ++k) { const int tt = t0 + tok + k - 2; const float msk = (tt >= 0 && tt < len) ? 1.0f : 0.0f;
                float uv[8]; unpack8(U[i][k], uv);
                const f32x4 w0 = *(const f32x4*)(F.in[I_CLW] + k * 1024 + ch) * msk, w1 = *(const f32x4*)(F.in[I_CLW] + k * 1024 + ch + 4) * msk;
                o[0] += w0[0] * uv[0]; o[1] += w0[1] * uv[1]; o[2] += w0[2] * uv[2]; o[3] += w0[3] * uv[3];
                o[4] += w1[0] * uv[4]; o[5] += w1[1] * uv[5]; o[6] += w1[2] * uv[6]; o[7] += w1[3] * uv[7]; }
            *(LAS u32x4*)(XB + tok * XB_STRIDE + cg8 * 8) = pack8(o); }
        const int Ln = L + F.G;
        lru_load(F, Ln < NU ? Ln : NU - 1, U);
        LDS_BARRIER();
#pragma unroll
        for (int d = 0; d < 2; ++d) {
            const int C = d * 1024 + h * 128 + 16 * w + 4 * fq;
            const f32x4 nba = *(const f32x4*)(F.in[I_BREC] + C) * -1.44269504f, nbx = *(const f32x4*)(F.in[I_BING] + C) * -1.44269504f, k2 = *(const f32x4*)((const float*)(F.ws + WS_K2) + C);
            f32x4 acc[2][4];
#pragma unroll
            for (int g2 = 0; g2 < 2; ++g2)
#pragma unroll
                for (int m = 0; m < 4; ++m) acc[g2][m] = (f32x4){0.f, 0.f, 0.f, 0.f};
#pragma unroll
            for (int m = 0; m < 4; ++m) { bf16x8 Xf[4];
#pragma unroll
                for (int kk = 0; kk < 4; ++kk) Xf[kk] = *(const LAS bf16x8*)(XB + (16 * m + fr) * XB_STRIDE + kk * 32 + fq * 8);
#pragma unroll
                for (int g2 = 0; g2 < 2; ++g2)
#pragma unroll
                    for (int kk = 0; kk < 4; ++kk) acc[g2][m] = __builtin_amdgcn_mfma_f32_16x16x32_bf16(Wf[2 * d + g2][kk], Xf[kk], acc[g2][m], 0, 0, 0); }
#pragma unroll
            for (int m = 0; m < 4; ++m) { const int tok = 16 * m + fr;
                const u32x2 xw = *(const LAS u32x2*)(XB + tok * XB_STRIDE + 16 * w + 4 * fq);
                const f32x4 xc = (f32x4){bf_lo(xw.x), bf_hi(xw.x), bf_lo(xw.y), bf_hi(xw.y)};
                f32x4 av, iv;
#pragma unroll
                for (int q = 0; q < 4; ++q) {
                    const float ea = __builtin_amdgcn_exp2f(fminf(fmaf(acc[0][m][q], -1.44269504f, nba[q]), 60.f)), ex = __builtin_amdgcn_exp2f(fminf(fmaf(acc[1][m][q], -1.44269504f, nbx[q]), 60.f));
                    const float pa = 1.0f + ea, px = 1.0f + ex, t = __builtin_amdgcn_rcpf(pa * px), r = t * px, ig = t * pa;
                    const float la2 = r * k2[q]; const float a = __builtin_amdgcn_exp2f(la2); const float u = la2 * 1.38629436f;
                    const float poly = -u * (1.0f + u * (0.5f + u * 0.16666667f));
                    const float em = u > -0.02f ? poly : fmaf(-a, a, 1.0f);
                    av[q] = a; iv[q] = __builtin_amdgcn_sqrtf(fmaxf(em, 0.f)) * ig * xc[q]; }
                *(LAS f32x4*)(F.lds + (d ? LDS_AB : LDS_AF) + (tok * AR_STRIDE + 16 * w + 4 * fq) * 4) = av;
                *(LAS f32x4*)(F.lds + (d ? LDS_IB : LDS_IF) + (tok * AR_STRIDE + 16 * w + 4 * fq) * 4) = iv; }
            asm volatile("" ::: "memory");
        }
        LDS_BARRIER();
        LAS float* ENDS = (LAS float*)(F.lds + LDS_XB);
        { const int half = F.tid >> 8, d = (F.tid >> 7) & 1, ch = F.tid & 127;
            LAS float* A = (LAS float*)(F.lds + (d ? LDS_AB : LDS_AF)) + ch; LAS float* I = (LAS float*)(F.lds + (d ? LDS_IB : LDS_IF)) + ch;
            float hs = 0.f, P = 1.f;
            if (d == 0) { const int tb = half * 32;
#pragma unroll 8
                for (int t = 0; t < 32; ++t) { const float a = A[(tb + t) * AR_STRIDE], x = I[(tb + t) * AR_STRIDE]; hs = a * hs + x; P *= a; I[(tb + t) * AR_STRIDE] = hs; A[(tb + t) * AR_STRIDE] = P; }
            } else { const int tb = 63 - half * 32;
#pragma unroll 8
                for (int t = 0; t < 32; ++t) { const float a = A[(tb - t) * AR_STRIDE], x = I[(tb - t) * AR_STRIDE]; hs = a * hs + x; P *= a; I[(tb - t) * AR_STRIDE] = hs; A[(tb - t) * AR_STRIDE] = P; }
            }
            ENDS[((d * 2 + half) * 2 + 0) * 128 + ch] = P; ENDS[((d * 2 + half) * 2 + 1) * 128 + ch] = hs; }
        LDS_BARRIER();
        if (F.tid < 256) { const int d = F.tid >> 7, ch = F.tid & 127;
            const float P0 = ENDS[((d * 2 + 0) * 2 + 0) * 128 + ch], H0 = ENDS[((d * 2 + 0) * 2 + 1) * 128 + ch], P1 = ENDS[((d * 2 + 1) * 2 + 0) * 128 + ch], H1 = ENDS[((d * 2 + 1) * 2 + 1) * 128 + ch];
            float* ag = agg + ((size_t)(b * NCHUNK + j) * 4 + d * 2) * 1024 + h * 128 + ch; ag[0] = P0 * P1; ag[1024] = P1 * H0 + H1; }
        if (!isctx) {
#pragma unroll
            for (int i = 0; i < 2; ++i) { const int idx = F.tid + 512 * i, tok = idx >> 4, cg8 = idx & 15; const int o = (tok * AR_STRIDE + cg8 * 8) * 4;
                const bool f2 = tok >= 32, b2 = tok < 32;
                float sv[8], pf[8], pb[8];
#pragma unroll
                for (int hh = 0; hh < 2; ++hh) { const f32x4 x0 = *(const LAS f32x4*)(F.lds + LDS_IF + o + hh * 16), x1 = *(const LAS f32x4*)(F.lds + LDS_IB + o + hh * 16);
                    const f32x4 p0 = *(const LAS f32x4*)(F.lds + LDS_AF + o + hh * 16), p1 = *(const LAS f32x4*)(F.lds + LDS_AB + o + hh * 16);
                    const int c0 = cg8 * 8 + hh * 4;
                    const f32x4 fP = f2 ? *(const LAS f32x4*)(ENDS + 0 * 128 + c0) : (f32x4){1.f, 1.f, 1.f, 1.f}, fH = f2 ? *(const LAS f32x4*)(ENDS + 1 * 128 + c0) : (f32x4){0.f, 0.f, 0.f, 0.f};
                    const f32x4 bP = b2 ? *(const LAS f32x4*)(ENDS + 4 * 128 + c0) : (f32x4){1.f, 1.f, 1.f, 1.f}, bH = b2 ? *(const LAS f32x4*)(ENDS + 5 * 128 + c0) : (f32x4){0.f, 0.f, 0.f, 0.f};
#pragma unroll
                    for (int q = 0; q < 4; ++q) { sv[hh * 4 + q] = (x0[q] + p0[q] * fH[q]) + (x1[q] + p1[q] * bH[q]); pf[hh * 4 + q] = p0[q] * fP[q]; pb[hh * 4 + q] = p1[q] * bP[q]; } }
                const size_t go = (size_t)(rowbase + t0 + tok) * 1024 + h * 128 + cg8 * 8;
                *(u32x4*)(So + go) = pack8(sv); *(u32x4*)(Pfo + go) = pack8(pf); *(u32x4*)(Pbo + go) = pack8(pb); }
        }
        LDS_BARRIER();
        if (Ln >= NU) break;
        L = Ln;
    }
    __syncthreads();
}

__device__ __forceinline__ void alt_phase(const Frame& F) {
    const bf16_t* PQT = (const bf16_t*)(F.ws + WS_PQT); float* y1024 = (float*)(F.ws + WS_Y1024);
    const bf16_t* ct = (const bf16_t*)(F.ws + WS_CTAB);
    const float sc = __uint_as_float(((unsigned)ct[0]) << 16);
    for (int o = F.bid * 8 + F.wave; o < 8192; o += F.G * 8) {
        const int bg = o >> 8, d = o & 255; const bf16_t* p = PQT + (size_t)(bg * 512 + d) * 2048 + F.lane * 32; float s = 0.f;
#pragma unroll
        for (int i = 0; i < 4; ++i) { float v[8]; unpack8(*(const u32x4*)(p + i * 8), v); s += (v[0] - v[1]) + (v[2] - v[3]) + (v[4] - v[5]) + (v[6] - v[7]); }
        s = wave_sum(s);
        if (F.lane == 0) y1024[(bg >> 2) * 1024 + (bg & 3) * 256 + d] = s * sc;
    }
}

__device__ __forceinline__ void assemble_phase(const Frame& F) {
    const float* agg = (const float*)(F.ws + WS_AGG);
    const bf16_t* S = (const bf16_t*)(F.ws + WS_S); const bf16_t* Pf = (const bf16_t*)(F.ws + WS_PF); const bf16_t* Pb = (const bf16_t*)(F.ws + WS_PB); const bf16_t* Ug = (const bf16_t*)(F.ws + WS_UG);
    const bf16_t* cp = (const bf16_t*)(F.ws + WS_CPSQ); const bf16_t* sq = cp + (size_t)8192 * 1024; const float* y1024 = (const float*)(F.ws + WS_Y1024);
    bf16_t* YA = (bf16_t*)(F.ws + WS_YA);
    LAS float* cf = (LAS float*)F.lds; LAS float* cb = cf + 1024;
    for (int L = F.bid; L < 256; L += F.G) {
        const int b = L >> 5, jc = L & 31, jj = jc + 4;
#pragma unroll
        for (int e = 0; e < 2; ++e) { const int ch = F.tid + 512 * e; const float* a0 = agg + (size_t)b * NCHUNK * 4096 + ch;
            float c = 0.f, c2 = 0.f;
#pragma unroll
            for (int i0 = 0; i0 < NCHUNK; i0 += 12) { float fa[12], fh[12], ba[12], bh[12];
#pragma unroll
                for (int k = 0; k < 12; ++k) { const int i = i0 + k; const int ib = i < 4 ? 3 - i : NCHUNK + 3 - i;
                    fa[k] = a0[(size_t)i * 4096]; fh[k] = a0[(size_t)i * 4096 + 1024]; ba[k] = a0[(size_t)ib * 4096 + 2048]; bh[k] = a0[(size_t)ib * 4096 + 3072]; }
#pragma unroll
                for (int k = 0; k < 12; ++k) { const int i = i0 + k; const int ib = i < 4 ? 3 - i : NCHUNK + 3 - i;
                    if (i < jj) c = fa[k] * c + fh[k];
                    if (ib < 4 || ib > jj) c2 = ba[k] * c2 + bh[k]; } }
            cf[ch] = c; cb[ch] = c2; }
        __syncthreads();
        const int row0 = b * SEQ + jc * 64;
        for (int i0 = 0; i0 < 16; i0 += 4) { u32x4 sw[4], fw[4], bw[4], gw[4];
#pragma unroll
            for (int k = 0; k < 4; ++k) { const int idx = F.tid + 512 * (i0 + k), row = idx >> 7, cg8 = idx & 127; const size_t go = (size_t)(row0 + row) * 1024 + cg8 * 8;
                sw[k] = *(const u32x4*)(S + go); fw[k] = *(const u32x4*)(Pf + go); bw[k] = *(const u32x4*)(Pb + go); gw[k] = *(const u32x4*)(Ug + go); }
#pragma unroll
            for (int k = 0; k < 4; ++k) { const int idx = F.tid + 512 * (i0 + k), row = idx >> 7, cg8 = idx & 127;
                float sv[8], pf[8], pb[8], ug[8], o[8]; unpack8(sw[k], sv); unpack8(fw[k], pf); unpack8(bw[k], pb); unpack8(gw[k], ug);
#pragma unroll
                for (int q = 0; q < 8; ++q) o[q] = (sv[q] + pf[q] * cf[cg8 * 8 + q] + pb[q] * cb[cg8 * 8 + q]) * gelu_tanh(ug[q]);
                *(u32x4*)(YA + (size_t)(row0 + row) * D + 1024 + cg8 * 8) = pack8(o); } }
        for (int i0 = 0; i0 < 32; i0 += 8) { u32x2 c4v[8], s4v[8];
#pragma unroll
            for (int k = 0; k < 8; ++k) { const int idx = F.tid + 512 * (i0 + k), row = idx >> 8, c4 = (idx & 255) * 4; const int kk = jc * 64 + row;
                const int ks = kk <= 1024 ? kk : 2048 - kk;
                const size_t o = (size_t)(b * 1024 + (ks < 1024 ? ks : 1023)) * 1024 + c4;
                c4v[k] = *(const u32x2*)(cp + o); s4v[k] = *(const u32x2*)(sq + o); }
#pragma unroll
            for (int k = 0; k < 8; ++k) { const int idx = F.tid + 512 * (i0 + k), row = idx >> 8, c4 = (idx & 255) * 4; const int kk = jc * 64 + row;
                const f32x4 cv = (f32x4){bf_lo(c4v[k].x), bf_hi(c4v[k].x), bf_lo(c4v[k].y), bf_hi(c4v[k].y)}, sv4 = (f32x4){bf_lo(s4v[k].x), bf_hi(s4v[k].x), bf_lo(s4v[k].y), bf_hi(s4v[k].y)};
                f32x4 y = kk < 1024 ? cv - sv4 : cv + sv4;
                if (kk == 1024) y = *(const f32x4*)(y1024 + b * 1024 + c4);
                y += *(const f32x4*)(F.in[I_BFOU] + c4);
                u32x2 w; w.x = cvt_pk_bf16(y[0], y[1]); w.y = cvt_pk_bf16(y[2], y[3]);
                *(u32x2*)(YA + (size_t)(row0 + row) * D + c4) = w; } }
        __syncthreads();
    }
}

__device__ __forceinline__ f32x4 ld_bf4(const bf16_t* p) { const u32x2 w = *(const u32x2*)p; return (f32x4){bf_lo(w.x), bf_hi(w.x), bf_lo(w.y), bf_hi(w.y)}; }
__device__ __forceinline__ void p7_norm2_staged(const Frame& F) {
    const float* pt = (const float*)(F.ws + WS_POS); const float* mod = (const float*)(F.ws + WS_MOD);
    const bf16_t* Y = (const bf16_t*)(F.ws + WS_Y); const float* rss = (const float*)(F.ws + WS_RSS1); bf16_t* H2 = (bf16_t*)(F.ws + WS_H2);
    const float* gpost = F.in[I_GMIXPOST]; const float* gpre = F.in[I_GFFNPRE];
    LAS float* L = (LAS float*)F.lds;
    for (int k0 = 0; k0 < NB; k0 += 2) {
        __syncthreads();
        for (int e = F.tid; e < 2 * 512; e += 512) { const int j = e >> 9, c4 = (e & 511) * 4; const float* mrow = mod + (size_t)(k0 + j) * 12288;
            *(LAS f32x4*)(L + (j * 3 + 0) * 2048 + c4) = *(const f32x4*)(mrow + 4096 + c4) * *(const f32x4*)(gpost + c4);
            *(LAS f32x4*)(L + (j * 3 + 1) * 2048 + c4) = (1.0f + *(const f32x4*)(mrow + 8192 + c4)) * *(const f32x4*)(gpre + c4);
            *(LAS f32x4*)(L + (j * 3 + 2) * 2048 + c4) = *(const f32x4*)(mrow + 6144 + c4); }
        __syncthreads();
        const int t = F.bid * 8 + F.wave;
        f32x4 v[2][8]; u32x2 yw[2][8]; float ssy[2], ss[2] = {0.f, 0.f};
#pragma unroll
        for (int j = 0; j < 2; ++j) { const int r = t + (k0 + j) * 2048; ssy[j] = F.lane < 32 ? rss[(size_t)r * 32 + F.lane] : 0.f;
#pragma unroll
            for (int i = 0; i < 8; ++i) { const int col = (i * 64 + F.lane) * 4; v[j][i] = *(const f32x4*)(F.in[I_X] + (size_t)r * D + col); yw[j][i] = *(const u32x2*)(Y + (size_t)r * D + col); } }
        f32x4 pp[8];
#pragma unroll
        for (int i = 0; i < 8; ++i) pp[i] = pos4(pt, t, (i * 64 + F.lane) * 4);
#pragma unroll
        for (int j = 0; j < 2; ++j) { const float rstdy = rsqrtf(wave_sum(ssy[j]) * (1.0f / D) + EPS);
#pragma unroll
            for (int i = 0; i < 8; ++i) { const int col = (i * 64 + F.lane) * 4;
                const f32x4 yv = (f32x4){bf_lo(yw[j][i].x), bf_hi(yw[j][i].x), bf_lo(yw[j][i].y), bf_hi(yw[j][i].y)};
                v[j][i] = v[j][i] + pp[i] + *(const LAS f32x4*)(L + (j * 3 + 0) * 2048 + col) * (yv * rstdy);
                ss[j] += v[j][i][0] * v[j][i][0] + v[j][i][1] * v[j][i][1] + v[j][i][2] * v[j][i][2] + v[j][i][3] * v[j][i][3]; } }
#pragma unroll
        for (int j = 0; j < 2; ++j) { const int r = t + (k0 + j) * 2048; const float rstd = rsqrtf(wave_sum(ss[j]) * (1.0f / D) + EPS);
#pragma unroll
            for (int i = 0; i < 8; ++i) { const int col = (i * 64 + F.lane) * 4;
                const f32x4 h = (v[j][i] * rstd) * *(const LAS f32x4*)(L + (j * 3 + 1) * 2048 + col) + *(const LAS f32x4*)(L + (j * 3 + 2) * 2048 + col);
                u32x2 w; w.x = cvt_pk_bf16(h[0], h[1]); w.y = cvt_pk_bf16(h[2], h[3]);
                *(u32x2*)(H2 + (size_t)r * D + col) = w; } }
    }
    __syncthreads();
}
__device__ __forceinline__ void p7_norm2(const Frame& F) {
    const float* pt = (const float*)(F.ws + WS_POS); const float* mod = (const float*)(F.ws + WS_MOD);
    const bf16_t* Y = (const bf16_t*)(F.ws + WS_Y); const float* rss = (const float*)(F.ws + WS_RSS1); bf16_t* H2 = (bf16_t*)(F.ws + WS_H2);
    const float* gpost = F.in[I_GMIXPOST]; const float* gpre = F.in[I_GFFNPRE];
    const int nw = F.G * 8;
    for (int r0 = F.bid * 8 + F.wave; r0 < MLAT; r0 += 2 * nw) {
        f32x4 v[2][8]; float ssy[2], ss[2] = {0.f, 0.f};
#pragma unroll
        for (int j = 0; j < 2; ++j) { const int r = r0 + j * nw < MLAT ? r0 + j * nw : r0; ssy[j] = F.lane < 32 ? rss[(size_t)r * 32 + F.lane] : 0.f; }
        u32x2 yw[2][8];
#pragma unroll
        for (int j = 0; j < 2; ++j) { const int r = r0 + j * nw < MLAT ? r0 + j * nw : r0;
#pragma unroll
            for (int i = 0; i < 8; ++i) { const int col = (i * 64 + F.lane) * 4; v[j][i] = *(const f32x4*)(F.in[I_X] + (size_t)r * D + col); yw[j][i] = *(const u32x2*)(Y + (size_t)r * D + col); } }
#pragma unroll
        for (int j = 0; j < 2; ++j) { const int r = r0 + j * nw < MLAT ? r0 + j * nw : r0; const int b = r >> 11, t = r & 2047; const float* mrow = mod + (size_t)b * 12288;
            const float rstdy = rsqrtf(wave_sum(ssy[j]) * (1.0f / D) + EPS);
#pragma unroll
            for (int i = 0; i < 8; ++i) { const int col = (i * 64 + F.lane) * 4;
                const f32x4 yv = (f32x4){bf_lo(yw[j][i].x), bf_hi(yw[j][i].x), bf_lo(yw[j][i].y), bf_hi(yw[j][i].y)}, gp = *(const f32x4*)(gpost + col), gt = *(const f32x4*)(mrow + 4096 + col);
                v[j][i] = v[j][i] + pos4(pt, t, col) + gt * (yv * rstdy * gp);
                ss[j] += v[j][i][0] * v[j][i][0] + v[j][i][1] * v[j][i][1] + v[j][i][2] * v[j][i][2] + v[j][i][3] * v[j][i][3]; } }
#pragma unroll
        for (int j = 0; j < 2; ++j) { const int r = r0 + j * nw; if (r >= MLAT) break; const int b = r >> 11; const float* mrow = mod + (size_t)b * 12288;
            const float rstd = rsqrtf(wave_sum(ss[j]) * (1.0f / D) + EPS);
#pragma unroll
            for (int i = 0; i < 8; ++i) { const int col = (i * 64 + F.lane) * 4; const f32x4 gg = *(const f32x4*)(gpre + col), sh = *(const f32x4*)(mrow + 6144 + col), sc = *(const f32x4*)(mrow + 8192 + col);
                const f32x4 h = (v[j][i] * rstd * gg) * (1.0f + sc) + sh; u32x2 w; w.x = cvt_pk_bf16(h[0], h[1]); w.y = cvt_pk_bf16(h[2], h[3]);
                *(u32x2*)(H2 + (size_t)r * D + col) = w; } }
    }
}

__device__ __forceinline__ void fixup_panel(const Frame& F, int pm) {
    const float* edge = (const float*)(F.ws + WS_EDGE); bf16_t* act = (bf16_t*)(F.ws + WS_ACT);
    const float* cw = F.in[I_CFW]; const float* cb = F.in[I_CFB];
    const int tb = pm & 7;
    for (int idx = F.tid; idx < 2 * 1408; idx += 512) {
        const int e = idx >= 1408, c = (idx - e * 1408) * 4;
        const f32x4 z = (f32x4){0.f, 0.f, 0.f, 0.f};
        f32x4 gp, gc, gn, vp, vc, vn;
        if (e == 0) { const float* pr = edge + ((size_t)(pm - 1) * 4 + 3) * DFF2; const float* cu = edge + ((size_t)pm * 4 + 0) * DFF2; const float* nx = edge + ((size_t)pm * 4 + 1) * DFF2;
            gp = tb ? *(const f32x4*)(pr + c) : z; vp = tb ? *(const f32x4*)(pr + DFF + c) : z; gc = *(const f32x4*)(cu + c); vc = *(const f32x4*)(cu + DFF + c); gn = *(const f32x4*)(nx + c); vn = *(const f32x4*)(nx + DFF + c); }
        else { const float* pr = edge + ((size_t)pm * 4 + 2) * DFF2; const float* cu = edge + ((size_t)pm * 4 + 3) * DFF2; const float* nx = edge + ((size_t)(pm + 1) * 4 + 0) * DFF2;
            gp = *(const f32x4*)(pr + c); vp = *(const f32x4*)(pr + DFF + c); gc = *(const f32x4*)(cu + c); vc = *(const f32x4*)(cu + DFF + c); gn = tb != 7 ? *(const f32x4*)(nx + c) : z; vn = tb != 7 ? *(const f32x4*)(nx + DFF + c) : z; }
        const f32x4 gg = *(const f32x4*)(cb + c) + *(const f32x4*)(cw + c) * gp + *(const f32x4*)(cw + DFF2 + c) * gc + *(const f32x4*)(cw + 2 * DFF2 + c) * gn;
        const f32x4 vv = *(const f32x4*)(cb + DFF + c) + *(const f32x4*)(cw + DFF + c) * vp + *(const f32x4*)(cw + DFF2 + DFF + c) * vc + *(const f32x4*)(cw + 2 * DFF2 + DFF + c) * vn;
        u32x2 w; w.x = cvt_pk_bf16(gelu_tanh(gg[0]) * vv[0], gelu_tanh(gg[1]) * vv[1]); w.y = cvt_pk_bf16(gelu_tanh(gg[2]) * vv[2], gelu_tanh(gg[3]) * vv[3]);
        *(u32x2*)(act + (size_t)(pm * 256 + (e ? 255 : 0)) * DFF + c) = w;
    }
}

__device__ __forceinline__ void final_phase_staged(const Frame& F) {
    const float* pt = (const float*)(F.ws + WS_POS); const float* mod = (const float*)(F.ws + WS_MOD);
    const bf16_t* Y = (const bf16_t*)(F.ws + WS_Y); const bf16_t* Y2 = (const bf16_t*)(F.ws + WS_Y2);
    const float* rss1 = (const float*)(F.ws + WS_RSS1); const float* rss2 = (const float*)(F.ws + WS_RSS2);
    const float* gpost1 = F.in[I_GMIXPOST]; const float* gpost2 = F.in[I_GFFNPOST];
    LAS float* L = (LAS float*)F.lds;
    for (int k0 = 0; k0 < NB; k0 += 2) {
        __syncthreads();
        for (int e = F.tid; e < 2 * 512; e += 512) { const int j = e >> 9, c4 = (e & 511) * 4; const float* mrow = mod + (size_t)(k0 + j) * 12288;
            *(LAS f32x4*)(L + (j * 2 + 0) * 2048 + c4) = *(const f32x4*)(mrow + 4096 + c4) * *(const f32x4*)(gpost1 + c4);
            *(LAS f32x4*)(L + (j * 2 + 1) * 2048 + c4) = *(const f32x4*)(mrow + 10240 + c4) * *(const f32x4*)(gpost2 + c4); }
        __syncthreads();
        const int t = F.bid * 8 + F.wave;
        f32x4 xv[2][8]; u32x2 y1[2][8], y2[2][8]; float s1[2], s2[2];
#pragma unroll
        for (int j = 0; j < 2; ++j) { const int r = t + (k0 + j) * 2048; s1[j] = F.lane < 32 ? rss1[(size_t)r * 32 + F.lane] : 0.f; s2[j] = F.lane < 32 ? rss2[(size_t)r * 32 + F.lane] : 0.f;
#pragma unroll
            for (int i = 0; i < 8; ++i) { const int col = (i * 64 + F.lane) * 4; xv[j][i] = *(const f32x4*)(F.in[I_X] + (size_t)r * D + col); y1[j][i] = *(const u32x2*)(Y + (size_t)r * D + col); y2[j][i] = *(const u32x2*)(Y2 + (size_t)r * D + col); } }
        f32x4 pp[8];
#pragma unroll
        for (int i = 0; i < 8; ++i) pp[i] = pos4(pt, t, (i * 64 + F.lane) * 4);
#pragma unroll
        for (int j = 0; j < 2; ++j) { const int r = t + (k0 + j) * 2048;
            const float rstd1 = rsqrtf(wave_sum(s1[j]) * (1.0f / D) + EPS), rstd2 = rsqrtf(wave_sum(s2[j]) * (1.0f / D) + EPS);
#pragma unroll
            for (int i = 0; i < 8; ++i) { const int col = (i * 64 + F.lane) * 4;
                const f32x4 a1 = (f32x4){bf_lo(y1[j][i].x), bf_hi(y1[j][i].x), bf_lo(y1[j][i].y), bf_hi(y1[j][i].y)}, a2 = (f32x4){bf_lo(y2[j][i].x), bf_hi(y2[j][i].x), bf_lo(y2[j][i].y), bf_hi(y2[j][i].y)};
                __builtin_nontemporal_store(xv[j][i] + pp[i] + *(const LAS f32x4*)(L + (j * 2 + 0) * 2048 + col) * (a1 * rstd1) + *(const LAS f32x4*)(L + (j * 2 + 1) * 2048 + col) * (a2 * rstd2), (f32x4*)(F.out + (size_t)r * D + col)); } }
    }
    __syncthreads();
}
__device__ __forceinline__ void final_phase(const Frame& F) {
    const float* pt = (const float*)(F.ws + WS_POS); const float* mod = (const float*)(F.ws + WS_MOD);
    const bf16_t* Y = (const bf16_t*)(F.ws + WS_Y); const bf16_t* Y2 = (const bf16_t*)(F.ws + WS_Y2);
    const float* rss1 = (const float*)(F.ws + WS_RSS1); const float* rss2 = (const float*)(F.ws + WS_RSS2);
    const float* gpost1 = F.in[I_GMIXPOST]; const float* gpost2 = F.in[I_GFFNPOST];
    for (int r = F.bid * 8 + F.wave; r < MLAT; r += F.G * 8) {
        const int b = r >> 11, t = r & 2047; const float* mrow = mod + (size_t)b * 12288;
        float s1 = F.lane < 32 ? rss1[(size_t)r * 32 + F.lane] : 0.f, s2 = F.lane < 32 ? rss2[(size_t)r * 32 + F.lane] : 0.f;
        s1 = wave_sum(s1); s2 = wave_sum(s2);
        const float rstd1 = rsqrtf(s1 * (1.0f / D) + EPS), rstd2 = rsqrtf(s2 * (1.0f / D) + EPS);
#pragma unroll
        for (int i = 0; i < 8; ++i) { const int col = (i * 64 + F.lane) * 4;
            const f32x4 xv = *(const f32x4*)(F.in[I_X] + (size_t)r * D + col) + pos4(pt, t, col);
            const f32x4 y1 = ld_bf4(Y + (size_t)r * D + col), y2 = ld_bf4(Y2 + (size_t)r * D + col);
            const f32x4 g1 = *(const f32x4*)(gpost1 + col), g2 = *(const f32x4*)(gpost2 + col), gt1 = *(const f32x4*)(mrow + 4096 + col), gt2 = *(const f32x4*)(mrow + 10240 + col);
            __builtin_nontemporal_store(xv + gt1 * (y1 * rstd1 * g1) + gt2 * (y2 * rstd2 * g2), (f32x4*)(F.out + (size_t)r * D + col)); }
    }
}

constexpr int N_PHASES = 13;
__global__ void __launch_bounds__(512, 2) hybrid_fwd(Args args) {
    extern __shared__ __attribute__((aligned(16))) unsigned char lds_raw[];
    Frame F; F.in = args.in; F.out = args.out; F.ws = args.ws; F.lds = (LAS unsigned char*)lds_raw;
    F.tid = threadIdx.x; F.lane = F.tid & 63; F.wave = __builtin_amdgcn_readfirstlane(F.tid >> 6); F.G = gridDim.x; F.bid = blockIdx.x;
    const int lo = args.ph_lo, hi = args.ph_hi;
#ifndef DUP_PHASE
#define DUP_PHASE -1
#endif
#define NREP(k) ((k) == DUP_PHASE ? 2 : 1)
#define IN(k) (lo <= (k) && (k) < hi)
#define SEAM(k) do { if (IN(k) && IN((k) + 1)) xcd_barrier(bar); } while (0)
    unsigned char* ws = args.ws;
    if (lo < 0) cg::this_grid().sync();
    if (F.tid < 16) ((LAS unsigned*)(F.lds + LDS_BAR))[F.tid] = 0u;
    __syncthreads();
    XcdBarrier bar; bar.bar = (unsigned*)ws; bar.x = 0; bar.st = (volatile LAS unsigned*)(F.lds + LDS_BAR);
    if (hi - lo > 1) bar = xcd_barrier_post((unsigned*)ws, (volatile LAS unsigned*)(F.lds + LDS_BAR));
    if (IN(0)) for (int rep_ = 0; rep_ < NREP(0); ++rep_) p0_prologue(F);
    SEAM(0);
    if (IN(1)) p1_norm(F, MLAT, MALL, 0, F.G);
    SEAM(1);
    if (IN(2)) {
        if (F.G >= 64) {
            if (F.bid < 32) { pg8::Gemm g{D, D, D, (size_t)128 * D * 2, (size_t)128 * D * 2};
                SchedWin S{(const bf16_t*)(ws + WS_H), (const bf16_t*)(ws + WS_WIN), 32, F.bid, 768, 800};
                EpiWin E{(bf16_t*)(ws + WS_UF)};
                pg8::gemm_phase(F.lds, g, S, E); }
            else if (((F.G - 32) & 7) == 0) p1_latent_staged(F, 32, F.G - 32); else p1_norm(F, 0, MLAT, 32, F.G - 32);
        } else { p1_norm(F, 0, MLAT, 0, F.G); }
    }
    SEAM(2);
    if (IN(3)) for (int rep_ = 0; rep_ < NREP(3); ++rep_) { pg8::Gemm g{D, D, D, (size_t)128 * D * 2, (size_t)128 * D * 2};
        SchedWin S{(const bf16_t*)(ws + WS_H), (const bf16_t*)(ws + WS_WIN), F.G, F.bid, 0, F.G >= 64 ? 768 : 800};
        EpiWin E{(bf16_t*)(ws + WS_UF)};
        pg8::gemm_phase(F.lds, g, S, E); }
    SEAM(3);
    if (IN(4)) { { pg8::Gemm g{256, 1024, 256, (size_t)128 * 256 * 2, (size_t)128 * 1024 * 2};
        SchedPQ S{(const bf16_t*)(ws + WS_WCS), (const bf16_t*)(ws + WS_UF), F.G, F.bid};
        EpiPQ E{(bf16_t*)(ws + WS_PQT)};
        pg8::gemm_phase(F.lds, g, S, E); }
        lru_phase(F); if (DUP_PHASE == 4) lru_phase(F); }
    SEAM(4);
    if (IN(5)) for (int rep_ = 0; rep_ < NREP(5); ++rep_) { pg8::Gemm g{2048, 2048, 2048, (size_t)128 * 2048 * 2, (size_t)128 * 2048 * 2};
        SchedDFT S{(const bf16_t*)(ws + WS_CTAB), (const bf16_t*)(ws + WS_STAB), (const bf16_t*)(ws + WS_PQT), F.G, F.bid};
        EpiDFT E{(bf16_t*)(ws + WS_CPSQ)};
        pg8::gemm_phase(F.lds, g, S, E);
        alt_phase(F); }
    SEAM(5);
    if (IN(6)) for (int rep_ = 0; rep_ < NREP(6); ++rep_) assemble_phase(F);
    SEAM(6);
    if (IN(7)) for (int rep_ = 0; rep_ < NREP(7); ++rep_) { pg8::Gemm g{D, D, D, (size_t)128 * D * 2, (size_t)128 * D * 2};
        SchedStd S{(const bf16_t*)(ws + WS_YA), (const bf16_t*)(ws + WS_WOUT), 64, 8, D, D, F.G, F.bid, OUTREP};
        EpiY E{(bf16_t*)(ws + WS_Y), (float*)(ws + WS_RSS1)};
        pg8::gemm_phase(F.lds, g, S, E); }
    SEAM(7);
    if (IN(8)) for (int rep_ = 0; rep_ < NREP(8); ++rep_) { if (F.G == 256) p7_norm2_staged(F); else p7_norm2(F); }
    SEAM(8);
    if (IN(9)) for (int rep_ = 0; rep_ < NREP(9); ++rep_) { pg8::Gemm g{D, D, D, (size_t)128 * D * 2, (size_t)DFF * D * 2};
        if (F.tid < 256) { ((LAS float*)(F.lds + LDS_EDGE))[F.tid] = 0.f; ((LAS float*)(F.lds + LDS_EDGE))[9 * 256 + F.tid] = 0.f; }
        __syncthreads();
        SchedUp S{(const bf16_t*)(ws + WS_H2), (const bf16_t*)(ws + WS_WUP), F.G, F.bid};
        EpiUpConv E{(bf16_t*)(ws + WS_ACT), (float*)(ws + WS_EDGE), F.in[I_CFW], F.in[I_CFB], F.lds};
        pg8::gemm_phase(F.lds, g, S, E); }
    if (IN(9) && IN(11)) xcd_barrier(bar);
    if (IN(11)) for (int rep_ = 0; rep_ < NREP(11); ++rep_) { pg8::Gemm g{DFF, DFF, DFF, (size_t)128 * DFF * 2, (size_t)128 * DFF * 2};
        SchedStd S{(const bf16_t*)(ws + WS_ACT), (const bf16_t*)(ws + WS_WDOWN), 64, 8, DFF, DFF, F.G, F.bid, DOWNREP};
        { pg8::Unit u; int last = -1;
          for (int i = 0; S.next(i, u); ++i) if (u.pm != last) { fixup_panel(F, u.pm); last = u.pm; }
          asm volatile("s_waitcnt vmcnt(0)" ::: "memory"); __syncthreads(); }
        EpiY E{(bf16_t*)(ws + WS_Y2), (float*)(ws + WS_RSS2)};
        pg8::gemm_phase(F.lds, g, S, E); }
    SEAM(11);
    if (IN(12)) for (int rep_ = 0; rep_ < NREP(12); ++rep_) { if (F.G == 256) final_phase_staged(F); else final_phase(F); }
#undef IN
#undef SEAM
}

extern "C" void kernel_launch(void* const* d_in, const int* in_sizes, int n_in, void* d_out, int out_size, void* d_ws, size_t ws_size, hipStream_t stream) {
    static int grid = 0;
    if (grid == 0) {
        if (n_in != 25 || out_size != MLAT * D || ws_size < WS_NEED) { fprintf(stderr, "kernel_launch: unexpected shapes n_in %d out %d ws %zu\n", n_in, out_size, ws_size); grid = -1; return; }
        int dev = 0, cus = 0, per_cu = 0;
        hipGetDevice(&dev); hipDeviceGetAttribute(&cus, hipDeviceAttributeMultiprocessorCount, dev);
        if (hipFuncSetAttribute((const void*)hybrid_fwd, hipFuncAttributeMaxDynamicSharedMemorySize, LDS_BYTES) != hipSuccess) { fprintf(stderr, "kernel_launch: hipFuncSetAttribute failed\n"); grid = -1; return; }
        if (hipOccupancyMaxActiveBlocksPerMultiprocessor(&per_cu, (const void*)hybrid_fwd, 512, LDS_BYTES) != hipSuccess || per_cu < 1) { fprintf(stderr, "kernel_launch: occupancy query failed (%d)\n", per_cu); (void)hipGetLastError(); per_cu = 1; }
        grid = cus * 1;
        if (grid % 8 != 0 || grid <= 0) grid = (grid / 8) * 8;
        fprintf(stderr, "kernel_launch: cus %d per_cu %d grid %d\n", cus, per_cu, grid);
    }
    if (grid <= 0) return;
    if (hipMemsetAsync(d_ws, 0, XCD_BAR_WORDS * 4, stream) != hipSuccess) { fprintf(stderr, "kernel_launch: memset of barrier words failed\n"); return; }
    Args a{};
    for (int i = 0; i < 25; ++i) a.in[i] = (const float*)d_in[i];
    a.out = (float*)d_out; a.ws = (unsigned char*)d_ws;
#if N_LAUNCH_MODE == 1
    a.ph_lo = 0; a.ph_hi = N_PHASES;
    void* kargs[] = {&a};
    hipError_t e = hipLaunchCooperativeKernel((const void*)hybrid_fwd, dim3(grid), dim3(512), kargs, LDS_BYTES, stream);
    if (e != hipSuccess) fprintf(stderr, "cooperative launch failed: %s (grid %d)\n", hipGetErrorString(e), grid);
#else
    for (int p = 0; p < N_PHASES; ++p) { a.ph_lo = p; a.ph_hi = p + 1; hipLaunchKernelGGL(hybrid_fwd, dim3(grid), dim3(512), LDS_BYTES, stream, a); }
#endif
}
```

```cpp
#include <hip/hip_runtime.h>
#include <hip/hip_cooperative_groups.h>
#include <cstdio>
#include <cstdint>
namespace cg = cooperative_groups;

#ifndef N_LAUNCH_MODE
#define N_LAUNCH_MODE 1
#endif

#define LAS __attribute__((address_space(3)))
typedef unsigned short bf16_t;
typedef short bf16x8 __attribute__((ext_vector_type(8)));
typedef float f32x4 __attribute__((ext_vector_type(4)));
typedef float f32x2 __attribute__((ext_vector_type(2)));
typedef unsigned u32x4 __attribute__((ext_vector_type(4)));
typedef unsigned u32x2 __attribute__((ext_vector_type(2)));

constexpr int D = 2048, NB = 8, SEQ = 2048, CTXL = 256, DFF = 5632, DFF2 = 11264;
constexpr int MLAT = NB * SEQ, MCTX = NB * CTXL, MALL = MLAT + MCTX;
constexpr int DLRU = 1024, DFOU = 1024, NPROJ = 3072;
constexpr int NCHUNK = 36;
constexpr float EPS = 1e-6f;

constexpr size_t MiB = 1u << 20;
constexpr size_t WS_MOD = 1 * MiB;
constexpr size_t WS_POS = 2 * MiB;
constexpr size_t WS_RSS1 = 3 * MiB;
constexpr size_t WS_RSS2 = 5 * MiB;
constexpr size_t WS_AGG = 7 * MiB;
constexpr size_t WS_Y1024 = 11 * MiB + 512 * 1024;
constexpr size_t WS_K2 = 11 * MiB + 768 * 1024;
constexpr size_t WS_WUP = 12 * MiB;
constexpr size_t WS_WDOWN = 56 * MiB;
constexpr size_t WS_WIN = 78 * MiB;
constexpr size_t WS_WOUT = 90 * MiB;
constexpr size_t WS_CTAB = 98 * MiB;
constexpr size_t WS_STAB = 102 * MiB;
constexpr size_t WS_WG = 106 * MiB;
constexpr size_t WS_WCS = 107 * MiB;
constexpr size_t WS_H = 108 * MiB;
constexpr size_t WS_UF = 180 * MiB;
constexpr size_t WS_UX = 212 * MiB;
constexpr size_t WS_UG = 248 * MiB;
constexpr size_t WS_S = 280 * MiB;
constexpr size_t WS_PF = 312 * MiB;
constexpr size_t WS_PB = 344 * MiB;
constexpr size_t WS_PQT = 108 * MiB;
constexpr size_t WS_CPSQ = 376 * MiB;
constexpr size_t WS_YA = 108 * MiB;
constexpr size_t WS_Y = 384 * MiB;
constexpr size_t WS_H2 = 78 * MiB;
constexpr size_t WS_ACT = 142 * MiB;
constexpr size_t WS_EDGE = 318 * MiB;
constexpr size_t WS_Y2 = 448 * MiB;
constexpr size_t WS_NEED = 512 * MiB;

constexpr int LDS_BAR = 152576;
constexpr int LDS_BYTES = 152576 + 64;
static_assert(WS_UX - WS_UF == 32 * MiB && WS_UG - WS_UF == 68 * MiB && WS_STAB - WS_CTAB == 4 * MiB, "pointer arithmetic in EpiWin / SchedDFT");

#define LDS_BARRIER() do { asm volatile("s_waitcnt lgkmcnt(0)" ::: "memory"); __builtin_amdgcn_s_barrier(); asm volatile("" ::: "memory"); } while (0)
__device__ __forceinline__ unsigned cvt_pk_bf16(float lo, float hi) { unsigned r; asm volatile("v_cvt_pk_bf16_f32 %0, %1, %2" : "=v"(r) : "v"(lo), "v"(hi)); return r; }
__device__ __forceinline__ float bf_lo(unsigned w) { return __uint_as_float(w << 16); }
__device__ __forceinline__ float bf_hi(unsigned w) { return __uint_as_float(w & 0xffff0000u); }
__device__ __forceinline__ float fast_sigmoid(float z) { return __builtin_amdgcn_rcpf(1.0f + __builtin_amdgcn_exp2f(-1.44269504f * z)); }
__device__ __forceinline__ float gelu_tanh(float x) { const float u = x * (1.0f + 0.044715f * x * x); return x * __builtin_amdgcn_rcpf(1.0f + __builtin_amdgcn_exp2f(-2.302208198f * u)); }
__device__ __forceinline__ float wave_sum(float v) { for (int o = 32; o >= 1; o >>= 1) v += __shfl_xor(v, o); return v; }
__device__ __forceinline__ u32x4 pack8(const float (&v)[8]) { u32x4 w; w.x = cvt_pk_bf16(v[0], v[1]); w.y = cvt_pk_bf16(v[2], v[3]); w.z = cvt_pk_bf16(v[4], v[5]); w.w = cvt_pk_bf16(v[6], v[7]); return w; }
__device__ __forceinline__ void unpack8(const u32x4 w, float (&v)[8]) { v[0] = bf_lo(w.x); v[1] = bf_hi(w.x); v[2] = bf_lo(w.y); v[3] = bf_hi(w.y); v[4] = bf_lo(w.z); v[5] = bf_hi(w.z); v[6] = bf_lo(w.w); v[7] = bf_hi(w.w); }

namespace pg8 {
constexpr int BM = 256, BK = 64, HALF = 128, HTB = HALF * BK * 2, STAGE_BYTES = 8 * HTB, NXCD = 8;
__host__ __device__ __forceinline__ int lds_byte(int r, int c) { const int st = (r >> 4) * 2 + (c >> 5), rr = r & 15, cc = c & 31, ob = rr * 64 + cc * 2; return st * 1024 + (ob ^ (((ob >> 9) & 1) << 5)); }
__host__ __device__ __forceinline__ void stage_rc(int b, int& R, int& C) { const int st = b / 1024, sb = b % 1024, swz = sb ^ (((sb >> 9) & 1) << 5); R = (st >> 1) * 16 + swz / 64; C = (st & 1) * 32 + (swz % 64) / 2; }
__host__ __device__ __forceinline__ int perm32(int rho) { const int n = rho >> 4, i = rho & 15; return 8 * (i >> 2) + 4 * n + (i & 3); }

struct Unit { int pm, pn, z; };
struct Gemm { int lda, ldb, K; size_t hstepA, hstepB; };

__device__ __forceinline__ void std_order(int L, int nM, int nN, int& pm, int& pn, const int WGM = 8) {
    const int nwg = nM * nN; int wgid = L;
    { const int q = nwg / NXCD, r = nwg % NXCD, xcd = wgid % NXCD, off = wgid / NXCD; wgid = (xcd < r ? xcd * (q + 1) : r * (q + 1) + (xcd - r) * q) + off; }
    const int nig = WGM * nN, gid = wgid / nig, fm = gid * WGM, gsz = (nM - fm) < WGM ? (nM - fm) : WGM;
    pm = fm + ((wgid % nig) % gsz); pn = (wgid % nig) / gsz;
}

__device__ __forceinline__ void store_tile_bf16(const f32x4 (&acc)[2][2][4][2], bf16_t* tile, size_t ldc, int wr, int wc, int fr, int fq) {
    bf16_t* p0 = tile + (size_t)(wr * 64 + fr) * ldc + wc * 32 + 8 * fq;
#pragma unroll
    for (int ai = 0; ai < 2; ++ai)
#pragma unroll
        for (int m = 0; m < 4; ++m) { bf16_t* rowp = p0 + (size_t)(ai * HALF + m * 16) * ldc;
#pragma unroll
            for (int bj = 0; bj < 2; ++bj) { const f32x4 v0 = acc[ai][bj][m][0], v1 = acc[ai][bj][m][1];
                u32x4 w; w.x = cvt_pk_bf16(v0[0], v0[1]); w.y = cvt_pk_bf16(v0[2], v0[3]); w.z = cvt_pk_bf16(v1[0], v1[1]); w.w = cvt_pk_bf16(v1[2], v1[3]);
                *(u32x4*)(rowp + bj * HALF) = w; } }
}
__device__ __forceinline__ void store_tile_f32(const f32x4 (&acc)[2][2][4][2], float* tile, size_t ldc, int wr, int wc, int fr, int fq) {
    float* p0 = tile + (size_t)(wr * 64 + fr) * ldc + wc * 32 + 4 * fq;
#pragma unroll
    for (int ai = 0; ai < 2; ++ai)
#pragma unroll
        for (int m = 0; m < 4; ++m) { float* rowp = p0 + (size_t)(ai * HALF + m * 16) * ldc;
#pragma unroll
            for (int bj = 0; bj < 2; ++bj)
#pragma unroll
                for (int n = 0; n < 2; ++n) *(f32x4*)(rowp + bj * HALF + n * 16) = acc[ai][bj][m][n]; }
}

template <class Epi, class Sched>
__device__ __forceinline__ void gemm_phase(LAS unsigned char* lds, const Gemm g, const Sched& S, const Epi& E) {
    const int tid = threadIdx.x, wid = __builtin_amdgcn_readfirstlane(tid >> 6), lane = tid & 63, wr = wid >> 2, wc = wid & 3, fr = lane & 15, fq = lane >> 4;
    const int K = g.K, nt = K / BK;
    unsigned voffA[2], voffB[2];
#pragma unroll
    for (int i = 0; i < 2; ++i) { int R, C; stage_rc(tid * 16 + i * 8192, R, C); const int Rb = Epi::PERM ? ((R & ~31) + perm32(R & 31)) : R;
        const int Ra = Epi::PERMA ? ((R & ~63) + 4 * (R & 15) + ((R >> 4) & 3)) : R;
        voffA[i] = (unsigned)(Ra * g.lda + C) * 2u; voffB[i] = (unsigned)(Rb * g.ldb + C) * 2u; }
    const size_t kstep = (size_t)(BK * 2);
    const size_t hstepA = g.hstepA, hstepB = g.hstepB;
    const unsigned ldsw = (unsigned)wid * 1024u;
    const int aoff = lds_byte(wr * 64 + fr, fq * 8), boff = lds_byte(wc * 32 + fr, fq * 8);
#define PG8_SA(b, h) (((b) * 2 + (h)) * HTB)
#define PG8_SB(b, h) ((4 + (b) * 2 + (h)) * HTB)
#define PG8_STAGE(bufoff, gbase, voff) do { _Pragma("unroll") for (int _i = 0; _i < 2; ++_i) \
        __builtin_amdgcn_global_load_lds((const unsigned*)((const char*)(gbase) + (voff)[_i]), (LAS unsigned*)(lds + (bufoff) + ldsw + _i * 8192), 16, 0, 0); } while (0)
#define PG8_LDA(dst, b, h) do { _Pragma("unroll") for (int m = 0; m < 4; ++m) _Pragma("unroll") for (int k = 0; k < 2; ++k) dst[m][k] = *(const LAS bf16x8*)(lds + PG8_SA(b, h) + aoff + m * 2048 + k * 1024); } while (0)
#define PG8_LDB(dst, b, h) do { _Pragma("unroll") for (int n = 0; n < 2; ++n) _Pragma("unroll") for (int k = 0; k < 2; ++k) dst[n][k] = *(const LAS bf16x8*)(lds + PG8_SB(b, h) + boff + n * 2048 + k * 1024); } while (0)
#define PG8_MMA(ai, bj, At, Bt) do { __builtin_amdgcn_s_setprio(1); _Pragma("unroll") for (int m = 0; m < 4; ++m) _Pragma("unroll") for (int n = 0; n < 2; ++n) _Pragma("unroll") for (int k = 0; k < 2; ++k) \
        acc[ai][bj][m][n] = __builtin_amdgcn_mfma_f32_16x16x32_bf16(Bt[n][k], At[m][k], acc[ai][bj][m][n], 0, 0, 0); __builtin_amdgcn_s_setprio(0); } while (0)
#define PG8_WAIT_V(n) asm volatile("s_waitcnt vmcnt(" #n ")" ::: "memory")
#define PG8_WAIT_L(n) asm volatile("s_waitcnt lgkmcnt(" #n ")" ::: "memory")
#define PG8_BAR __builtin_amdgcn_s_barrier()
#define PG8_SCHED __builtin_amdgcn_sched_barrier(0)
    Unit cur, nxt; int ui = 0;
    if (!S.next(0, cur)) return;
    f32x4 acc[2][2][4][2];
#pragma unroll
    for (int a = 0; a < 2; ++a)
#pragma unroll
        for (int b = 0; b < 2; ++b)
#pragma unroll
            for (int m = 0; m < 4; ++m)
#pragma unroll
                for (int n = 0; n < 2; ++n) acc[a][b][m][n] = (f32x4){0.f, 0.f, 0.f, 0.f};
    bf16x8 At[4][2], B0[2][2], B1[2][2];
    const char* cA; const char* cB; S.ptrs(cur, cA, cB);
    PG8_STAGE(PG8_SB(0, 0), cB, voffB); PG8_STAGE(PG8_SB(0, 1), cB + hstepB, voffB); PG8_STAGE(PG8_SA(0, 0), cA, voffA); PG8_STAGE(PG8_SA(0, 1), cA + hstepA, voffA);
    if (wr == 1) PG8_BAR;
    PG8_WAIT_V(2); PG8_BAR;
    PG8_STAGE(PG8_SB(1, 0), cB + kstep, voffB); PG8_STAGE(PG8_SA(1, 0), cA + kstep, voffA); PG8_STAGE(PG8_SB(1, 1), cB + hstepB + kstep, voffB);
    PG8_WAIT_V(6); PG8_BAR;
    for (;;) {
        const bool has_next = S.next(ui + 1, nxt);
        const char* nA = cA; const char* nB = cB; if (has_next) S.ptrs(nxt, nA, nB);
#pragma unroll 1
        for (int t = 0; t < nt; t += 2) {
            const bool last = (t == nt - 2);
            const char* a1 = cA + (size_t)(t + 1) * kstep;
            const char* a2 = last ? nA : cA + (size_t)(t + 2) * kstep; const char* b2 = last ? nB : cB + (size_t)(t + 2) * kstep;
            const char* a3 = a2 + kstep; const char* b3 = b2 + kstep;
            PG8_LDB(B0, 0, 0); PG8_LDB(B1, 0, 1); PG8_SCHED; PG8_LDA(At, 0, 0); PG8_STAGE(PG8_SA(1, 1), a1 + hstepA, voffA);
            PG8_WAIT_V(8); PG8_WAIT_L(0); PG8_BAR; PG8_MMA(0, 0, At, B0); PG8_MMA(0, 1, At, B1); PG8_BAR; PG8_SCHED;
            PG8_LDA(At, 0, 1); PG8_STAGE(PG8_SB(0, 0), b2, voffB); PG8_STAGE(PG8_SB(0, 1), b2 + hstepB, voffB); PG8_STAGE(PG8_SA(0, 0), a2, voffA);
            PG8_WAIT_V(8); PG8_WAIT_L(0); PG8_BAR; PG8_MMA(1, 0, At, B0); PG8_MMA(1, 1, At, B1); PG8_BAR; PG8_SCHED;
            PG8_LDB(B0, 1, 0); PG8_LDB(B1, 1, 1); PG8_SCHED; PG8_LDA(At, 1, 0); PG8_STAGE(PG8_SA(0, 1), a2 + hstepA, voffA);
            PG8_WAIT_V(8); PG8_WAIT_L(0); PG8_BAR; PG8_MMA(0, 0, At, B0); PG8_MMA(0, 1, At, B1); PG8_BAR; PG8_SCHED;
            PG8_LDA(At, 1, 1); PG8_STAGE(PG8_SB(1, 0), b3, voffB); PG8_STAGE(PG8_SB(1, 1), b3 + hstepB, voffB); PG8_STAGE(PG8_SA(1, 0), a3, voffA);
            PG8_WAIT_V(8); PG8_WAIT_L(0); PG8_BAR; PG8_MMA(1, 0, At, B0); PG8_MMA(1, 1, At, B1); PG8_BAR; PG8_SCHED;
        }
        if (wr == 0) PG8_BAR;
        E(acc, cur, wr, wc, fr, fq);
        if (!has_next) break;
#pragma unroll
        for (int a = 0; a < 2; ++a)
#pragma unroll
            for (int b = 0; b < 2; ++b)
#pragma unroll
                for (int m = 0; m < 4; ++m)
#pragma unroll
                    for (int n = 0; n < 2; ++n) acc[a][b][m][n] = (f32x4){0.f, 0.f, 0.f, 0.f};
        cur = nxt; cA = nA; cB = nB; ++ui;
        if (wr == 1) PG8_BAR;
    }
    PG8_WAIT_V(0);
    PG8_BAR;
#undef PG8_SA
#undef PG8_SB
#undef PG8_STAGE
#undef PG8_LDA
#undef PG8_LDB
#undef PG8_MMA
#undef PG8_WAIT_V
#undef PG8_WAIT_L
#undef PG8_BAR
#undef PG8_SCHED
}
}

#define XB_TMO      128
#define XB_XCNT(j)  (256  + 64 * (j))
#define XB_XSUB(j)  (1280 + 64 * (j))
#define XB_XGEN(j)  (2304 + 64 * (j))
#define XB_TOP      3328
#define XB_TOPGEN   3392
#define XCD_BAR_WORDS 3456
#define XB_SPIN_CAP (1u << 18)
__device__ __forceinline__ unsigned xb_ld(unsigned* p)              { return __hip_atomic_load(p, __ATOMIC_RELAXED, __HIP_MEMORY_SCOPE_AGENT); }
__device__ __forceinline__ unsigned xb_add(unsigned* p, unsigned v) { return __hip_atomic_fetch_add(p, v, __ATOMIC_RELAXED, __HIP_MEMORY_SCOPE_AGENT); }
__device__ __forceinline__ unsigned xb_xcc_id() { return (unsigned)__builtin_amdgcn_s_getreg((3 << 11) | 20) & 0xFu; }
#define XB_SPIN(cond, bar) do { unsigned _sp = 0; while (cond) { __builtin_amdgcn_s_sleep(1); \
    if ((++_sp & 255u) == 0u) { if (xb_ld(&(bar)[XB_TMO])) break; if (_sp > XB_SPIN_CAP) { atomicAdd(&(bar)[XB_TMO], 1u); break; } } } } while (0)
struct XcdBarrier { unsigned* bar; unsigned x; volatile LAS unsigned* st; };
__device__ __forceinline__ XcdBarrier xcd_barrier_post(unsigned* bar, volatile LAS unsigned* st) {
    XcdBarrier b; b.bar = bar; b.x = xb_xcc_id(); b.st = st;
    if (threadIdx.x == 0) (void)xb_add(&bar[XB_XCNT(b.x)], 1u);
    return b;
}
__device__ __forceinline__ void xcd_barrier_complete(unsigned* bar, unsigned x, unsigned& nloc, unsigned& nx) {
    const unsigned G = gridDim.x * gridDim.y * gridDim.z;
    unsigned sum, cnt, mine, sp = 0u;
    for (;;) {
        sum = 0u; cnt = 0u; mine = 0u;
#pragma unroll
        for (unsigned j = 0; j < 16; ++j) { const unsigned c = xb_ld(&bar[XB_XCNT(j)]); sum += c; cnt += (c > 0u) ? 1u : 0u; mine = (j == x) ? c : mine; }
        if (sum == G) break;
        __builtin_amdgcn_s_sleep(1);
        if ((++sp & 255u) == 0u) { if (xb_ld(&bar[XB_TMO])) break; if (sp > XB_SPIN_CAP) { atomicAdd(&bar[XB_TMO], 1u); break; } }
    }
    nloc = mine > 0u ? mine : 1u; nx = cnt > 0u ? cnt : 1u;
}
__device__ __forceinline__ void xcd_barrier(const XcdBarrier& b) {
    asm volatile("s_waitcnt vmcnt(0)" ::: "memory");
    __syncthreads();
    if (threadIdx.x == 0) {
        unsigned* bar = b.bar;
        __builtin_amdgcn_s_waitcnt(0);
        unsigned nloc = b.st[0], nx = b.st[1];
        if (nloc == 0u) { xcd_barrier_complete(bar, b.x, nloc, nx); b.st[0] = nloc; b.st[1] = nx; }
        const unsigned old = xb_add(&bar[XB_XSUB(b.x)], 1u);
        const unsigned gen = old / nloc;
        if (old + 1u == (gen + 1u) * nloc) {
            __builtin_amdgcn_fence(__ATOMIC_RELEASE, "agent");
            asm volatile("s_waitcnt vmcnt(0)" ::: "memory");
            const unsigned og = xb_add(&bar[XB_TOP], 1u);
            const unsigned tg = og / nx;
            if (og + 1u == (tg + 1u) * nx) xb_add(&bar[XB_TOPGEN], 1u);
            else XB_SPIN(xb_ld(&bar[XB_TOPGEN]) == tg, bar);
            __builtin_amdgcn_fence(__ATOMIC_ACQUIRE, "agent");
            xb_add(&bar[XB_XGEN(b.x)], 1u);
            asm volatile("s_waitcnt vmcnt(0)" ::: "memory");
        } else {
            XB_SPIN(xb_ld(&bar[XB_XGEN(b.x)]) == gen, bar);
            __builtin_amdgcn_fence(__ATOMIC_ACQUIRE, "agent");
            asm volatile("s_waitcnt vmcnt(0)" ::: "memory");
        }
    }
    __syncthreads();
}

struct Args { const float* in[25]; float* out; unsigned char* ws; int ph_lo, ph_hi; };
struct Frame {
    const float* const* in; float* out; unsigned char* ws; LAS unsigned char* lds; int tid, lane, wave, G, bid;
};
enum { I_X = 0, I_C, I_CTX, I_CCTX, I_WADA, I_BADA, I_GMIXPRE, I_GMIXPOST, I_GFFNPRE, I_GFFNPOST, I_WIN, I_CLW, I_CLB, I_WREC, I_BREC, I_WING, I_BING, I_LAM, I_WFOU, I_BFOU, I_WOUT, I_WUP, I_CFW, I_CFB, I_WDOWN };

constexpr int IT_MOD = 192;
constexpr int IT_TR_WIN = 16 * 48, IT_TR_WOUT = 16 * 32, IT_TR_WUP = 16 * 176, IT_TR_WDOWN = 44 * 32, IT_TR_G = 64;
constexpr int IT_TR = IT_TR_WIN + IT_TR_WOUT + IT_TR_WUP + IT_TR_WDOWN + IT_TR_G;
constexpr int IT_TAB = 128, IT_WCS = 256, IT_POS = 96;
constexpr int IT_TR_SPLIT = IT_TR - 640;

__device__ __forceinline__ void mod_item(const Frame& F, int it) {
    LAS float* sil = (LAS float*)F.lds;
    LAS float* red = (LAS float*)(F.lds + 73728);
    const float* c = F.in[I_C]; const float* cc = F.in[I_CCTX];
    for (int idx = F.tid; idx < 9 * 2048; idx += 512) { const int bb = idx >> 11, k = idx & 2047; const float v = bb < 8 ? c[bb * 2048 + k] : cc[k]; sil[idx] = v * fast_sigmoid(v); }
    __syncthreads();
    const int n0 = it * 64, rg = F.tid >> 4, l16 = F.tid & 15;
    const float* w = F.in[I_WADA] + n0 + l16 * 4;
    f32x4 acc[9];
#pragma unroll
    for (int b = 0; b < 9; ++b) acc[b] = (f32x4){0.f, 0.f, 0.f, 0.f};
    for (int i0 = 0; i0 < 64; i0 += 8) { f32x4 wv[8];
#pragma unroll
        for (int i = 0; i < 8; ++i) wv[i] = *(const f32x4*)(w + (size_t)(rg + 32 * (i0 + i)) * 12288);
#pragma unroll
        for (int i = 0; i < 8; ++i) { const int k = rg + 32 * (i0 + i);
#pragma unroll
            for (int b = 0; b < 9; ++b) acc[b] += sil[b * 2048 + k] * wv[i]; } }
#pragma unroll
    for (int b = 0; b < 9; ++b) *(LAS f32x4*)(red + (rg * 9 + b) * 64 + l16 * 4) = acc[b];
    __syncthreads();
    for (int o = F.tid; o < 576; o += 512) { const int bb = o >> 6, col = o & 63; float s = 0.f; for (int r = 0; r < 32; ++r) s += red[(r * 9 + bb) * 64 + col];
        ((float*)(F.ws + WS_MOD))[bb * 12288 + n0 + col] = s + F.in[I_BADA][n0 + col]; }
    __syncthreads();
}

struct TrDesc { const float* src; bf16_t* dst; int N, ldd, k0, n0; };
__device__ __forceinline__ TrDesc tr_decode(const Frame& F, int it) {
    TrDesc t;
    if (it < IT_TR_WIN) { t.src = F.in[I_WIN]; t.N = NPROJ; t.dst = (bf16_t*)(F.ws + WS_WIN); t.ldd = D; t.k0 = (it % 16) * 128; t.n0 = (it / 16) * 64; return t; }
    it -= IT_TR_WIN;
    if (it < IT_TR_WOUT) { t.src = F.in[I_WOUT]; t.N = D; t.dst = (bf16_t*)(F.ws + WS_WOUT); t.ldd = D; t.k0 = (it % 16) * 128; t.n0 = (it / 16) * 64; return t; }
    it -= IT_TR_WOUT;
    if (it < IT_TR_WUP) { t.src = F.in[I_WUP]; t.N = DFF2; t.dst = (bf16_t*)(F.ws + WS_WUP); t.ldd = D; t.k0 = (it % 16) * 128; t.n0 = (it / 16) * 64; return t; }
    it -= IT_TR_WUP;
    if (it < IT_TR_WDOWN) { t.src = F.in[I_WDOWN]; t.N = D; t.dst = (bf16_t*)(F.ws + WS_WDOWN); t.ldd = DFF; t.k0 = (it % 44) * 128; t.n0 = (it / 44) * 64; return t; }
    it -= IT_TR_WDOWN;
    { const int half = it & 1, mat = it >> 1, type = mat & 1, dir = (mat >> 1) & 1, h = mat >> 2;
      t.src = (type ? F.in[I_WING] : F.in[I_WREC]) + (size_t)(dir * 8 + h) * 128 * 128; t.N = 128;
      t.dst = (bf16_t*)(F.ws + WS_WG) + (size_t)(h * 512 + (dir * 2 + type) * 128) * 128; t.ldd = 128; t.k0 = 0; t.n0 = half * 64; }
    return t;
}
__device__ __forceinline__ void tr_load(const Frame& F, int it, f32x4 (&v)[4]) {
    const TrDesc t = tr_decode(F, it); const int kr0 = F.tid >> 4, c4 = F.tid & 15;
#pragma unroll
    for (int i = 0; i < 4; ++i) v[i] = *(const f32x4*)(t.src + (size_t)(t.k0 + kr0 + 32 * i) * t.N + t.n0 + c4 * 4);
}
__device__ __forceinline__ void tr_store(const Frame& F, int it, const f32x4 (&v)[4]) {
    const TrDesc t = tr_decode(F, it);
    LAS bf16_t* T = (LAS bf16_t*)F.lds;
    const int kr0 = F.tid >> 4, c4 = F.tid & 15;
#pragma unroll
    for (int i = 0; i < 4; ++i) { const int kr = kr0 + 32 * i;
        const unsigned p0 = cvt_pk_bf16(v[i][0], v[i][1]), p1 = cvt_pk_bf16(v[i][2], v[i][3]);
        T[(c4 * 4 + 0) * 136 + kr] = (bf16_t)(p0 & 0xffff); T[(c4 * 4 + 1) * 136 + kr] = (bf16_t)(p0 >> 16);
        T[(c4 * 4 + 2) * 136 + kr] = (bf16_t)(p1 & 0xffff); T[(c4 * 4 + 3) * 136 + kr] = (bf16_t)(p1 >> 16); }
    LDS_BARRIER();
#pragma unroll
    for (int i = 0; i < 2; ++i) { const int n = (F.tid >> 4) + 32 * i, kg = F.tid & 15;
        const u32x4 w = *(const LAS u32x4*)(T + n * 136 + kg * 8);
        *(u32x4*)(t.dst + (size_t)(t.n0 + n) * t.ldd + t.k0 + kg * 8) = w; }
    LDS_BARRIER();
}

__device__ __forceinline__ void tr_range(const Frame& F, int lo, int hi, int b, int nb) {
    int it = lo + b; if (it >= hi) return;
    f32x4 A[4], B[4];
    tr_load(F, it, A);
    for (;;) {
        const int i1 = it + nb; tr_load(F, i1 < hi ? i1 : hi - 1, B);
        tr_store(F, it, A);
        if (i1 >= hi) break;
        const int i2 = i1 + nb; tr_load(F, i2 < hi ? i2 : hi - 1, A);
        tr_store(F, i1, B);
        if (i2 >= hi) break;
        it = i2;
    }
}

__device__ __forceinline__ void tab_items(const Frame& F, int b, int nb) {
    if (b >= IT_TAB) return;
    LAS float* tc = (LAS float*)F.lds; LAS float* ts = tc + 2048;
    const float sc = 0.02209708691f;
    for (int j = F.tid; j < 2048; j += 512) { float s, c; sincospif((float)j * (1.0f / 1024.0f), &s, &c); tc[j] = c * sc; ts[j] = s * sc; }
    __syncthreads();
    bf16_t* ct = (bf16_t*)(F.ws + WS_CTAB); bf16_t* st = (bf16_t*)(F.ws + WS_STAB);
    for (int it = b; it < IT_TAB; it += nb)
        for (int r = 0; r < 8; ++r) { const int k = it * 8 + r; const int n = F.tid * 4; float cv[4], sv[4];
#pragma unroll
            for (int j = 0; j < 4; ++j) { const int idx = (k * (n + j)) & 2047; cv[j] = tc[idx]; sv[j] = ts[idx]; }
            u32x2 cw, sw; cw.x = cvt_pk_bf16(cv[0], cv[1]); cw.y = cvt_pk_bf16(cv[2], cv[3]); sw.x = cvt_pk_bf16(sv[0], sv[1]); sw.y = cvt_pk_bf16(sv[2], sv[3]);
            *(u32x2*)(ct + (size_t)k * 2048 + n) = cw; *(u32x2*)(st + (size_t)k * 2048 + n) = sw; }
    __syncthreads();
}

__device__ __forceinline__ void wcs_items(const Frame& F, int b, int nb) {
    LAS float* tab = (LAS float*)F.lds;
    if (F.tid < 256) { float s, c; sincospif((float)F.tid * (1.0f / 128.0f), &s, &c); tab[F.tid] = c; tab[256 + F.tid] = s; }
    __syncthreads();
    for (int it = b; it < IT_WCS; it += nb) {
        const int g = it >> 6, c0 = (it & 63) * 4, d = F.tid & 255, s = F.tid >> 8;
        const float* wf = F.in[I_WFOU] + (size_t)g * 65536 + d; const LAS float* tb = tab + s * 256;
        const float sg = s ? -1.0f : 1.0f;
        float a0 = 0.f, a1 = 0.f, a2 = 0.f, a3 = 0.f;
        for (int m0 = 1; m0 < 128; m0 += 8) { float e[8];
#pragma unroll
            for (int j = 0; j < 8; ++j) { const int m = m0 + j; e[j] = m < 128 ? wf[m * 256] + sg * wf[(256 - m) * 256] : 0.f; }
#pragma unroll
            for (int j = 0; j < 8; ++j) { const int m = m0 + j;
                a0 += tb[(m * (c0 + 0)) & 255] * e[j]; a1 += tb[(m * (c0 + 1)) & 255] * e[j]; a2 += tb[(m * (c0 + 2)) & 255] * e[j]; a3 += tb[(m * (c0 + 3)) & 255] * e[j]; } }
        if (s == 0) { const float w0 = wf[0], w128 = wf[128 * 256]; a0 += w0 + w128; a1 += w0 - w128; a2 += w0 + w128; a3 += w0 - w128; }
        u32x2 w; w.x = cvt_pk_bf16(a0 * 0.0625f, a1 * 0.0625f); w.y = cvt_pk_bf16(a2 * 0.0625f, a3 * 0.0625f);
        *(u32x2*)((bf16_t*)(F.ws + WS_WCS) + (size_t)(g * 512 + s * 256 + d) * 256 + c0) = w;
    }
    __syncthreads();
}

__device__ __forceinline__ void pos_item(const Frame& F, int p) {
    float* pt = (float*)(F.ws + WS_POS) + (size_t)p * 1024;
    const float pe = (float)(p < 32 ? p : p - 32);
    for (int e = F.tid; e < 1024; e += 512) { const int half = e >> 9, i = e & 511;
        const float f = powf(10000.0f, -(float)i / 512.0f); const float ang = pe * f;
        pt[e] = half ? cosf(ang) : sinf(ang); }
}

__device__ __forceinline__ void p0_prologue(const Frame& F) {
    const int NC = F.G >= 128 ? 64 : 0;
    const bool comp = NC == 0 || F.bid < NC, mem = NC == 0 || F.bid >= NC;
    const int cb = F.bid, cn = NC ? NC : F.G, mb = F.bid - NC, mn = F.G - NC;
    if (mem) {
        for (int it = mb; it < IT_MOD; it += mn) mod_item(F, it);
        tr_range(F, 0, NC ? IT_TR_SPLIT : IT_TR, mb, mn);
        __syncthreads();
    }
    if (comp) {
        wcs_items(F, cb, cn);
        tab_items(F, cb, cn);
        for (int it = cb; it < IT_POS; it += cn) pos_item(F, it);
        if (cb == 0) for (int e = F.tid; e < 2048; e += 512) ((float*)(F.ws + WS_K2))[e] = -8.0f * 1.44269504f * log1pf(expf(-F.in[I_LAM][e]));
        if (NC) { __syncthreads(); tr_range(F, IT_TR_SPLIT, IT_TR, cb, cn); __syncthreads(); }
    }
}

__device__ __forceinline__ f32x4 pos4(const float* pt, int t, int col) {
    const float* p = col < 1024 ? pt + (size_t)(t >> 6) * 1024 + col : pt + (size_t)(32 + (t & 63)) * 1024 + (col - 1024);
    return *(const f32x4*)p;
}
__device__ __forceinline__ void p1_norm(const Frame& F, int r_lo, int r_hi, int b0, int nb) {
    const float* pt = (const float*)(F.ws + WS_POS); const float* mod = (const float*)(F.ws + WS_MOD);
    const float* g = F.in[I_GMIXPRE]; bf16_t* H = (bf16_t*)(F.ws + WS_H);
    for (int r = r_lo + (F.bid - b0) * 8 + F.wave; r < r_hi; r += nb * 8) {
        const bool lat = r < MLAT; const int b = lat ? (r >> 11) : ((r - MLAT) >> 8), t = r & 2047;
        const float* src = lat ? F.in[I_X] + (size_t)r * D : F.in[I_CTX] + (size_t)(r - MLAT) * D;
        const float* mrow = mod + (size_t)(lat ? b : 8) * 12288;
        f32x4 v[8]; float ss = 0.f;
#pragma unroll
        for (int i = 0; i < 8; ++i) { const int col = (i * 64 + F.lane) * 4; v[i] = *(const f32x4*)(src + col); if (lat) v[i] += pos4(pt, t, col);
            ss += v[i][0] * v[i][0] + v[i][1] * v[i][1] + v[i][2] * v[i][2] + v[i][3] * v[i][3]; }
        ss = wave_sum(ss); const float rstd = rsqrtf(ss * (1.0f / D) + EPS);
#pragma unroll
        for (int i = 0; i < 8; ++i) { const int col = (i * 64 + F.lane) * 4; const f32x4 gg = *(const f32x4*)(g + col), sh = *(const f32x4*)(mrow + col), sc = *(const f32x4*)(mrow + 2048 + col);
            const f32x4 h = (v[i] * rstd * gg) * (1.0f + sc) + sh; u32x2 w; w.x = cvt_pk_bf16(h[0], h[1]); w.y = cvt_pk_bf16(h[2], h[3]);
            *(u32x2*)(H + (size_t)r * D + col) = w; }
    }
}

__device__ __forceinline__ void p1_latent_staged(const Frame& F, int b0, int nb) {
    const float* pt = (const float*)(F.ws + WS_POS); const float* mod = (const float*)(F.ws + WS_MOD);
    const float* g = F.in[I_GMIXPRE]; bf16_t* H = (bf16_t*)(F.ws + WS_H);
    const int j = F.bid - b0, per = nb >> 3, b = j / per, jb = j - b * per;
    LAS float* L = (LAS float*)F.lds;
    const float* mrow = mod + (size_t)b * 12288;
    __syncthreads();
    for (int e = F.tid; e < 512; e += 512) { const int c4 = e * 4;
        *(LAS f32x4*)(L + c4) = (1.0f + *(const f32x4*)(mrow + 2048 + c4)) * *(const f32x4*)(g + c4);
        *(LAS f32x4*)(L + 2048 + c4) = *(const f32x4*)(mrow + c4); }
    __syncthreads();
    const int step = per * 8;
    for (int t0 = jb * 8 + F.wave; t0 < SEQ; t0 += 2 * step) {
        f32x4 v[2][8]; float ss[2] = {0.f, 0.f};
#pragma unroll
        for (int q = 0; q < 2; ++q) { const int t = t0 + q * step < SEQ ? t0 + q * step : t0; const size_t r = (size_t)b * SEQ + t;
#pragma unroll
            for (int i = 0; i < 8; ++i) v[q][i] = *(const f32x4*)(F.in[I_X] + r * D + (i * 64 + F.lane) * 4); }
#pragma unroll
        for (int q = 0; q < 2; ++q) { const int t = t0 + q * step < SEQ ? t0 + q * step : t0;
#pragma unroll
            for (int i = 0; i < 8; ++i) { v[q][i] += pos4(pt, t, (i * 64 + F.lane) * 4); ss[q] += v[q][i][0] * v[q][i][0] + v[q][i][1] * v[q][i][1] + v[q][i][2] * v[q][i][2] + v[q][i][3] * v[q][i][3]; } }
#pragma unroll
        for (int q = 0; q < 2; ++q) { const int t = t0 + q * step; if (t >= SEQ) break; const size_t r = (size_t)b * SEQ + t;
            const float rstd = rsqrtf(wave_sum(ss[q]) * (1.0f / D) + EPS);
#pragma unroll
            for (int i = 0; i < 8; ++i) { const int col = (i * 64 + F.lane) * 4;
                const f32x4 h = (v[q][i] * rstd) * *(const LAS f32x4*)(L + col) + *(const LAS f32x4*)(L + 2048 + col);
                u32x2 w; w.x = cvt_pk_bf16(h[0], h[1]); w.y = cvt_pk_bf16(h[2], h[3]);
                *(u32x2*)(H + r * D + col) = w; } }
    }
    __syncthreads();
}
struct SchedWin {
    const bf16_t* A; const bf16_t* B; int G, c;
    int lo, hi;
    __device__ __forceinline__ bool next(int i, pg8::Unit& u) const { const int L = lo + i * G + c; if (L >= hi) return false;
        if (L < 768) pg8::std_order(L, 64, 12, u.pm, u.pn); else { const int l = L - 768; u.pm = 64 + (l >> 2); u.pn = 4 + (l & 3); } u.z = 0; return true; }
    __device__ __forceinline__ void ptrs(const pg8::Unit& u, const char*& a, const char*& b) const { a = (const char*)(A + (size_t)u.pm * 256 * D); b = (const char*)(B + (size_t)u.pn * 256 * D); }
};
struct EpiWin { static constexpr bool PERM = true, PERMA = false; bf16_t* uf;
    __device__ __forceinline__ void operator()(const f32x4 (&acc)[2][2][4][2], const pg8::Unit& u, int wr, int wc, int fr, int fq) const {
        const int seg = u.pn >> 2; bf16_t* base = uf + (size_t)seg * (16u << 20) + (size_t)(seg >> 1) * (2u << 20);
        pg8::store_tile_bf16(acc, base + (size_t)u.pm * 256 * 1024 + (u.pn & 3) * 256, 1024, wr, wc, fr, fq); }
};
struct SchedPQ {
    const bf16_t* A; const bf16_t* B; int G, c;
    __device__ __forceinline__ bool next(int i, pg8::Unit& u) const { const int L = i * G + c; if (L >= 512) return false; u.z = L >> 4; u.pm = (L >> 3) & 1; u.pn = L & 7; return true; }
    __device__ __forceinline__ void ptrs(const pg8::Unit& u, const char*& a, const char*& b) const { const int bb = u.z >> 2, g = u.z & 3;
        a = (const char*)(A + (size_t)(g * 512 + u.pm * 256) * 256); b = (const char*)(B + (size_t)(bb * 2048 + u.pn * 256) * 1024 + g * 256); }
};
struct EpiPQ { static constexpr bool PERM = true, PERMA = false; bf16_t* o;
    __device__ __forceinline__ void operator()(const f32x4 (&acc)[2][2][4][2], const pg8::Unit& u, int wr, int wc, int fr, int fq) const {
        pg8::store_tile_bf16(acc, o + (size_t)(u.z * 512 + u.pm * 256) * 2048 + u.pn * 256, 2048, wr, wc, fr, fq); }
};
struct SchedDFT {
    const bf16_t* ct; const bf16_t* st; const bf16_t* B; int G, c;
    __device__ __forceinline__ bool next(int i, pg8::Unit& u) const { const int L = i * G + c; if (L >= 256) return false; u.pm = L & 3; u.pn = (L >> 2) & 1; u.z = L >> 3; return true; }
    __device__ __forceinline__ void ptrs(const pg8::Unit& u, const char*& a, const char*& b) const {
        a = (const char*)(ct + (size_t)u.pn * (2u << 20) + (size_t)u.pm * 256 * 2048); b = (const char*)(B + (size_t)(u.z * 512 + u.pn * 256) * 2048); }
};
struct EpiDFT { static constexpr bool PERM = true, PERMA = false; bf16_t* o;
    __device__ __forceinline__ void operator()(const f32x4 (&acc)[2][2][4][2], const pg8::Unit& u, int wr, int wc, int fr, int fq) const { const int bb = u.z >> 2, g = u.z & 3;
        pg8::store_tile_bf16(acc, o + (size_t)u.pn * 8192 * 1024 + (size_t)(bb * 1024 + u.pm * 256) * 1024 + g * 256, 1024, wr, wc, fr, fq); }
};
struct SchedStd {
    const bf16_t* A; const bf16_t* B; int nM, nN, lda, ldb, G, c, nrep;
    __device__ __forceinline__ bool next(int i, pg8::Unit& u) const { int L = i * G + c; if (L >= nM * nN * nrep) return false; L %= nM * nN; pg8::std_order(L, nM, nN, u.pm, u.pn, 4); u.z = 0; return true; }
    __device__ __forceinline__ void ptrs(const pg8::Unit& u, const char*& a, const char*& b) const { a = (const char*)(A + (size_t)u.pm * 256 * lda); b = (const char*)(B + (size_t)u.pn * 256 * ldb); }
};
struct EpiY { static constexpr bool PERM = true, PERMA = false; bf16_t* y; float* rss;
    __device__ __forceinline__ void operator()(const f32x4 (&acc)[2][2][4][2], const pg8::Unit& u, int wr, int wc, int fr, int fq) const {
        pg8::store_tile_bf16(acc, y + (size_t)u.pm * 256 * D + u.pn * 256, D, wr, wc, fr, fq);
#pragma unroll
        for (int ai = 0; ai < 2; ++ai)
#pragma unroll
            for (int m = 0; m < 4; ++m) { float s = 0.f;
#pragma unroll
                for (int bj = 0; bj < 2; ++bj)
#pragma unroll
                    for (int n = 0; n < 2; ++n) { const f32x4 v = acc[ai][bj][m][n]; s += (v[0] * v[0] + v[1] * v[1]) + (v[2] * v[2] + v[3] * v[3]); }
                s += __shfl_xor(s, 16); s += __shfl_xor(s, 32);
                if (fq == 0) rss[(size_t)(u.pm * 256 + ai * 128 + wr * 64 + m * 16 + fr) * 32 + u.pn * 4 + wc] = s; }
    }
};
template <int CTRL> __device__ __forceinline__ float dpp_f(float old, float src) { return __int_as_float(__builtin_amdgcn_update_dpp(__float_as_int(old), __float_as_int(src), CTRL, 0xF, 0xF, false)); }
constexpr int DPP_SHL1 = 0x101, DPP_SHR1 = 0x111, DPP_ROR1 = 0x121, DPP_ROR15 = 0x12F;
constexpr int LDS_EDGE = 131072;
#ifndef OUTREP
#define OUTREP 1
#endif
#ifndef DOWNREP
#define DOWNREP 1
#endif
#ifndef UPREP
#define UPREP 1
#endif
struct SchedUp {
    const bf16_t* A; const bf16_t* B; int G, c;
    __device__ __forceinline__ bool next(int i, pg8::Unit& u) const { int L = i * G + c; if (L >= 64 * 44 * UPREP) return false; L %= 64 * 44; pg8::std_order(L, 64, 44, u.pm, u.pn, 4); u.z = 0; return true; }
    __device__ __forceinline__ void ptrs(const pg8::Unit& u, const char*& a, const char*& b) const { a = (const char*)(A + (size_t)u.pm * 256 * D); b = (const char*)(B + (size_t)u.pn * 128 * D); }
};
struct EpiUpConv { static constexpr bool PERM = true, PERMA = true; bf16_t* act; float* edge; const float* cw; const float* cb; LAS unsigned char* lds;
    __device__ __forceinline__ void operator()(f32x4 (&acc)[2][2][4][2], const pg8::Unit& u, int wr, int wc, int fr, int fq) const {
        const int colw = 32 * wc + 8 * fq;
        LAS float* E = (LAS float*)(lds + LDS_EDGE) + wr * 512 + colw;
#pragma unroll
        for (int ai = 0; ai < 2; ++ai)
#pragma unroll
            for (int bj = 0; bj < 2; ++bj)
#pragma unroll
                for (int n = 0; n < 2; ++n) {
                    if (fr == 0) *(LAS f32x4*)(E + (4 * ai + 1) * 256 + bj * 128 + 4 * n) = acc[ai][bj][0][n];
                    if (fr == 15) *(LAS f32x4*)(E + (4 * ai + 2) * 256 + bj * 128 + 4 * n) = acc[ai][bj][3][n]; }
        { float* eg = edge + (size_t)u.pm * 4 * DFF2 + u.pn * 128 + colw;
          if (wr == 0) { if (fr == 0) {
#pragma unroll
              for (int bj = 0; bj < 2; ++bj)
#pragma unroll
                  for (int n = 0; n < 2; ++n) { *(f32x4*)(eg + bj * DFF + 4 * n) = acc[0][bj][0][n]; *(f32x4*)(eg + DFF2 + bj * DFF + 4 * n) = acc[0][bj][1][n]; } } }
          else { if (fr == 15) {
#pragma unroll
              for (int bj = 0; bj < 2; ++bj)
#pragma unroll
                  for (int n = 0; n < 2; ++n) { *(f32x4*)(eg + 2 * DFF2 + bj * DFF + 4 * n) = acc[1][bj][2][n]; *(f32x4*)(eg + 3 * DFF2 + bj * DFF + 4 * n) = acc[1][bj][3][n]; } } } }
        const float* cwp = cw + u.pn * 128 + colw; const float* cbp = cb + u.pn * 128 + colw;
        f32x4 W[2][8];
#pragma unroll
        for (int n = 0; n < 2; ++n) { W[n][0] = *(const f32x4*)(cwp + 4 * n); W[n][1] = *(const f32x4*)(cwp + DFF2 + 4 * n); W[n][2] = *(const f32x4*)(cwp + 2 * DFF2 + 4 * n); W[n][3] = *(const f32x4*)(cbp + 4 * n);
            W[n][4] = *(const f32x4*)(cwp + DFF + 4 * n); W[n][5] = *(const f32x4*)(cwp + DFF2 + DFF + 4 * n); W[n][6] = *(const f32x4*)(cwp + 2 * DFF2 + DFF + 4 * n); W[n][7] = *(const f32x4*)(cbp + DFF + 4 * n); }
        asm volatile("s_waitcnt lgkmcnt(0)" ::: "memory"); __builtin_amdgcn_s_barrier(); __builtin_amdgcn_s_barrier(); asm volatile("" ::: "memory");
#pragma unroll
        for (int n = 0; n < 2; ++n) {
            f32x4 wg0 = W[n][0], wg1 = W[n][1], wg2 = W[n][2], bg = W[n][3], wv0 = W[n][4], wv1 = W[n][5], wv2 = W[n][6], bv = W[n][7];
            asm volatile("" : "+v"(wg0), "+v"(wg1), "+v"(wg2), "+v"(bg), "+v"(wv0), "+v"(wv1), "+v"(wv2), "+v"(bv));
#pragma unroll
            for (int ai = 0; ai < 2; ++ai) {
                f32x4 ep0 = *(const LAS f32x4*)(E + (4 * ai) * 256 + 4 * n), ep1 = *(const LAS f32x4*)(E + (4 * ai) * 256 + 128 + 4 * n);
                f32x4 en0 = *(const LAS f32x4*)(E + (4 * ai + 3) * 256 + 4 * n), en1 = *(const LAS f32x4*)(E + (4 * ai + 3) * 256 + 128 + 4 * n);
                asm volatile("" : "+v"(ep0), "+v"(ep1), "+v"(en0), "+v"(en1));
                f32x4 T[4];
#pragma unroll
                for (int m = 0; m < 4; ++m) {
                    asm volatile("" : "+v"(acc[ai][0][m][n]), "+v"(acc[ai][1][m][n]));
#pragma unroll
                    for (int q = 0; q < 4; q += 2) {
                        f32x2 g, v, gp, vp, gn, vn;
#pragma unroll
                        for (int e = 0; e < 2; ++e) { const int qq = q + e;
                            g[e] = acc[ai][0][m][n][qq]; v[e] = acc[ai][1][m][n][qq];
                            gp[e] = m > 0 ? acc[ai][0][m > 0 ? m - 1 : 0][n][qq] : dpp_f<DPP_SHR1>(ep0[qq], acc[ai][0][3][n][qq]);
                            vp[e] = m > 0 ? acc[ai][1][m > 0 ? m - 1 : 0][n][qq] : dpp_f<DPP_SHR1>(ep1[qq], acc[ai][1][3][n][qq]);
                            gn[e] = m < 3 ? acc[ai][0][m < 3 ? m + 1 : 3][n][qq] : dpp_f<DPP_SHL1>(en0[qq], acc[ai][0][0][n][qq]);
                            vn[e] = m < 3 ? acc[ai][1][m < 3 ? m + 1 : 3][n][qq] : dpp_f<DPP_SHL1>(en1[qq], acc[ai][1][0][n][qq]); }
                        const f32x2 w0g = (f32x2){wg0[q], wg0[q + 1]}, w1g = (f32x2){wg1[q], wg1[q + 1]}, w2g = (f32x2){wg2[q], wg2[q + 1]}, b0g = (f32x2){bg[q], bg[q + 1]};
                        const f32x2 w0v = (f32x2){wv0[q], wv0[q + 1]}, w1v = (f32x2){wv1[q], wv1[q + 1]}, w2v = (f32x2){wv2[q], wv2[q + 1]}, b0v = (f32x2){bv[q], bv[q + 1]};
                        const f32x2 gg = b0g + w0g * gp + w1g * g + w2g * gn;
                        const f32x2 vv = b0v + w0v * vp + w1v * v + w2v * vn;
                        const f32x2 arg = gg * ((gg * gg) * (-2.302208198f * 0.044715f) + (-2.302208198f));
                        f32x2 d; d.x = __builtin_amdgcn_exp2f(arg.x); d.y = __builtin_amdgcn_exp2f(arg.y); d = d + 1.0f;
                        f32x2 r; r.x = __builtin_amdgcn_rcpf(d.x); r.y = __builtin_amdgcn_rcpf(d.y);
                        const f32x2 o = (gg * vv) * r;
                        T[m][q] = o.x; T[m][q + 1] = o.y; }
                    asm volatile("" : "+v"(T[m])); }
#pragma unroll
                for (int m = 0; m < 4; ++m) acc[ai][0][m][n] = T[m]; } }
        bf16_t* p0 = act + (size_t)(u.pm * 256 + wr * 64 + 4 * fr) * DFF + u.pn * 128 + colw;
#pragma unroll
        for (int ai = 0; ai < 2; ++ai)
#pragma unroll
            for (int m = 0; m < 4; ++m) { const f32x4 v0 = acc[ai][0][m][0], v1 = acc[ai][0][m][1];
                u32x4 w; w.x = cvt_pk_bf16(v0[0], v0[1]); w.y = cvt_pk_bf16(v0[2], v0[3]); w.z = cvt_pk_bf16(v1[0], v1[1]); w.w = cvt_pk_bf16(v1[2], v1[3]);
                *(u32x4*)(p0 + (size_t)(ai * 128 + m) * DFF) = w; }
    }
};

constexpr int XB_STRIDE = 136, AR_STRIDE = 132;
constexpr int LDS_XB = 0, LDS_AF = 17408, LDS_IF = LDS_AF + 33792, LDS_AB = LDS_IF + 33792, LDS_IB = LDS_AB + 33792;
static_assert(LDS_IB + 33792 <= LDS_BAR, "lds");

__device__ __forceinline__ void lru_load(const Frame& F, int L, u32x4 (&U)[2][4]) {
    const bf16_t* Ux = (const bf16_t*)(F.ws + WS_UX);
    const int h = L & 7, s = L >> 3, b = s / NCHUNK, j = s % NCHUNK;
    const bool isctx = j < 4; const int rowbase = isctx ? MLAT + b * CTXL : b * SEQ, t0 = isctx ? j * 64 : (j - 4) * 64, len = isctx ? CTXL : SEQ;
#pragma unroll
    for (int i = 0; i < 2; ++i) { const int idx = F.tid + 512 * i, tok = idx >> 4, cg8 = idx & 15;
#pragma unroll
        for (int k = 0; k < 4; ++k) { int tt = t0 + tok + k - 2; tt = tt < 0 ? 0 : (tt >= len ? len - 1 : tt);
            U[i][k] = *(const u32x4*)(Ux + (size_t)(rowbase + tt) * 1024 + h * 128 + cg8 * 8); } }
}
__device__ __forceinline__ void lru_phase(const Frame& F) {
    const bf16_t* WgT = (const bf16_t*)(F.ws + WS_WG);
    bf16_t* So = (bf16_t*)(F.ws + WS_S); bf16_t* Pfo = (bf16_t*)(F.ws + WS_PF); bf16_t* Pbo = (bf16_t*)(F.ws + WS_PB);
    float* agg = (float*)(F.ws + WS_AGG);
    LAS bf16_t* XB = (LAS bf16_t*)(F.lds + LDS_XB);
    const int w = F.wave, fr = F.lane & 15, fq = F.lane >> 4;
    constexpr int NU = NB * NCHUNK * 8;
    int cur_h = -1;
    bf16x8 Wf[4][4];
    int L = F.bid; if (L >= NU) return;
    u32x4 U[2][4];
    lru_load(F, L, U);
    for (;;) {
        const int h = L & 7, s = L >> 3, b = s / NCHUNK, j = s % NCHUNK;
        if (h != cur_h) { cur_h = h;
#pragma unroll
            for (int g4 = 0; g4 < 4; ++g4)
#pragma unroll
                for (int kk = 0; kk < 4; ++kk) Wf[g4][kk] = *(const bf16x8*)(WgT + (size_t)(h * 512 + g4 * 128 + 16 * w + fr) * 128 + kk * 32 + fq * 8);
        }
        const bool isctx = j < 4; const int rowbase = isctx ? MLAT + b * CTXL : b * SEQ, t0 = isctx ? j * 64 : (j - 4) * 64, len = isctx ? CTXL : SEQ;
#pragma unroll
        for (int i = 0; i < 2; ++i) { const int idx = F.tid + 512 * i, tok = idx >> 4, cg8 = idx & 15; const int ch = h * 128 + cg8 * 8;
            float o[8]; { const f32x4 b0 = *(const f32x4*)(F.in[I_CLB] + ch), b1 = *(const f32x4*)(F.in[I_CLB] + ch + 4);
                o[0] = b0[0]; o[1] = b0[1]; o[2] = b0[2]; o[3] = b0[3]; o[4] = b1[0]; o[5] = b1[1]; o[6] = b1[2]; o[7] = b1[3]; }
#pragma unroll
            for (int k = 0; k < 4; ++k) { const int tt = t0 + tok + k - 2; const float msk = (tt >= 0 && tt < len) ? 1.0f : 0.0f;
                float uv[8]; unpack8(U[i][k], uv);
                const f32x4 w0 = *(const f32x4*)(F.in[I_CLW] + k * 1024 + ch) * msk, w1 = *(const f32x4*)(F.in[I_CLW] + k * 1024 + ch + 4) * msk;
                o[0] += w0[0] * uv[0]; o[1] += w0[1] * uv[1]; o[2] += w0[2] * uv[2]; o[3] += w0[3] * uv[3];
                o[4] += w1[0] * uv[4]; o[5] += w1[1] * uv[5]; o[6] += w1[2] * uv[6]; o[7] += w1[3] * uv[7]; }
            *(LAS u32x4*)(XB + tok * XB_STRIDE + cg8 * 8) = pack8(o); }
        const int Ln = L + F.G;
        lru_load(F, Ln < NU ? Ln : NU - 1, U);
        LDS_BARRIER();
#pragma unroll
        for (int d = 0; d < 2; ++d) {
            const int C = d * 1024 + h * 128 + 16 * w + 4 * fq;
            const f32x4 nba = *(const f32x4*)(F.in[I_BREC] + C) * -1.44269504f, nbx = *(const f32x4*)(F.in[I_BING] + C) * -1.44269504f, k2 = *(const f32x4*)((const float*)(F.ws + WS_K2) + C);
            f32x4 acc[2][4];
#pragma unroll
            for (int g2 = 0; g2 < 2; ++g2)
#pragma unroll
                for (int m = 0; m < 4; ++m) acc[g2][m] = (f32x4){0.f, 0.f, 0.f, 0.f};
#pragma unroll
            for (int m = 0; m < 4; ++m) { bf16x8 Xf[4];
#pragma unroll
                for (int kk = 0; kk < 4; ++kk) Xf[kk] = *(const LAS bf16x8*)(XB + (16 * m + fr) * XB_STRIDE + kk * 32 + fq * 8);
#pragma unroll
                for (int g2 = 0; g2 < 2; ++g2)
#pragma unroll
                    for (int kk = 0; kk < 4; ++kk) acc[g2][m] = __builtin_amdgcn_mfma_f32_16x16x32_bf16(Wf[2 * d + g2][kk], Xf[kk], acc[g2][m], 0, 0, 0); }
#pragma unroll
            for (int m = 0; m < 4; ++m) { const int tok = 16 * m + fr;
                const u32x2 xw = *(const LAS u32x2*)(XB + tok * XB_STRIDE + 16 * w + 4 * fq);
                const f32x4 xc = (f32x4){bf_lo(xw.x), bf_hi(xw.x), bf_lo(xw.y), bf_hi(xw.y)};
                f32x4 av, iv;
#pragma unroll
                for (int q = 0; q < 4; ++q) {
                    const float ea = __builtin_amdgcn_exp2f(fminf(fmaf(acc[0][m][q], -1.44269504f, nba[q]), 60.f)), ex = __builtin_amdgcn_exp2f(fminf(fmaf(acc[1][m][q], -1.44269504f, nbx[q]), 60.f));
                    const float pa = 1.0f + ea, px = 1.0f + ex, t = __builtin_amdgcn_rcpf(pa * px), r = t * px, ig = t * pa;
                    const float la2 = r * k2[q]; const float a = __builtin_amdgcn_exp2f(la2); const float u = la2 * 1.38629436f;
                    const float poly = -u * (1.0f + u * (0.5f + u * 0.16666667f));
                    const float em = u > -0.02f ? poly : fmaf(-a, a, 1.0f);
                    av[q] = a; iv[q] = __builtin_amdgcn_sqrtf(fmaxf(em, 0.f)) * ig * xc[q]; }
                *(LAS f32x4*)(F.lds + (d ? LDS_AB : LDS_AF) + (tok * AR_STRIDE + 16 * w + 4 * fq) * 4) = av;
                *(LAS f32x4*)(F.lds + (d ? LDS_IB : LDS_IF) + (tok * AR_STRIDE + 16 * w + 4 * fq) * 4) = iv; }
            asm volatile("" ::: "memory");
        }
        LDS_BARRIER();
        LAS float* ENDS = (LAS float*)(F.lds + LDS_XB);
        { const int half = F.tid >> 8, d = (F.tid >> 7) & 1, ch = F.tid & 127;
            LAS float* A = (LAS float*)(F.lds + (d ? LDS_AB : LDS_AF)) + ch; LAS float* I = (LAS float*)(F.lds + (d ? LDS_IB : LDS_IF)) + ch;
            float hs = 0.f, P = 1.f;
            if (d == 0) { const int tb = half * 32;
#pragma unroll 8
                for (int t = 0; t < 32; ++t) { const float a = A[(tb + t) * AR_STRIDE], x = I[(tb + t) * AR_STRIDE]; hs = a * hs + x; P *= a; I[(tb + t) * AR_STRIDE] = hs; A[(tb + t) * AR_STRIDE] = P; }
            } else { const int tb = 63 - half * 32;
#pragma unroll 8
                for (int t = 0; t < 32; ++t) { const float a = A[(tb - t) * AR_STRIDE], x = I[(tb - t) * AR_STRIDE]; hs = a * hs + x; P *= a; I[(tb - t) * AR_STRIDE] = hs; A[(tb - t) * AR_STRIDE] = P; }
            }
            ENDS[((d * 2 + half) * 2 + 0) * 128 + ch] = P; ENDS[((d * 2 + half) * 2 + 1) * 128 + ch] = hs; }
        LDS_BARRIER();
        if (F.tid < 256) { const int d = F.tid >> 7, ch = F.tid & 127;
            const float P0 = ENDS[((d * 2 + 0) * 2 + 0) * 128 + ch], H0 = ENDS[((d * 2 + 0) * 2 + 1) * 128 + ch], P1 = ENDS[((d * 2 + 1) * 2 + 0) * 128 + ch], H1 = ENDS[((d * 2 + 1) * 2 + 1) * 128 + ch];
            float* ag = agg + ((size_t)(b * NCHUNK + j) * 4 + d * 2) * 1024 + h * 128 + ch; ag[0] = P0 * P1; ag[1024] = P1 * H0 + H1; }
        if (!isctx) {
#pragma unroll
            for (int i = 0; i < 2; ++i) { const int idx = F.tid + 512 * i, tok = idx >> 4, cg8 = idx & 15; const int o = (tok * AR_STRIDE + cg8 * 8) * 4;
                const bool f2 = tok >= 32, b2 = tok < 32;
                float sv[8], pf[8], pb[8];
#pragma unroll
                for (int hh = 0; hh < 2; ++hh) { const f32x4 x0 = *(const LAS f32x4*)(F.lds + LDS_IF + o + hh * 16), x1 = *(const LAS f32x4*)(F.lds + LDS_IB + o + hh * 16);
                    const f32x4 p0 = *(const LAS f32x4*)(F.lds + LDS_AF + o + hh * 16), p1 = *(const LAS f32x4*)(F.lds + LDS_AB + o + hh * 16);
                    const int c0 = cg8 * 8 + hh * 4;
                    const f32x4 fP = f2 ? *(const LAS f32x4*)(ENDS + 0 * 128 + c0) : (f32x4){1.f, 1.f, 1.f, 1.f}, fH = f2 ? *(const LAS f32x4*)(ENDS + 1 * 128 + c0) : (f32x4){0.f, 0.f, 0.f, 0.f};
                    const f32x4 bP = b2 ? *(const LAS f32x4*)(ENDS + 4 * 128 + c0) : (f32x4){1.f, 1.f, 1.f, 1.f}, bH = b2 ? *(const LAS f32x4*)(ENDS + 5 * 128 + c0) : (f32x4){0.f, 0.f, 0.f, 0.f};
#pragma unroll
                    for (int q = 0; q < 4; ++q) { sv[hh * 4 + q] = (x0[q] + p0[q] * fH[q]) + (x1[q] + p1[q] * bH[q]); pf[hh * 4 + q] = p0[q] * fP[q]; pb[hh * 4 + q] = p1[q] * bP[q]; } }
                const size_t go = (size_t)(rowbase + t0 + tok) * 1024 + h * 128 + cg8 * 8;
                *(u32x4*)(So + go) = pack8(sv); *(u32x4*)(Pfo + go) = pack8(pf); *(u32x4*)(Pbo + go) = pack8(pb); }
        }
        LDS_BARRIER();
        if (Ln >= NU) break;
        L = Ln;
    }
    __syncthreads();
}

__device__ __forceinline__ void alt_phase(const Frame& F) {
    const bf16_t* PQT = (const bf16_t*)(F.ws + WS_PQT); float* y1024 = (float*)(F.ws + WS_Y1024);
    const bf16_t* ct = (const bf16_t*)(F.ws + WS_CTAB);
    const float sc = __uint_as_float(((unsigned)ct[0]) << 16);
    for (int o = F.bid * 8 + F.wave; o < 8192; o += F.G * 8) {
        const int bg = o >> 8, d = o & 255; const bf16_t* p = PQT + (size_t)(bg * 512 + d) * 2048 + F.lane * 32; float s = 0.f;
#pragma unroll
        for (int i = 0; i < 4; ++i) { float v[8]; unpack8(*(const u32x4*)(p + i * 8), v); s += (v[0] - v[1]) + (v[2] - v[3]) + (v[4] - v[5]) + (v[6] - v[7]); }
        s = wave_sum(s);
        if (F.lane == 0) y1024[(bg >> 2) * 1024 + (bg & 3) * 256 + d] = s * sc;
    }
}

__device__ __forceinline__ void assemble_phase(const Frame& F) {
    const float* agg = (const float*)(F.ws + WS_AGG);
    const bf16_t* S = (const bf16_t*)(F.ws + WS_S); const bf16_t* Pf = (const bf16_t*)(F.ws + WS_PF); const bf16_t* Pb = (const bf16_t*)(F.ws + WS_PB); const bf16_t* Ug = (const bf16_t*)(F.ws + WS_UG);
    const bf16_t* cp = (const bf16_t*)(F.ws + WS_CPSQ); const bf16_t* sq = cp + (size_t)8192 * 1024; const float* y1024 = (const float*)(F.ws + WS_Y1024);
    bf16_t* YA = (bf16_t*)(F.ws + WS_YA);
    LAS float* cf = (LAS float*)F.lds; LAS float* cb = cf + 1024;
    for (int L = F.bid; L < 256; L += F.G) {
        const int b = L >> 5, jc = L & 31, jj = jc + 4;
#pragma unroll
        for (int e = 0; e < 2; ++e) { const int ch = F.tid + 512 * e; const float* a0 = agg + (size_t)b * NCHUNK * 4096 + ch;
            float c = 0.f, c2 = 0.f;
#pragma unroll
            for (int i0 = 0; i0 < NCHUNK; i0 += 12) { float fa[12], fh[12], ba[12], bh[12];
#pragma unroll
                for (int k = 0; k < 12; ++k) { const int i = i0 + k; const int ib = i < 4 ? 3 - i : NCHUNK + 3 - i;
                    fa[k] = a0[(size_t)i * 4096]; fh[k] = a0[(size_t)i * 4096 + 1024]; ba[k] = a0[(size_t)ib * 4096 + 2048]; bh[k] = a0[(size_t)ib * 4096 + 3072]; }
#pragma unroll
                for (int k = 0; k < 12; ++k) { const int i = i0 + k; const int ib = i < 4 ? 3 - i : NCHUNK + 3 - i;
                    if (i < jj) c = fa[k] * c + fh[k];
                    if (ib < 4 || ib > jj) c2 = ba[k] * c2 + bh[k]; } }
            cf[ch] = c; cb[ch] = c2; }
        __syncthreads();
        const int row0 = b * SEQ + jc * 64;
        for (int i0 = 0; i0 < 16; i0 += 4) { u32x4 sw[4], fw[4], bw[4], gw[4];
#pragma unroll
            for (int k = 0; k < 4; ++k) { const int idx = F.tid + 512 * (i0 + k), row = idx >> 7, cg8 = idx & 127; const size_t go = (size_t)(row0 + row) * 1024 + cg8 * 8;
                sw[k] = *(const u32x4*)(S + go); fw[k] = *(const u32x4*)(Pf + go); bw[k] = *(const u32x4*)(Pb + go); gw[k] = *(const u32x4*)(Ug + go); }
#pragma unroll
            for (int k = 0; k < 4; ++k) { const int idx = F.tid + 512 * (i0 + k), row = idx >> 7, cg8 = idx & 127;
                float sv[8], pf[8], pb[8], ug[8], o[8]; unpack8(sw[k], sv); unpack8(fw[k], pf); unpack8(bw[k], pb); unpack8(gw[k], ug);
#pragma unroll
                for (int q = 0; q < 8; ++q) o[q] = (sv[q] + pf[q] * cf[cg8 * 8 + q] + pb[q] * cb[cg8 * 8 + q]) * gelu_tanh(ug[q]);
                *(u32x4*)(YA + (size_t)(row0 + row) * D + 1024 + cg8 * 8) = pack8(o); } }
        for (int i0 = 0; i0 < 32; i0 += 8) { u32x2 c4v[8], s4v[8];
#pragma unroll
            for (int k = 0; k < 8; ++k) { const int idx = F.tid + 512 * (i0 + k), row = idx >> 8, c4 = (idx & 255) * 4; const int kk = jc * 64 + row;
                const int ks = kk <= 1024 ? kk : 2048 - kk;
                const size_t o = (size_t)(b * 1024 + (ks < 1024 ? ks : 1023)) * 1024 + c4;
                c4v[k] = *(const u32x2*)(cp + o); s4v[k] = *(const u32x2*)(sq + o); }
#pragma unroll
            for (int k = 0; k < 8; ++k) { const int idx = F.tid + 512 * (i0 + k), row = idx >> 8, c4 = (idx & 255) * 4; const int kk = jc * 64 + row;
                const f32x4 cv = (f32x4){bf_lo(c4v[k].x), bf_hi(c4v[k].x), bf_lo(c4v[k].y), bf_hi(c4v[k].y)}, sv4 = (f32x4){bf_lo(s4v[k].x), bf_hi(s4v[k].x), bf_lo(s4v[k].y), bf_hi(s4v[k].y)};
                f32x4 y = kk < 1024 ? cv - sv4 : cv + sv4;
                if (kk == 1024) y = *(const f32x4*)(y1024 + b * 1024 + c4);
                y += *(const f32x4*)(F.in[I_BFOU] + c4);
                u32x2 w; w.x = cvt_pk_bf16(y[0], y[1]); w.y = cvt_pk_bf16(y[2], y[3]);
                *(u32x2*)(YA + (size_t)(row0 + row) * D + c4) = w; } }
        __syncthreads();
    }
}

__device__ __forceinline__ f32x4 ld_bf4(const bf16_t* p) { const u32x2 w = *(const u32x2*)p; return (f32x4){bf_lo(w.x), bf_hi(w.x), bf_lo(w.y), bf_hi(w.y)}; }
__device__ __forceinline__ void p7_norm2_staged(const Frame& F) {
    const float* pt = (const float*)(F.ws + WS_POS); const float* mod = (const float*)(F.ws + WS_MOD);
    const bf16_t* Y = (const bf16_t*)(F.ws + WS_Y); const float* rss = (const float*)(F.ws + WS_RSS1); bf16_t* H2 = (bf16_t*)(F.ws + WS_H2);
    const float* gpost = F.in[I_GMIXPOST]; const float* gpre = F.in[I_GFFNPRE];
    LAS float* L = (LAS float*)F.lds;
    for (int k0 = 0; k0 < NB; k0 += 2) {
        __syncthreads();
        for (int e = F.tid; e < 2 * 512; e += 512) { const int j = e >> 9, c4 = (e & 511) * 4; const float* mrow = mod + (size_t)(k0 + j) * 12288;
            *(LAS f32x4*)(L + (j * 3 + 0) * 2048 + c4) = *(const f32x4*)(mrow + 4096 + c4) * *(const f32x4*)(gpost + c4);
            *(LAS f32x4*)(L + (j * 3 + 1) * 2048 + c4) = (1.0f + *(const f32x4*)(mrow + 8192 + c4)) * *(const f32x4*)(gpre + c4);
            *(LAS f32x4*)(L + (j * 3 + 2) * 2048 + c4) = *(const f32x4*)(mrow + 6144 + c4); }
        __syncthreads();
        const int t = F.bid * 8 + F.wave;
        f32x4 v[2][8]; u32x2 yw[2][8]; float ssy[2], ss[2] = {0.f, 0.f};
#pragma unroll
        for (int j = 0; j < 2; ++j) { const int r = t + (k0 + j) * 2048; ssy[j] = F.lane < 32 ? rss[(size_t)r * 32 + F.lane] : 0.f;
#pragma unroll
            for (int i = 0; i < 8; ++i) { const int col = (i * 64 + F.lane) * 4; v[j][i] = *(const f32x4*)(F.in[I_X] + (size_t)r * D + col); yw[j][i] = *(const u32x2*)(Y + (size_t)r * D + col); } }
        f32x4 pp[8];
#pragma unroll
        for (int i = 0; i < 8; ++i) pp[i] = pos4(pt, t, (i * 64 + F.lane) * 4);
#pragma unroll
        for (int j = 0; j < 2; ++j) { const float rstdy = rsqrtf(wave_sum(ssy[j]) * (1.0f / D) + EPS);
#pragma unroll
            for (int i = 0; i < 8; ++i) { const int col = (i * 64 + F.lane) * 4;
                const f32x4 yv = (f32x4){bf_lo(yw[j][i].x), bf_hi(yw[j][i].x), bf_lo(yw[j][i].y), bf_hi(yw[j][i].y)};
                v[j][i] = v[j][i] + pp[i] + *(const LAS f32x4*)(L + (j * 3 + 0) * 2048 + col) * (yv * rstdy);
                ss[j] += v[j][i][0] * v[j][i][0] + v[j][i][1] * v[j][i][1] + v[j][i][2] * v[j][i][2] + v[j][i][3] * v[j][i][3]; } }
#pragma unroll
        for (int j = 0; j < 2; ++j) { const int r = t + (k0 + j) * 2048; const float rstd = rsqrtf(wave_sum(ss[j]) * (1.0f / D) + EPS);
#pragma unroll
            for (int i = 0; i < 8; ++i) { const int col = (i * 64 + F.lane) * 4;
                const f32x4 h = (v[j][i] * rstd) * *(const LAS f32x4*)(L + (j * 3 + 1) * 2048 + col) + *(const LAS f32x4*)(L + (j * 3 + 2) * 2048 + col);
                u32x2 w; w.x = cvt_pk_bf16(h[0], h[1]); w.y = cvt_pk_bf16(h[2], h[3]);
                *(u32x2*)(H2 + (size_t)r * D + col) = w; } }
    }
    __syncthreads();
}
__device__ __forceinline__ void p7_norm2(const Frame& F) {
    const float* pt = (const float*)(F.ws + WS_POS); const float* mod = (const float*)(F.ws + WS_MOD);
    const bf16_t* Y = (const bf16_t*)(F.ws + WS_Y); const float* rss = (const float*)(F.ws + WS_RSS1); bf16_t* H2 = (bf16_t*)(F.ws + WS_H2);
    const float* gpost = F.in[I_GMIXPOST]; const float* gpre = F.in[I_GFFNPRE];
    const int nw = F.G * 8;
    for (int r0 = F.bid * 8 + F.wave; r0 < MLAT; r0 += 2 * nw) {
        f32x4 v[2][8]; float ssy[2], ss[2] = {0.f, 0.f};
#pragma unroll
        for (int j = 0; j < 2; ++j) { const int r = r0 + j * nw < MLAT ? r0 + j * nw : r0; ssy[j] = F.lane < 32 ? rss[(size_t)r * 32 + F.lane] : 0.f; }
        u32x2 yw[2][8];
#pragma unroll
        for (int j = 0; j < 2; ++j) { const int r = r0 + j * nw < MLAT ? r0 + j * nw : r0;
#pragma unroll
            for (int i = 0; i < 8; ++i) { const int col = (i * 64 + F.lane) * 4; v[j][i] = *(const f32x4*)(F.in[I_X] + (size_t)r * D + col); yw[j][i] = *(const u32x2*)(Y + (size_t)r * D + col); } }
#pragma unroll
        for (int j = 0; j < 2; ++j) { const int r = r0 + j * nw < MLAT ? r0 + j * nw : r0; const int b = r >> 11, t = r & 2047; const float* mrow = mod + (size_t)b * 12288;
            const float rstdy = rsqrtf(wave_sum(ssy[j]) * (1.0f / D) + EPS);
#pragma unroll
            for (int i = 0; i < 8; ++i) { const int col = (i * 64 + F.lane) * 4;
                const f32x4 yv = (f32x4){bf_lo(yw[j][i].x), bf_hi(yw[j][i].x), bf_lo(yw[j][i].y), bf_hi(yw[j][i].y)}, gp = *(const f32x4*)(gpost + col), gt = *(const f32x4*)(mrow + 4096 + col);
                v[j][i] = v[j][i] + pos4(pt, t, col) + gt * (yv * rstdy * gp);
                ss[j] += v[j][i][0] * v[j][i][0] + v[j][i][1] * v[j][i][1] + v[j][i][2] * v[j][i][2] + v[j][i][3] * v[j][i][3]; } }
#pragma unroll
        for (int j = 0; j < 2; ++j) { const int r = r0 + j * nw; if (r >= MLAT) break; const int b = r >> 11; const float* mrow = mod + (size_t)b * 12288;
            const float rstd = rsqrtf(wave_sum(ss[j]) * (1.0f / D) + EPS);
#pragma unroll
            for (int i = 0; i < 8; ++i) { const int col = (i * 64 + F.lane) * 4; const f32x4 gg = *(const f32x4*)(gpre + col), sh = *(const f32x4*)(mrow + 6144 + col), sc = *(const f32x4*)(mrow + 8192 + col);
                const f32x4 h = (v[j][i] * rstd * gg) * (1.0f + sc) + sh; u32x2 w; w.x = cvt_pk_bf16(h[0], h[1]); w.y = cvt_pk_bf16(h[2], h[3]);
                *(u32x2*)(H2 + (size_t)r * D + col) = w; } }
    }
}

__device__ __forceinline__ void fixup_panel(const Frame& F, int pm) {
    const float* edge = (const float*)(F.ws + WS_EDGE); bf16_t* act = (bf16_t*)(F.ws + WS_ACT);
    const float* cw = F.in[I_CFW]; const float* cb = F.in[I_CFB];
    const int tb = pm & 7;
    for (int idx = F.tid; idx < 2 * 1408; idx += 512) {
        const int e = idx >= 1408, c = (idx - e * 1408) * 4;
        const f32x4 z = (f32x4){0.f, 0.f, 0.f, 0.f};
        f32x4 gp, gc, gn, vp, vc, vn;
        if (e == 0) { const float* pr = edge + ((size_t)(pm - 1) * 4 + 3) * DFF2; const float* cu = edge + ((size_t)pm * 4 + 0) * DFF2; const float* nx = edge + ((size_t)pm * 4 + 1) * DFF2;
            gp = tb ? *(const f32x4*)(pr + c) : z; vp = tb ? *(const f32x4*)(pr + DFF + c) : z; gc = *(const f32x4*)(cu + c); vc = *(const f32x4*)(cu + DFF + c); gn = *(const f32x4*)(nx + c); vn = *(const f32x4*)(nx + DFF + c); }
        else { const float* pr = edge + ((size_t)pm * 4 + 2) * DFF2; const float* cu = edge + ((size_t)pm * 4 + 3) * DFF2; const float* nx = edge + ((size_t)(pm + 1) * 4 + 0) * DFF2;
            gp = *(const f32x4*)(pr + c); vp = *(const f32x4*)(pr + DFF + c); gc = *(const f32x4*)(cu + c); vc = *(const f32x4*)(cu + DFF + c); gn = tb != 7 ? *(const f32x4*)(nx + c) : z; vn = tb != 7 ? *(const f32x4*)(nx + DFF + c) : z; }
        const f32x4 gg = *(const f32x4*)(cb + c) + *(const f32x4*)(cw + c) * gp + *(const f32x4*)(cw + DFF2 + c) * gc + *(const f32x4*)(cw + 2 * DFF2 + c) * gn;
        const f32x4 vv = *(const f32x4*)(cb + DFF + c) + *(const f32x4*)(cw + DFF + c) * vp + *(const f32x4*)(cw + DFF2 + DFF + c) * vc + *(const f32x4*)(cw + 2 * DFF2 + DFF + c) * vn;
        u32x2 w; w.x = cvt_pk_bf16(gelu_tanh(gg[0]) * vv[0], gelu_tanh(gg[1]) * vv[1]); w.y = cvt_pk_bf16(gelu_tanh(gg[2]) * vv[2], gelu_tanh(gg[3]) * vv[3]);
        *(u32x2*)(act + (size_t)(pm * 256 + (e ? 255 : 0)) * DFF + c) = w;
    }
}

__device__ __forceinline__ void final_phase_staged(const Frame& F) {
    const float* pt = (const float*)(F.ws + WS_POS); const float* mod = (const float*)(F.ws + WS_MOD);
    const bf16_t* Y = (const bf16_t*)(F.ws + WS_Y); const bf16_t* Y2 = (const bf16_t*)(F.ws + WS_Y2);
    const float* rss1 = (const float*)(F.ws + WS_RSS1); const float* rss2 = (const float*)(F.ws + WS_RSS2);
    const float* gpost1 = F.in[I_GMIXPOST]; const float* gpost2 = F.in[I_GFFNPOST];
    LAS float* L = (LAS float*)F.lds;
    for (int k0 = 0; k0 < NB; k0 += 2) {
        __syncthreads();
        for (int e = F.tid; e < 2 * 512; e += 512) { const int j = e >> 9, c4 = (e & 511) * 4; const float* mrow = mod + (size_t)(k0 + j) * 12288;
            *(LAS f32x4*)(L + (j * 2 + 0) * 2048 + c4) = *(const f32x4*)(mrow + 4096 + c4) * *(const f32x4*)(gpost1 + c4);
            *(LAS f32x4*)(L + (j * 2 + 1) * 2048 + c4) = *(const f32x4*)(mrow + 10240 + c4) * *(const f32x4*)(gpost2 + c4); }
        __syncthreads();
        const int t = F.bid * 8 + F.wave;
        f32x4 xv[2][8]; u32x2 y1[2][8], y2[2][8]; float s1[2], s2[2];
#pragma unroll
        for (int j = 0; j < 2; ++j) { const int r = t + (k0 + j) * 2048; s1[j] = F.lane < 32 ? rss1[(size_t)r * 32 + F.lane] : 0.f; s2[j] = F.lane < 32 ? rss2[(size_t)r * 32 + F.lane] : 0.f;
#pragma unroll
            for (int i = 0; i < 8; ++i) { const int col = (i * 64 + F.lane) * 4; xv[j][i] = *(const f32x4*)(F.in[I_X] + (size_t)r * D + col); y1[j][i] = *(const u32x2*)(Y + (size_t)r * D + col); y2[j][i] = *(const u32x2*)(Y2 + (size_t)r * D + col); } }
        f32x4 pp[8];
#pragma unroll
        for (int i = 0; i < 8; ++i) pp[i] = pos4(pt, t, (i * 64 + F.lane) * 4);
#pragma unroll
        for (int j = 0; j < 2; ++j) { const int r = t + (k0 + j) * 2048;
            const float rstd1 = rsqrtf(wave_sum(s1[j]) * (1.0f / D) + EPS), rstd2 = rsqrtf(wave_sum(s2[j]) * (1.0f / D) + EPS);
#pragma unroll
            for (int i = 0; i < 8; ++i) { const int col = (i * 64 + F.lane) * 4;
                const f32x4 a1 = (f32x4){bf_lo(y1[j][i].x), bf_hi(y1[j][i].x), bf_lo(y1[j][i].y), bf_hi(y1[j][i].y)}, a2 = (f32x4){bf_lo(y2[j][i].x), bf_hi(y2[j][i].x), bf_lo(y2[j][i].y), bf_hi(y2[j][i].y)};
                __builtin_nontemporal_store(xv[j][i] + pp[i] + *(const LAS f32x4*)(L + (j * 2 + 0) * 2048 + col) * (a1 * rstd1) + *(const LAS f32x4*)(L + (j * 2 + 1) * 2048 + col) * (a2 * rstd2), (f32x4*)(F.out + (size_t)r * D + col)); } }
    }
    __syncthreads();
}
__device__ __forceinline__ void final_phase(const Frame& F) {
    const float* pt = (const float*)(F.ws + WS_POS); const float* mod = (const float*)(F.ws + WS_MOD);
    const bf16_t* Y = (const bf16_t*)(F.ws + WS_Y); const bf16_t* Y2 = (const bf16_t*)(F.ws + WS_Y2);
    const float* rss1 = (const float*)(F.ws + WS_RSS1); const float* rss2 = (const float*)(F.ws + WS_RSS2);
    const float* gpost1 = F.in[I_GMIXPOST]; const float* gpost2 = F.in[I_GFFNPOST];
    for (int r = F.bid * 8 + F.wave; r < MLAT; r += F.G * 8) {
        const int b = r >> 11, t = r & 2047; const float* mrow = mod + (size_t)b * 12288;
        float s1 = F.lane < 32 ? rss1[(size_t)r * 32 + F.lane] : 0.f, s2 = F.lane < 32 ? rss2[(size_t)r * 32 + F.lane] : 0.f;
        s1 = wave_sum(s1); s2 = wave_sum(s2);
        const float rstd1 = rsqrtf(s1 * (1.0f / D) + EPS), rstd2 = rsqrtf(s2 * (1.0f / D) + EPS);
#pragma unroll
        for (int i = 0; i < 8; ++i) { const int col = (i * 64 + F.lane) * 4;
            const f32x4 xv = *(const f32x4*)(F.in[I_X] + (size_t)r * D + col) + pos4(pt, t, col);
            const f32x4 y1 = ld_bf4(Y + (size_t)r * D + col), y2 = ld_bf4(Y2 + (size_t)r * D + col);
            const f32x4 g1 = *(const f32x4*)(gpost1 + col), g2 = *(const f32x4*)(gpost2 + col), gt1 = *(const f32x4*)(mrow + 4096 + col), gt2 = *(const f32x4*)(mrow + 10240 + col);
            __builtin_nontemporal_store(xv + gt1 * (y1 * rstd1 * g1) + gt2 * (y2 * rstd2 * g2), (f32x4*)(F.out + (size_t)r * D + col)); }
    }
}

constexpr int N_PHASES = 13;
__global__ void __launch_bounds__(512, 2) hybrid_fwd(Args args) {
    extern __shared__ __attribute__((aligned(16))) unsigned char lds_raw[];
    Frame F; F.in = args.in; F.out = args.out; F.ws = args.ws; F.lds = (LAS unsigned char*)lds_raw;
    F.tid = threadIdx.x; F.lane = F.tid & 63; F.wave = __builtin_amdgcn_readfirstlane(F.tid >> 6); F.G = gridDim.x; F.bid = blockIdx.x;
    const int lo = args.ph_lo, hi = args.ph_hi;
#ifndef DUP_PHASE
#define DUP_PHASE -1
#endif
#define NREP(k) ((k) == DUP_PHASE ? 2 : 1)
#define IN(k) (lo <= (k) && (k) < hi)
#define SEAM(k) do { if (IN(k) && IN((k) + 1)) xcd_barrier(bar); } while (0)
    unsigned char* ws = args.ws;
    if (lo < 0) cg::this_grid().sync();
    if (F.tid < 16) ((LAS unsigned*)(F.lds + LDS_BAR))[F.tid] = 0u;
    __syncthreads();
    XcdBarrier bar; bar.bar = (unsigned*)ws; bar.x = 0; bar.st = (volatile LAS unsigned*)(F.lds + LDS_BAR);
    if (hi - lo > 1) bar = xcd_barrier_post((unsigned*)ws, (volatile LAS unsigned*)(F.lds + LDS_BAR));
    if (IN(0)) for (int rep_ = 0; rep_ < NREP(0); ++rep_) p0_prologue(F);
    SEAM(0);
    if (IN(1)) p1_norm(F, MLAT, MALL, 0, F.G);
    SEAM(1);
    if (IN(2)) {
        if (F.G >= 64) {
            if (F.bid < 32) { pg8::Gemm g{D, D, D, (size_t)128 * D * 2, (size_t)128 * D * 2};
                SchedWin S{(const bf16_t*)(ws + WS_H), (const bf16_t*)(ws + WS_WIN), 32, F.bid, 768, 800};
                EpiWin E{(bf16_t*)(ws + WS_UF)};
                pg8::gemm_phase(F.lds, g, S, E); }
            else if (((F.G - 32) & 7) == 0) p1_latent_staged(F, 32, F.G - 32); else p1_norm(F, 0, MLAT, 32, F.G - 32);
        } else { p1_norm(F, 0, MLAT, 0, F.G); }
    }
    SEAM(2);
    if (IN(3)) for (int rep_ = 0; rep_ < NREP(3); ++rep_) { pg8::Gemm g{D, D, D, (size_t)128 * D * 2, (size_t)128 * D * 2};
        SchedWin S{(const bf16_t*)(ws + WS_H), (const bf16_t*)(ws + WS_WIN), F.G, F.bid, 0, F.G >= 64 ? 768 : 800};
        EpiWin E{(bf16_t*)(ws + WS_UF)};
        pg8::gemm_phase(F.lds, g, S, E); }
    SEAM(3);
    if (IN(4)) { { pg8::Gemm g{256, 1024, 256, (size_t)128 * 256 * 2, (size_t)128 * 1024 * 2};
        SchedPQ S{(const bf16_t*)(ws + WS_WCS), (const bf16_t*)(ws + WS_UF), F.G, F.bid};
        EpiPQ E{(bf16_t*)(ws + WS_PQT)};
        pg8::gemm_phase(F.lds, g, S, E); }
        lru_phase(F); if (DUP_PHASE == 4) lru_phase(F); }
    SEAM(4);
    if (IN(5)) for (int rep_ = 0; rep_ < NREP(5); ++rep_) { pg8::Gemm g{2048, 2048, 2048, (size_t)128 * 2048 * 2, (size_t)128 * 2048 * 2};
        SchedDFT S{(const bf16_t*)(ws + WS_CTAB), (const bf16_t*)(ws + WS_STAB), (const bf16_t*)(ws + WS_PQT), F.G, F.bid};
        EpiDFT E{(bf16_t*)(ws + WS_CPSQ)};
        pg8::gemm_phase(F.lds, g, S, E);
        alt_phase(F); }
    SEAM(5);
    if (IN(6)) for (int rep_ = 0; rep_ < NREP(6); ++rep_) assemble_phase(F);
    SEAM(6);
    if (IN(7)) for (int rep_ = 0; rep_ < NREP(7); ++rep_) { pg8::Gemm g{D, D, D, (size_t)128 * D * 2, (size_t)128 * D * 2};
        SchedStd S{(const bf16_t*)(ws + WS_YA), (const bf16_t*)(ws + WS_WOUT), 64, 8, D, D, F.G, F.bid, OUTREP};
        EpiY E{(bf16_t*)(ws + WS_Y), (float*)(ws + WS_RSS1)};
        pg8::gemm_phase(F.lds, g, S, E); }
    SEAM(7);
    if (IN(8)) for (int rep_ = 0; rep_ < NREP(8); ++rep_) { if (F.G == 256) p7_norm2_staged(F); else p7_norm2(F); }
    SEAM(8);
    if (IN(9)) for (int rep_ = 0; rep_ < NREP(9); ++rep_) { pg8::Gemm g{D, D, D, (size_t)128 * D * 2, (size_t)DFF * D * 2};
        if (F.tid < 256) { ((LAS float*)(F.lds + LDS_EDGE))[F.tid] = 0.f; ((LAS float*)(F.lds + LDS_EDGE))[9 * 256 + F.tid] = 0.f; }
        __syncthreads();
        SchedUp S{(const bf16_t*)(ws + WS_H2), (const bf16_t*)(ws + WS_WUP), F.G, F.bid};
        EpiUpConv E{(bf16_t*)(ws + WS_ACT), (float*)(ws + WS_EDGE), F.in[I_CFW], F.in[I_CFB], F.lds};
        pg8::gemm_phase(F.lds, g, S, E); }
    if (IN(9) && IN(11)) xcd_barrier(bar);
    if (IN(11)) for (int rep_ = 0; rep_ < NREP(11); ++rep_) { pg8::Gemm g{DFF, DFF, DFF, (size_t)128 * DFF * 2, (size_t)128 * DFF * 2};
        SchedStd S{(const bf16_t*)(ws + WS_ACT), (const bf16_t*)(ws + WS_WDOWN), 64, 8, DFF, DFF, F.G, F.bid, DOWNREP};
        { pg8::Unit u; int last = -1;
          for (int i = 0; S.next(i, u); ++i) if (u.pm != last) { fixup_panel(F, u.pm); last = u.pm; }
          asm volatile("s_waitcnt vmcnt(0)" ::: "memory"); __syncthreads(); }
        EpiY E{(bf16_t*)(ws + WS_Y2), (float*)(ws + WS_RSS2)};
        pg8::gemm_phase(F.lds, g, S, E); }
    SEAM(11);
    if (IN(12)) for (int rep_ = 0; rep_ < NREP(12); ++rep_) { if (F.G == 256) final_phase_staged(F); else final_phase(F); }
#undef IN
#undef SEAM
}

extern "C" void kernel_launch(void* const* d_in, const int* in_sizes, int n_in, void* d_out, int out_size, void* d_ws, size_t ws_size, hipStream_t stream) {
    static int grid = 0;
    if (grid == 0) {
        if (n_in != 25 || out_size != MLAT * D || ws_size < WS_NEED) { fprintf(stderr, "kernel_launch: unexpected shapes n_in %d out %d ws %zu\n", n_in, out_size, ws_size); grid = -1; return; }
        int dev = 0, cus = 0, per_cu = 0;
        hipGetDevice(&dev); hipDeviceGetAttribute(&cus, hipDeviceAttributeMultiprocessorCount, dev);
        if (hipFuncSetAttribute((const void*)hybrid_fwd, hipFuncAttributeMaxDynamicSharedMemorySize, LDS_BYTES) != hipSuccess) { fprintf(stderr, "kernel_launch: hipFuncSetAttribute failed\n"); grid = -1; return; }
        if (hipOccupancyMaxActiveBlocksPerMultiprocessor(&per_cu, (const void*)hybrid_fwd, 512, LDS_BYTES) != hipSuccess || per_cu < 1) { fprintf(stderr, "kernel_launch: occupancy query failed (%d)\n", per_cu); (void)hipGetLastError(); per_cu = 1; }
        grid = cus * 1;
        if (grid % 8 != 0 || grid <= 0) grid = (grid / 8) * 8;
        fprintf(stderr, "kernel_launch: cus %d per_cu %d grid %d\n", cus, per_cu, grid);
    }
    if (grid <= 0) return;
    if (hipMemsetAsync(d_ws, 0, XCD_BAR_WORDS * 4, stream) != hipSuccess) { fprintf(stderr, "kernel_launch: memset of barrier words failed\n"); return; }
    Args a{};
    for (int i = 0; i < 25; ++i) a.in[i] = (const float*)d_in[i];
    a.out = (float*)d_out; a.ws = (unsigned char*)d_ws;
#if N_LAUNCH_MODE == 1
    a.ph_lo = 0; a.ph_hi = N_PHASES;
    void* kargs[] = {&a};
    hipError_t e = hipLaunchCooperativeKernel((const void*)hybrid_fwd, dim3(grid), dim3(512), kargs, LDS_BYTES, stream);
    if (e != hipSuccess) fprintf(stderr, "cooperative launch failed: %s (grid %d)\n", hipGetErrorString(e), grid);
#else
    for (int p = 0; p < N_PHASES; ++p) { a.ph_lo = p; a.ph_hi = p + 1; hipLaunchKernelGGL(hybrid_fwd, dim3(grid), dim3(512), LDS_BYTES, stream, a); }
#endif
}
```

```cpp
#include <hip/hip_runtime.h>
#include <hip/hip_cooperative_groups.h>
#include <cstdio>
#include <cstdint>
namespace cg = cooperative_groups;

#ifndef N_LAUNCH_MODE
#define N_LAUNCH_MODE 1
#endif

#define LAS __attribute__((address_space(3)))
typedef unsigned short bf16_t;
typedef short bf16x8 __attribute__((ext_vector_type(8)));
typedef float f32x4 __attribute__((ext_vector_type(4)));
typedef float f32x2 __attribute__((ext_vector_type(2)));
typedef unsigned u32x4 __attribute__((ext_vector_type(4)));
typedef unsigned u32x2 __attribute__((ext_vector_type(2)));

constexpr int D = 2048, NB = 8, SEQ = 2048, CTXL = 256, DFF = 5632, DFF2 = 11264;
constexpr int MLAT = NB * SEQ, MCTX = NB * CTXL, MALL = MLAT + MCTX;
constexpr int DLRU = 1024, DFOU = 1024, NPROJ = 3072;
constexpr int NCHUNK = 36;
constexpr float EPS = 1e-6f;

constexpr size_t MiB = 1u << 20;
constexpr size_t WS_MOD = 1 * MiB;
constexpr size_t WS_POS = 2 * MiB;
constexpr size_t WS_RSS1 = 3 * MiB;
constexpr size_t WS_RSS2 = 5 * MiB;
constexpr size_t WS_AGG = 7 * MiB;
constexpr size_t WS_Y1024 = 11 * MiB + 512 * 1024;
constexpr size_t WS_K2 = 11 * MiB + 768 * 1024;
constexpr size_t WS_WUP = 12 * MiB;
constexpr size_t WS_WDOWN = 56 * MiB;
constexpr size_t WS_WIN = 78 * MiB;
constexpr size_t WS_WOUT = 90 * MiB;
constexpr size_t WS_CTAB = 98 * MiB;
constexpr size_t WS_STAB = 102 * MiB;
constexpr size_t WS_WG = 106 * MiB;
constexpr size_t WS_WCS = 107 * MiB;
constexpr size_t WS_H = 108 * MiB;
constexpr size_t WS_UF = 180 * MiB;
constexpr size_t WS_UX = 212 * MiB;
constexpr size_t WS_UG = 248 * MiB;
constexpr size_t WS_S = 280 * MiB;
constexpr size_t WS_PF = 312 * MiB;
constexpr size_t WS_PB = 344 * MiB;
constexpr size_t WS_PQT = 108 * MiB;
constexpr size_t WS_CPSQ = 376 * MiB;
constexpr size_t WS_YA = 108 * MiB;
constexpr size_t WS_Y = 384 * MiB;
constexpr size_t WS_H2 = 78 * MiB;
constexpr size_t WS_ACT = 142 * MiB;
constexpr size_t WS_EDGE = 318 * MiB;
constexpr size_t WS_Y2 = 448 * MiB;
constexpr size_t WS_NEED = 512 * MiB;

constexpr int LDS_BAR = 152576;
constexpr int LDS_BYTES = 152576 + 64;
static_assert(WS_UX - WS_UF == 32 * MiB && WS_UG - WS_UF == 68 * MiB && WS_STAB - WS_CTAB == 4 * MiB, "pointer arithmetic in EpiWin / SchedDFT");

#define LDS_BARRIER() do { asm volatile("s_waitcnt lgkmcnt(0)" ::: "memory"); __builtin_amdgcn_s_barrier(); asm volatile("" ::: "memory"); } while (0)
__device__ __forceinline__ unsigned cvt_pk_bf16(float lo, float hi) { unsigned r; asm volatile("v_cvt_pk_bf16_f32 %0, %1, %2" : "=v"(r) : "v"(lo), "v"(hi)); return r; }
__device__ __forceinline__ float bf_lo(unsigned w) { return __uint_as_float(w << 16); }
__device__ __forceinline__ float bf_hi(unsigned w) { return __uint_as_float(w & 0xffff0000u); }
__device__ __forceinline__ float fast_sigmoid(float z) { return __builtin_amdgcn_rcpf(1.0f + __builtin_amdgcn_exp2f(-1.44269504f * z)); }
__device__ __forceinline__ float gelu_tanh(float x) { const float u = x * (1.0f + 0.044715f * x * x); return x * __builtin_amdgcn_rcpf(1.0f + __builtin_amdgcn_exp2f(-2.302208198f * u)); }
__device__ __forceinline__ float wave_sum(float v) { for (int o = 32; o >= 1; o >>= 1) v += __shfl_xor(v, o); return v; }
__device__ __forceinline__ u32x4 pack8(const float (&v)[8]) { u32x4 w; w.x = cvt_pk_bf16(v[0], v[1]); w.y = cvt_pk_bf16(v[2], v[3]); w.z = cvt_pk_bf16(v[4], v[5]); w.w = cvt_pk_bf16(v[6], v[7]); return w; }
__device__ __forceinline__ void unpack8(const u32x4 w, float (&v)[8]) { v[0] = bf_lo(w.x); v[1] = bf_hi(w.x); v[2] = bf_lo(w.y); v[3] = bf_hi(w.y); v[4] = bf_lo(w.z); v[5] = bf_hi(w.z); v[6] = bf_lo(w.w); v[7] = bf_hi(w.w); }

namespace pg8 {
constexpr int BM = 256, BK = 64, HALF = 128, HTB = HALF * BK * 2, STAGE_BYTES = 8 * HTB, NXCD = 8;
__host__ __device__ __forceinline__ int lds_byte(int r, int c) { const int st = (r >> 4) * 2 + (c >> 5), rr = r & 15, cc = c & 31, ob = rr * 64 + cc * 2; return st * 1024 + (ob ^ (((ob >> 9) & 1) << 5)); }
__host__ __device__ __forceinline__ void stage_rc(int b, int& R, int& C) { const int st = b / 1024, sb = b % 1024, swz = sb ^ (((sb >> 9) & 1) << 5); R = (st >> 1) * 16 + swz / 64; C = (st & 1) * 32 + (swz % 64) / 2; }
__host__ __device__ __forceinline__ int perm32(int rho) { const int n = rho >> 4, i = rho & 15; return 8 * (i >> 2) + 4 * n + (i & 3); }

struct Unit { int pm, pn, z; };
struct Gemm { int lda, ldb, K; size_t hstepA, hstepB; };

__device__ __forceinline__ void std_order(int L, int nM, int nN, int& pm, int& pn, const int WGM = 8) {
    const int nwg = nM * nN; int wgid = L;
    { const int q = nwg / NXCD, r = nwg % NXCD, xcd = wgid % NXCD, off = wgid / NXCD; wgid = (xcd < r ? xcd * (q + 1) : r * (q + 1) + (xcd - r) * q) + off; }
    const int nig = WGM * nN, gid = wgid / nig, fm = gid * WGM, gsz = (nM - fm) < WGM ? (nM - fm) : WGM;
    pm = fm + ((wgid % nig) % gsz); pn = (wgid % nig) / gsz;
}

__device__ __forceinline__ void store_tile_bf16(const f32x4 (&acc)[2][2][4][2], bf16_t* tile, size_t ldc, int wr, int wc, int fr, int fq) {
    bf16_t* p0 = tile + (size_t)(wr * 64 + fr) * ldc + wc * 32 + 8 * fq;
#pragma unroll
    for (int ai = 0; ai < 2; ++ai)
#pragma unroll
        for (int m = 0; m < 4; ++m) { bf16_t* rowp = p0 + (size_t)(ai * HALF + m * 16) * ldc;
#pragma unroll
            for (int bj = 0; bj < 2; ++bj) { const f32x4 v0 = acc[ai][bj][m][0], v1 = acc[ai][bj][m][1];
                u32x4 w; w.x = cvt_pk_bf16(v0[0], v0[1]); w.y = cvt_pk_bf16(v0[2], v0[3]); w.z = cvt_pk_bf16(v1[0], v1[1]); w.w = cvt_pk_bf16(v1[2], v1[3]);
                *(u32x4*)(rowp + bj * HALF) = w; } }
}
__device__ __forceinline__ void store_tile_f32(const f32x4 (&acc)[2][2][4][2], float* tile, size_t ldc, int wr, int wc, int fr, int fq) {
    float* p0 = tile + (size_t)(wr * 64 + fr) * ldc + wc * 32 + 4 * fq;
#pragma unroll
    for (int ai = 0; ai < 2; ++ai)
#pragma unroll
        for (int m = 0; m < 4; ++m) { float* rowp = p0 + (size_t)(ai * HALF + m * 16) * ldc;
#pragma unroll
            for (int bj = 0; bj < 2; ++bj)
#pragma unroll
                for (int n = 0; n < 2; ++n) *(f32x4*)(rowp + bj * HALF + n * 16) = acc[ai][bj][m][n]; }
}

template <class Epi, class Sched>
__device__ __forceinline__ void gemm_phase(LAS unsigned char* lds, const Gemm g, const Sched& S, const Epi& E) {
    const int tid = threadIdx.x, wid = __builtin_amdgcn_readfirstlane(tid >> 6), lane = tid & 63, wr = wid >> 2, wc = wid & 3, fr = lane & 15, fq = lane >> 4;
    const int K = g.K, nt = K / BK;
    unsigned voffA[2], voffB[2];
#pragma unroll
    for (int i = 0; i < 2; ++i) { int R, C; stage_rc(tid * 16 + i * 8192, R, C); const int Rb = Epi::PERM ? ((R & ~31) + perm32(R & 31)) : R;
        const int Ra = Epi::PERMA ? ((R & ~63) + 4 * (R & 15) + ((R >> 4) & 3)) : R;
        voffA[i] = (unsigned)(Ra * g.lda + C) * 2u; voffB[i] = (unsigned)(Rb * g.ldb + C) * 2u; }
    const size_t kstep = (size_t)(BK * 2);
    const size_t hstepA = g.hstepA, hstepB = g.hstepB;
    const unsigned ldsw = (unsigned)wid * 1024u;
    const int aoff = lds_byte(wr * 64 + fr, fq * 8), boff = lds_byte(wc * 32 + fr, fq * 8);
#define PG8_SA(b, h) (((b) * 2 + (h)) * HTB)
#define PG8_SB(b, h) ((4 + (b) * 2 + (h)) * HTB)
#define PG8_STAGE(bufoff, gbase, voff) do { _Pragma("unroll") for (int _i = 0; _i < 2; ++_i) \
        __builtin_amdgcn_global_load_lds((const unsigned*)((const char*)(gbase) + (voff)[_i]), (LAS unsigned*)(lds + (bufoff) + ldsw + _i * 8192), 16, 0, 0); } while (0)
#define PG8_LDA(dst, b, h) do { _Pragma("unroll") for (int m = 0; m < 4; ++m) _Pragma("unroll") for (int k = 0; k < 2; ++k) dst[m][k] = *(const LAS bf16x8*)(lds + PG8_SA(b, h) + aoff + m * 2048 + k * 1024); } while (0)
#define PG8_LDB(dst, b, h) do { _Pragma("unroll") for (int n = 0; n < 2; ++n) _Pragma("unroll") for (int k = 0; k < 2; ++k) dst[n][k] = *(const LAS bf16x8*)(lds + PG8_SB(b, h) + boff + n * 2048 + k * 1024); } while (0)
#define PG8_MMA(ai, bj, At, Bt) do { __builtin_amdgcn_s_setprio(1); _Pragma("unroll") for (int m = 0; m < 4; ++m) _Pragma("unroll") for (int n = 0; n < 2; ++n) _Pragma("unroll") for (int k = 0; k < 2; ++k) \
        acc[ai][bj][m][n] = __builtin_amdgcn_mfma_f32_16x16x32_bf16(Bt[n][k], At[m][k], acc[ai][bj][m][n], 0, 0, 0); __builtin_amdgcn_s_setprio(0); } while (0)
#define PG8_WAIT_V(n) asm volatile("s_waitcnt vmcnt(" #n ")" ::: "memory")
#define PG8_WAIT_L(n) asm volatile("s_waitcnt lgkmcnt(" #n ")" ::: "memory")
#define PG8_BAR __builtin_amdgcn_s_barrier()
#define PG8_SCHED __builtin_amdgcn_sched_barrier(0)
    Unit cur, nxt; int ui = 0;
    if (!S.next(0, cur)) return;
    f32x4 acc[2][2][4][2];
#pragma unroll
    for (int a = 0; a < 2; ++a)
#pragma unroll
        for (int b = 0; b < 2; ++b)
#pragma unroll
            for (int m = 0; m < 4; ++m)
#pragma unroll
                for (int n = 0; n < 2; ++n) acc[a][b][m][n] = (f32x4){0.f, 0.f, 0.f, 0.f};
    bf16x8 At[4][2], B0[2][2], B1[2][2];
    const char* cA; const char* cB; S.ptrs(cur, cA, cB);
    PG8_STAGE(PG8_SB(0, 0), cB, voffB); PG8_STAGE(PG8_SB(0, 1), cB + hstepB, voffB); PG8_STAGE(PG8_SA(0, 0), cA, voffA); PG8_STAGE(PG8_SA(0, 1), cA + hstepA, voffA);
    if (wr == 1) PG8_BAR;
    PG8_WAIT_V(2); PG8_BAR;
    PG8_STAGE(PG8_SB(1, 0), cB + kstep, voffB); PG8_STAGE(PG8_SA(1, 0), cA + kstep, voffA); PG8_STAGE(PG8_SB(1, 1), cB + hstepB + kstep, voffB);
    PG8_WAIT_V(6); PG8_BAR;
    for (;;) {
        const bool has_next = S.next(ui + 1, nxt);
        const char* nA = cA; const char* nB = cB; if (has_next) S.ptrs(nxt, nA, nB);
#pragma unroll 1
        for (int t = 0; t < nt; t += 2) {
            const bool last = (t == nt - 2);
            const char* a1 = cA + (size_t)(t + 1) * kstep;
            const char* a2 = last ? nA : cA + (size_t)(t + 2) * kstep; const char* b2 = last ? nB : cB + (size_t)(t + 2) * kstep;
            const char* a3 = a2 + kstep; const char* b3 = b2 + kstep;
            PG8_LDB(B0, 0, 0); PG8_LDB(B1, 0, 1); PG8_SCHED; PG8_LDA(At, 0, 0); PG8_STAGE(PG8_SA(1, 1), a1 + hstepA, voffA);
            PG8_WAIT_V(8); PG8_WAIT_L(0); PG8_BAR; PG8_MMA(0, 0, At, B0); PG8_MMA(0, 1, At, B1); PG8_BAR; PG8_SCHED;
            PG8_LDA(At, 0, 1); PG8_STAGE(PG8_SB(0, 0), b2, voffB); PG8_STAGE(PG8_SB(0, 1), b2 + hstepB, voffB); PG8_STAGE(PG8_SA(0, 0), a2, voffA);
            PG8_WAIT_V(8); PG8_WAIT_L(0); PG8_BAR; PG8_MMA(1, 0, At, B0); PG8_MMA(1, 1, At, B1); PG8_BAR; PG8_SCHED;
            PG8_LDB(B0, 1, 0); PG8_LDB(B1, 1, 1); PG8_SCHED; PG8_LDA(At, 1, 0); PG8_STAGE(PG8_SA(0, 1), a2 + hstepA, voffA);
            PG8_WAIT_V(8); PG8_WAIT_L(0); PG8_BAR; PG8_MMA(0, 0, At, B0); PG8_MMA(0, 1, At, B1); PG8_BAR; PG8_SCHED;
            PG8_LDA(At, 1, 1); PG8_STAGE(PG8_SB(1, 0), b3, voffB); PG8_STAGE(PG8_SB(1, 1), b3 + hstepB, voffB); PG8_STAGE(PG8_SA(1, 0), a3, voffA);
            PG8_WAIT_V(8); PG8_WAIT_L(0); PG8_BAR; PG8_MMA(1, 0, At, B0); PG8_MMA(1, 1, At, B1); PG8_BAR; PG8_SCHED;
        }
        if (wr == 0) PG8_BAR;
        E(acc, cur, wr, wc, fr, fq);
        if (!has_next) break;
#pragma unroll
        for (int a = 0; a < 2; ++a)
#pragma unroll
            for (int b = 0; b < 2; ++b)
#pragma unroll
                for (int m = 0; m < 4; ++m)
#pragma unroll
                    for (int n = 0; n < 2; ++n) acc[a][b][m][n] = (f32x4){0.f, 0.f, 0.f, 0.f};
        cur = nxt; cA = nA; cB = nB; ++ui;
        if (wr == 1) PG8_BAR;
    }
    PG8_WAIT_V(0);
    PG8_BAR;
#undef PG8_SA
#undef PG8_SB
#undef PG8_STAGE
#undef PG8_LDA
#undef PG8_LDB
#undef PG8_MMA
#undef PG8_WAIT_V
#undef PG8_WAIT_L
#undef PG8_BAR
#undef PG8_SCHED
}
}

#define XB_TMO      128
#define XB_XCNT(j)  (256  + 64 * (j))
#define XB_XSUB(j)  (1280 + 64 * (j))
#define XB_XGEN(j)  (2304 + 64 * (j))
#define XB_TOP      3328
#define XB_TOPGEN   3392
#define XCD_BAR_WORDS 3456
#define XB_SPIN_CAP (1u << 18)
__device__ __forceinline__ unsigned xb_ld(unsigned* p)              { return __hip_atomic_load(p, __ATOMIC_RELAXED, __HIP_MEMORY_SCOPE_AGENT); }
__device__ __forceinline__ unsigned xb_add(unsigned* p, unsigned v) { return __hip_atomic_fetch_add(p, v, __ATOMIC_RELAXED, __HIP_MEMORY_SCOPE_AGENT); }
__device__ __forceinline__ unsigned xb_xcc_id() { return (unsigned)__builtin_amdgcn_s_getreg((3 << 11) | 20) & 0xFu; }
#define XB_SPIN(cond, bar) do { unsigned _sp = 0; while (cond) { __builtin_amdgcn_s_sleep(1); \
    if ((++_sp & 255u) == 0u) { if (xb_ld(&(bar)[XB_TMO])) break; if (_sp > XB_SPIN_CAP) { atomicAdd(&(bar)[XB_TMO], 1u); break; } } } } while (0)
struct XcdBarrier { unsigned* bar; unsigned x; volatile LAS unsigned* st; };
__device__ __forceinline__ XcdBarrier xcd_barrier_post(unsigned* bar, volatile LAS unsigned* st) {
    XcdBarrier b; b.bar = bar; b.x = xb_xcc_id(); b.st = st;
    if (threadIdx.x == 0) (void)xb_add(&bar[XB_XCNT(b.x)], 1u);
    return b;
}
__device__ __forceinline__ void xcd_barrier_complete(unsigned* bar, unsigned x, unsigned& nloc, unsigned& nx) {
    const unsigned G = gridDim.x * gridDim.y * gridDim.z;
    unsigned sum, cnt, mine, sp = 0u;
    for (;;) {
        sum = 0u; cnt = 0u; mine = 0u;
#pragma unroll
        for (unsigned j = 0; j < 16; ++j) { const unsigned c = xb_ld(&bar[XB_XCNT(j)]); sum += c; cnt += (c > 0u) ? 1u : 0u; mine = (j == x) ? c : mine; }
        if (sum == G) break;
        __builtin_amdgcn_s_sleep(1);
        if ((++sp & 255u) == 0u) { if (xb_ld(&bar[XB_TMO])) break; if (sp > XB_SPIN_CAP) { atomicAdd(&bar[XB_TMO], 1u); break; } }
    }
    nloc = mine > 0u ? mine : 1u; nx = cnt > 0u ? cnt : 1u;
}
__device__ __forceinline__ void xcd_barrier(const XcdBarrier& b) {
    asm volatile("s_waitcnt vmcnt(0)" ::: "memory");
    __syncthreads();
    if (threadIdx.x == 0) {
        unsigned* bar = b.bar;
        __builtin_amdgcn_s_waitcnt(0);
        unsigned nloc = b.st[0], nx = b.st[1];
        if (nloc == 0u) { xcd_barrier_complete(bar, b.x, nloc, nx); b.st[0] = nloc; b.st[1] = nx; }
        const unsigned old = xb_add(&bar[XB_XSUB(b.x)], 1u);
        const unsigned gen = old / nloc;
        if (old + 1u == (gen + 1u) * nloc) {
            __builtin_amdgcn_fence(__ATOMIC_RELEASE, "agent");
            asm volatile("s_waitcnt vmcnt(0)" ::: "memory");
            const unsigned og = xb_add(&bar[XB_TOP], 1u);
            const unsigned tg = og / nx;
            if (og + 1u == (tg + 1u) * nx) xb_add(&bar[XB_TOPGEN], 1u);
            else XB_SPIN(xb_ld(&bar[XB_TOPGEN]) == tg, bar);
            __builtin_amdgcn_fence(__ATOMIC_ACQUIRE, "agent");
            xb_add(&bar[XB_XGEN(b.x)], 1u);
            asm volatile("s_waitcnt vmcnt(0)" ::: "memory");
        } else {
            XB_SPIN(xb_ld(&bar[XB_XGEN(b.x)]) == gen, bar);
            __builtin_amdgcn_fence(__ATOMIC_ACQUIRE, "agent");
            asm volatile("s_waitcnt vmcnt(0)" ::: "memory");
        }
    }
    __syncthreads();
}

struct Args { const float* in[25]; float* out; unsigned char* ws; int ph_lo, ph_hi; };
struct Frame {
    const float* const* in; float* out; unsigned char* ws; LAS unsigned char* lds; int tid, lane, wave, G, bid;
};
enum { I_X = 0, I_C, I_CTX, I_CCTX, I_WADA, I_BADA, I_GMIXPRE, I_GMIXPOST, I_GFFNPRE, I_GFFNPOST, I_WIN, I_CLW, I_CLB, I_WREC, I_BREC, I_WING, I_BING, I_LAM, I_WFOU, I_BFOU, I_WOUT, I_WUP, I_CFW, I_CFB, I_WDOWN };

constexpr int IT_MOD = 192;
constexpr int IT_TR_WIN = 16 * 48, IT_TR_WOUT = 16 * 32, IT_TR_WUP = 16 * 176, IT_TR_WDOWN = 44 * 32, IT_TR_G = 64;
constexpr int IT_TR = IT_TR_WIN + IT_TR_WOUT + IT_TR_WUP + IT_TR_WDOWN + IT_TR_G;
constexpr int IT_TAB = 128, IT_WCS = 256, IT_POS = 96;

__device__ __forceinline__ void mod_item(const Frame& F, int it) {
    LAS float* sil = (LAS float*)F.lds;
    LAS float* red = (LAS float*)(F.lds + 73728);
    const float* c = F.in[I_C]; const float* cc = F.in[I_CCTX];
    for (int idx = F.tid; idx < 9 * 2048; idx += 512) { const int bb = idx >> 11, k = idx & 2047; const float v = bb < 8 ? c[bb * 2048 + k] : cc[k]; sil[idx] = v * fast_sigmoid(v); }
    __syncthreads();
    const int n0 = it * 64, rg = F.tid >> 4, l16 = F.tid & 15;
    const float* w = F.in[I_WADA] + n0 + l16 * 4;
    f32x4 acc[9];
#pragma unroll
    for (int b = 0; b < 9; ++b) acc[b] = (f32x4){0.f, 0.f, 0.f, 0.f};
    for (int i0 = 0; i0 < 64; i0 += 8) { f32x4 wv[8];
#pragma unroll
        for (int i = 0; i < 8; ++i) wv[i] = *(const f32x4*)(w + (size_t)(rg + 32 * (i0 + i)) * 12288);
#pragma unroll
        for (int i = 0; i < 8; ++i) { const int k = rg + 32 * (i0 + i);
#pragma unroll
            for (int b = 0; b < 9; ++b) acc[b] += sil[b * 2048 + k] * wv[i]; } }
#pragma unroll
    for (int b = 0; b < 9; ++b) *(LAS f32x4*)(red + (rg * 9 + b) * 64 + l16 * 4) = acc[b];
    __syncthreads();
    for (int o = F.tid; o < 576; o += 512) { const int bb = o >> 6, col = o & 63; float s = 0.f; for (int r = 0; r < 32; ++r) s += red[(r * 9 + bb) * 64 + col];
        ((float*)(F.ws + WS_MOD))[bb * 12288 + n0 + col] = s + F.in[I_BADA][n0 + col]; }
    __syncthreads();
}

struct TrDesc { const float* src; bf16_t* dst; int N, ldd, k0, n0; };
__device__ __forceinline__ TrDesc tr_decode(const Frame& F, int it) {
    TrDesc t;
    if (it < IT_TR_WIN) { t.src = F.in[I_WIN]; t.N = NPROJ; t.dst = (bf16_t*)(F.ws + WS_WIN); t.ldd = D; t.k0 = (it % 16) * 128; t.n0 = (it / 16) * 64; return t; }
    it -= IT_TR_WIN;
    if (it < IT_TR_WOUT) { t.src = F.in[I_WOUT]; t.N = D; t.dst = (bf16_t*)(F.ws + WS_WOUT); t.ldd = D; t.k0 = (it % 16) * 128; t.n0 = (it / 16) * 64; return t; }
    it -= IT_TR_WOUT;
    if (it < IT_TR_WUP) { t.src = F.in[I_WUP]; t.N = DFF2; t.dst = (bf16_t*)(F.ws + WS_WUP); t.ldd = D; t.k0 = (it % 16) * 128; t.n0 = (it / 16) * 64; return t; }
    it -= IT_TR_WUP;
    if (it < IT_TR_WDOWN) { t.src = F.in[I_WDOWN]; t.N = D; t.dst = (bf16_t*)(F.ws + WS_WDOWN); t.ldd = DFF; t.k0 = (it % 44) * 128; t.n0 = (it / 44) * 64; return t; }
    it -= IT_TR_WDOWN;
    { const int half = it & 1, mat = it >> 1, type = mat & 1, dir = (mat >> 1) & 1, h = mat >> 2;
      t.src = (type ? F.in[I_WING] : F.in[I_WREC]) + (size_t)(dir * 8 + h) * 128 * 128; t.N = 128;
      t.dst = (bf16_t*)(F.ws + WS_WG) + (size_t)(h * 512 + (dir * 2 + type) * 128) * 128; t.ldd = 128; t.k0 = 0; t.n0 = half * 64; }
    return t;
}
__device__ __forceinline__ void tr_load(const Frame& F, int it, f32x4 (&v)[4]) {
    const TrDesc t = tr_decode(F, it); const int kr0 = F.tid >> 4, c4 = F.tid & 15;
#pragma unroll
    for (int i = 0; i < 4; ++i) v[i] = *(const f32x4*)(t.src + (size_t)(t.k0 + kr0 + 32 * i) * t.N + t.n0 + c4 * 4);
}
__device__ __forceinline__ void tr_store(const Frame& F, int it, const f32x4 (&v)[4]) {
    const TrDesc t = tr_decode(F, it);
    LAS bf16_t* T = (LAS bf16_t*)F.lds;
    const int kr0 = F.tid >> 4, c4 = F.tid & 15;
#pragma unroll
    for (int i = 0; i < 4; ++i) { const int kr = kr0 + 32 * i;
        const unsigned p0 = cvt_pk_bf16(v[i][0], v[i][1]), p1 = cvt_pk_bf16(v[i][2], v[i][3]);
        T[(c4 * 4 + 0) * 136 + kr] = (bf16_t)(p0 & 0xffff); T[(c4 * 4 + 1) * 136 + kr] = (bf16_t)(p0 >> 16);
        T[(c4 * 4 + 2) * 136 + kr] = (bf16_t)(p1 & 0xffff); T[(c4 * 4 + 3) * 136 + kr] = (bf16_t)(p1 >> 16); }
    LDS_BARRIER();
#pragma unroll
    for (int i = 0; i < 2; ++i) { const int n = (F.tid >> 4) + 32 * i, kg = F.tid & 15;
        const u32x4 w = *(const LAS u32x4*)(T + n * 136 + kg * 8);
        *(u32x4*)(t.dst + (size_t)(t.n0 + n) * t.ldd + t.k0 + kg * 8) = w; }
    LDS_BARRIER();
}

__device__ __forceinline__ void tr_range(const Frame& F, int lo, int hi, int b, int nb) {
    int it = lo + b; if (it >= hi) return;
    f32x4 A[4], B[4];
    tr_load(F, it, A);
    for (;;) {
        const int i1 = it + nb; tr_load(F, i1 < hi ? i1 : hi - 1, B);
        tr_store(F, it, A);
        if (i1 >= hi) break;
        const int i2 = i1 + nb; tr_load(F, i2 < hi ? i2 : hi - 1, A);
        tr_store(F, i1, B);
        if (i2 >= hi) break;
        it = i2;
    }
}

__device__ __forceinline__ void tab_items(const Frame& F, int b, int nb) {
    if (b >= IT_TAB) return;
    LAS float* tc = (LAS float*)F.lds; LAS float* ts = tc + 2048;
    const float sc = 0.02209708691f;
    for (int j = F.tid; j < 2048; j += 512) { float s, c; sincospif((float)j * (1.0f / 1024.0f), &s, &c); tc[j] = c * sc; ts[j] = s * sc; }
    __syncthreads();
    bf16_t* ct = (bf16_t*)(F.ws + WS_CTAB); bf16_t* st = (bf16_t*)(F.ws + WS_STAB);
    for (int it = b; it < IT_TAB; it += nb)
        for (int r = 0; r < 8; ++r) { const int k = it * 8 + r; const int n = F.tid * 4; float cv[4], sv[4];
#pragma unroll
            for (int j = 0; j < 4; ++j) { const int idx = (k * (n + j)) & 2047; cv[j] = tc[idx]; sv[j] = ts[idx]; }
            u32x2 cw, sw; cw.x = cvt_pk_bf16(cv[0], cv[1]); cw.y = cvt_pk_bf16(cv[2], cv[3]); sw.x = cvt_pk_bf16(sv[0], sv[1]); sw.y = cvt_pk_bf16(sv[2], sv[3]);
            *(u32x2*)(ct + (size_t)k * 2048 + n) = cw; *(u32x2*)(st + (size_t)k * 2048 + n) = sw; }
    __syncthreads();
}

__device__ __forceinline__ void wcs_items(const Frame& F, int b, int nb) {
    LAS float* tab = (LAS float*)F.lds;
    if (F.tid < 256) { float s, c; sincospif((float)F.tid * (1.0f / 128.0f), &s, &c); tab[F.tid] = c; tab[256 + F.tid] = s; }
    __syncthreads();
    for (int it = b; it < IT_WCS; it += nb) {
        const int g = it >> 6, c0 = (it & 63) * 4, d = F.tid & 255, s = F.tid >> 8;
        const float* wf = F.in[I_WFOU] + (size_t)g * 65536 + d; const LAS float* tb = tab + s * 256;
        const float sg = s ? -1.0f : 1.0f;
        float a0 = 0.f, a1 = 0.f, a2 = 0.f, a3 = 0.f;
        for (int m0 = 1; m0 < 128; m0 += 8) { float e[8];
#pragma unroll
            for (int j = 0; j < 8; ++j) { const int m = m0 + j; e[j] = m < 128 ? wf[m * 256] + sg * wf[(256 - m) * 256] : 0.f; }
#pragma unroll
            for (int j = 0; j < 8; ++j) { const int m = m0 + j;
                a0 += tb[(m * (c0 + 0)) & 255] * e[j]; a1 += tb[(m * (c0 + 1)) & 255] * e[j]; a2 += tb[(m * (c0 + 2)) & 255] * e[j]; a3 += tb[(m * (c0 + 3)) & 255] * e[j]; } }
        if (s == 0) { const float w0 = wf[0], w128 = wf[128 * 256]; a0 += w0 + w128; a1 += w0 - w128; a2 += w0 + w128; a3 += w0 - w128; }
        u32x2 w; w.x = cvt_pk_bf16(a0 * 0.0625f, a1 * 0.0625f); w.y = cvt_pk_bf16(a2 * 0.0625f, a3 * 0.0625f);
        *(u32x2*)((bf16_t*)(F.ws + WS_WCS) + (size_t)(g * 512 + s * 256 + d) * 256 + c0) = w;
    }
    __syncthreads();
}

__device__ __forceinline__ void pos_item(const Frame& F, int p) {
    float* pt = (float*)(F.ws + WS_POS) + (size_t)p * 1024;
    const float pe = (float)(p < 32 ? p : p - 32);
    for (int e = F.tid; e < 1024; e += 512) { const int half = e >> 9, i = e & 511;
        const float f = powf(10000.0f, -(float)i / 512.0f); const float ang = pe * f;
        pt[e] = half ? cosf(ang) : sinf(ang); }
}

__device__ __forceinline__ void p0_prologue(const Frame& F) {
    const int NC = F.G >= 128 ? 64 : 0;
    const bool comp = NC == 0 || F.bid < NC, mem = NC == 0 || F.bid >= NC;
    const int cb = F.bid, cn = NC ? NC : F.G, mb = F.bid - NC, mn = F.G - NC;
    if (mem) {
        for (int it = mb; it < IT_MOD; it += mn) mod_item(F, it);
        tr_range(F, 0, IT_TR, mb, mn);
        __syncthreads();
    }
    if (comp) {
        wcs_items(F, cb, cn);
        tab_items(F, cb, cn);
        for (int it = cb; it < IT_POS; it += cn) pos_item(F, it);
        if (cb == 0) for (int e = F.tid; e < 2048; e += 512) ((float*)(F.ws + WS_K2))[e] = -8.0f * 1.44269504f * log1pf(expf(-F.in[I_LAM][e]));
    }
}

__device__ __forceinline__ f32x4 pos4(const float* pt, int t, int col) {
    const float* p = col < 1024 ? pt + (size_t)(t >> 6) * 1024 + col : pt + (size_t)(32 + (t & 63)) * 1024 + (col - 1024);
    return *(const f32x4*)p;
}
__device__ __forceinline__ void p1_norm(const Frame& F, int r_lo, int r_hi, int b0, int nb) {
    const float* pt = (const float*)(F.ws + WS_POS); const float* mod = (const float*)(F.ws + WS_MOD);
    const float* g = F.in[I_GMIXPRE]; bf16_t* H = (bf16_t*)(F.ws + WS_H);
    for (int r = r_lo + (F.bid - b0) * 8 + F.wave; r < r_hi; r += nb * 8) {
        const bool lat = r < MLAT; const int b = lat ? (r >> 11) : ((r - MLAT) >> 8), t = r & 2047;
        const float* src = lat ? F.in[I_X] + (size_t)r * D : F.in[I_CTX] + (size_t)(r - MLAT) * D;
        const float* mrow = mod + (size_t)(lat ? b : 8) * 12288;
        f32x4 v[8]; float ss = 0.f;
#pragma unroll
        for (int i = 0; i < 8; ++i) { const int col = (i * 64 + F.lane) * 4; v[i] = *(const f32x4*)(src + col); if (lat) v[i] += pos4(pt, t, col);
            ss += v[i][0] * v[i][0] + v[i][1] * v[i][1] + v[i][2] * v[i][2] + v[i][3] * v[i][3]; }
        ss = wave_sum(ss); const float rstd = rsqrtf(ss * (1.0f / D) + EPS);
#pragma unroll
        for (int i = 0; i < 8; ++i) { const int col = (i * 64 + F.lane) * 4; const f32x4 gg = *(const f32x4*)(g + col), sh = *(const f32x4*)(mrow + col), sc = *(const f32x4*)(mrow + 2048 + col);
            const f32x4 h = (v[i] * rstd * gg) * (1.0f + sc) + sh; u32x2 w; w.x = cvt_pk_bf16(h[0], h[1]); w.y = cvt_pk_bf16(h[2], h[3]);
            *(u32x2*)(H + (size_t)r * D + col) = w; }
    }
}

__device__ __forceinline__ void p1_latent_staged(const Frame& F, int b0, int nb) {
    const float* pt = (const float*)(F.ws + WS_POS); const float* mod = (const float*)(F.ws + WS_MOD);
    const float* g = F.in[I_GMIXPRE]; bf16_t* H = (bf16_t*)(F.ws + WS_H);
    const int j = F.bid - b0, per = nb >> 3, b = j / per, jb = j - b * per;
    LAS float* L = (LAS float*)F.lds;
    const float* mrow = mod + (size_t)b * 12288;
    __syncthreads();
    for (int e = F.tid; e < 512; e += 512) { const int c4 = e * 4;
        *(LAS f32x4*)(L + c4) = (1.0f + *(const f32x4*)(mrow + 2048 + c4)) * *(const f32x4*)(g + c4);
        *(LAS f32x4*)(L + 2048 + c4) = *(const f32x4*)(mrow + c4); }
    __syncthreads();
    const int step = per * 8;
    for (int t0 = jb * 8 + F.wave; t0 < SEQ; t0 += 2 * step) {
        f32x4 v[2][8]; float ss[2] = {0.f, 0.f};
#pragma unroll
        for (int q = 0; q < 2; ++q) { const int t = t0 + q * step < SEQ ? t0 + q * step : t0; const size_t r = (size_t)b * SEQ + t;
#pragma unroll
            for (int i = 0; i < 8; ++i) v[q][i] = __builtin_nontemporal_load((const f32x4*)(F.in[I_X] + r * D + (i * 64 + F.lane) * 4)); }
#pragma unroll
        for (int q = 0; q < 2; ++q) { const int t = t0 + q * step < SEQ ? t0 + q * step : t0;
#pragma unroll
            for (int i = 0; i < 8; ++i) { v[q][i] += pos4(pt, t, (i * 64 + F.lane) * 4); ss[q] += v[q][i][0] * v[q][i][0] + v[q][i][1] * v[q][i][1] + v[q][i][2] * v[q][i][2] + v[q][i][3] * v[q][i][3]; } }
#pragma unroll
        for (int q = 0; q < 2; ++q) { const int t = t0 + q * step; if (t >= SEQ) break; const size_t r = (size_t)b * SEQ + t;
            const float rstd = rsqrtf(wave_sum(ss[q]) * (1.0f / D) + EPS);
#pragma unroll
            for (int i = 0; i < 8; ++i) { const int col = (i * 64 + F.lane) * 4;
                const f32x4 h = (v[q][i] * rstd) * *(const LAS f32x4*)(L + col) + *(const LAS f32x4*)(L + 2048 + col);
                u32x2 w; w.x = cvt_pk_bf16(h[0], h[1]); w.y = cvt_pk_bf16(h[2], h[3]);
                *(u32x2*)(H + r * D + col) = w; } }
    }
    __syncthreads();
}
struct SchedWin {
    const bf16_t* A; const bf16_t* B; int G, c;
    int lo, hi;
    __device__ __forceinline__ bool next(int i, pg8::Unit& u) const { const int L = lo + i * G + c; if (L >= hi) return false;
        if (L < 768) pg8::std_order(L, 64, 12, u.pm, u.pn); else { const int l = L - 768; u.pm = 64 + (l >> 2); u.pn = 4 + (l & 3); } u.z = 0; return true; }
    __device__ __forceinline__ void ptrs(const pg8::Unit& u, const char*& a, const char*& b) const { a = (const char*)(A + (size_t)u.pm * 256 * D); b = (const char*)(B + (size_t)u.pn * 256 * D); }
};
struct EpiWin { static constexpr bool PERM = true, PERMA = false; bf16_t* uf;
    __device__ __forceinline__ void operator()(const f32x4 (&acc)[2][2][4][2], const pg8::Unit& u, int wr, int wc, int fr, int fq) const {
        const int seg = u.pn >> 2; bf16_t* base = uf + (size_t)seg * (16u << 20) + (size_t)(seg >> 1) * (2u << 20);
        pg8::store_tile_bf16(acc, base + (size_t)u.pm * 256 * 1024 + (u.pn & 3) * 256, 1024, wr, wc, fr, fq); }
};
struct SchedPQ {
    const bf16_t* A; const bf16_t* B; int G, c;
    __device__ __forceinline__ bool next(int i, pg8::Unit& u) const { const int L = i * G + c; if (L >= 512) return false; u.z = L >> 4; u.pm = (L >> 3) & 1; u.pn = L & 7; return true; }
    __device__ __forceinline__ void ptrs(const pg8::Unit& u, const char*& a, const char*& b) const { const int bb = u.z >> 2, g = u.z & 3;
        a = (const char*)(A + (size_t)(g * 512 + u.pm * 256) * 256); b = (const char*)(B + (size_t)(bb * 2048 + u.pn * 256) * 1024 + g * 256); }
};
struct EpiPQ { static constexpr bool PERM = true, PERMA = false; bf16_t* o;
    __device__ __forceinline__ void operator()(const f32x4 (&acc)[2][2][4][2], const pg8::Unit& u, int wr, int wc, int fr, int fq) const {
        pg8::store_tile_bf16(acc, o + (size_t)(u.z * 512 + u.pm * 256) * 2048 + u.pn * 256, 2048, wr, wc, fr, fq); }
};
struct SchedDFT {
    const bf16_t* ct; const bf16_t* st; const bf16_t* B; int G, c;
    __device__ __forceinline__ bool next(int i, pg8::Unit& u) const { const int L = i * G + c; if (L >= 256) return false; u.pm = L & 3; u.pn = (L >> 2) & 1; u.z = L >> 3; return true; }
    __device__ __forceinline__ void ptrs(const pg8::Unit& u, const char*& a, const char*& b) const {
        a = (const char*)(ct + (size_t)u.pn * (2u << 20) + (size_t)u.pm * 256 * 2048); b = (const char*)(B + (size_t)(u.z * 512 + u.pn * 256) * 2048); }
};
struct EpiDFT { static constexpr bool PERM = true, PERMA = false; bf16_t* o;
    __device__ __forceinline__ void operator()(const f32x4 (&acc)[2][2][4][2], const pg8::Unit& u, int wr, int wc, int fr, int fq) const { const int bb = u.z >> 2, g = u.z & 3;
        pg8::store_tile_bf16(acc, o + (size_t)u.pn * 8192 * 1024 + (size_t)(bb * 1024 + u.pm * 256) * 1024 + g * 256, 1024, wr, wc, fr, fq); }
};
struct SchedStd {
    const bf16_t* A; const bf16_t* B; int nM, nN, lda, ldb, G, c, nrep;
    __device__ __forceinline__ bool next(int i, pg8::Unit& u) const { int L = i * G + c; if (L >= nM * nN * nrep) return false; L %= nM * nN; pg8::std_order(L, nM, nN, u.pm, u.pn, 4); u.z = 0; return true; }
    __device__ __forceinline__ void ptrs(const pg8::Unit& u, const char*& a, const char*& b) const { a = (const char*)(A + (size_t)u.pm * 256 * lda); b = (const char*)(B + (size_t)u.pn * 256 * ldb); }
};
struct EpiY { static constexpr bool PERM = true, PERMA = false; bf16_t* y; float* rss;
    __device__ __forceinline__ void operator()(const f32x4 (&acc)[2][2][4][2], const pg8::Unit& u, int wr, int wc, int fr, int fq) const {
        pg8::store_tile_bf16(acc, y + (size_t)u.pm * 256 * D + u.pn * 256, D, wr, wc, fr, fq);
#pragma unroll
        for (int ai = 0; ai < 2; ++ai)
#pragma unroll
            for (int m = 0; m < 4; ++m) { float s = 0.f;
#pragma unroll
                for (int bj = 0; bj < 2; ++bj)
#pragma unroll
                    for (int n = 0; n < 2; ++n) { const f32x4 v = acc[ai][bj][m][n]; s += (v[0] * v[0] + v[1] * v[1]) + (v[2] * v[2] + v[3] * v[3]); }
                s += __shfl_xor(s, 16); s += __shfl_xor(s, 32);
                if (fq == 0) rss[(size_t)(u.pm * 256 + ai * 128 + wr * 64 + m * 16 + fr) * 32 + u.pn * 4 + wc] = s; }
    }
};
template <int CTRL> __device__ __forceinline__ float dpp_f(float old, float src) { return __int_as_float(__builtin_amdgcn_update_dpp(__float_as_int(old), __float_as_int(src), CTRL, 0xF, 0xF, false)); }
constexpr int DPP_SHL1 = 0x101, DPP_SHR1 = 0x111, DPP_ROR1 = 0x121, DPP_ROR15 = 0x12F;
constexpr int LDS_EDGE = 131072;
#ifndef OUTREP
#define OUTREP 1
#endif
#ifndef DOWNREP
#define DOWNREP 1
#endif
#ifndef UPREP
#define UPREP 1
#endif
struct SchedUp {
    const bf16_t* A; const bf16_t* B; int G, c;
    __device__ __forceinline__ bool next(int i, pg8::Unit& u) const { int L = i * G + c; if (L >= 64 * 44 * UPREP) return false; L %= 64 * 44; pg8::std_order(L, 64, 44, u.pm, u.pn, 4); u.z = 0; return true; }
    __device__ __forceinline__ void ptrs(const pg8::Unit& u, const char*& a, const char*& b) const { a = (const char*)(A + (size_t)u.pm * 256 * D); b = (const char*)(B + (size_t)u.pn * 128 * D); }
};
struct EpiUpConv { static constexpr bool PERM = true, PERMA = true; bf16_t* act; float* edge; const float* cw; const float* cb; LAS unsigned char* lds;
    __device__ __forceinline__ void operator()(f32x4 (&acc)[2][2][4][2], const pg8::Unit& u, int wr, int wc, int fr, int fq) const {
        const int colw = 32 * wc + 8 * fq;
        LAS float* E = (LAS float*)(lds + LDS_EDGE) + wr * 512 + colw;
#pragma unroll
        for (int ai = 0; ai < 2; ++ai)
#pragma unroll
            for (int bj = 0; bj < 2; ++bj)
#pragma unroll
                for (int n = 0; n < 2; ++n) {
                    if (fr == 0) *(LAS f32x4*)(E + (4 * ai + 1) * 256 + bj * 128 + 4 * n) = acc[ai][bj][0][n];
                    if (fr == 15) *(LAS f32x4*)(E + (4 * ai + 2) * 256 + bj * 128 + 4 * n) = acc[ai][bj][3][n]; }
        { float* eg = edge + (size_t)u.pm * 4 * DFF2 + u.pn * 128 + colw;
          if (wr == 0) { if (fr == 0) {
#pragma unroll
              for (int bj = 0; bj < 2; ++bj)
#pragma unroll
                  for (int n = 0; n < 2; ++n) { *(f32x4*)(eg + bj * DFF + 4 * n) = acc[0][bj][0][n]; *(f32x4*)(eg + DFF2 + bj * DFF + 4 * n) = acc[0][bj][1][n]; } } }
          else { if (fr == 15) {
#pragma unroll
              for (int bj = 0; bj < 2; ++bj)
#pragma unroll
                  for (int n = 0; n < 2; ++n) { *(f32x4*)(eg + 2 * DFF2 + bj * DFF + 4 * n) = acc[1][bj][2][n]; *(f32x4*)(eg + 3 * DFF2 + bj * DFF + 4 * n) = acc[1][bj][3][n]; } } } }
        const float* cwp = cw + u.pn * 128 + colw; const float* cbp = cb + u.pn * 128 + colw;
        f32x4 W[2][8];
#pragma unroll
        for (int n = 0; n < 2; ++n) { W[n][0] = *(const f32x4*)(cwp + 4 * n); W[n][1] = *(const f32x4*)(cwp + DFF2 + 4 * n); W[n][2] = *(const f32x4*)(cwp + 2 * DFF2 + 4 * n); W[n][3] = *(const f32x4*)(cbp + 4 * n);
            W[n][4] = *(const f32x4*)(cwp + DFF + 4 * n); W[n][5] = *(const f32x4*)(cwp + DFF2 + DFF + 4 * n); W[n][6] = *(const f32x4*)(cwp + 2 * DFF2 + DFF + 4 * n); W[n][7] = *(const f32x4*)(cbp + DFF + 4 * n); }
        asm volatile("s_waitcnt lgkmcnt(0)" ::: "memory"); __builtin_amdgcn_s_barrier(); __builtin_amdgcn_s_barrier(); asm volatile("" ::: "memory");
#pragma unroll
        for (int n = 0; n < 2; ++n) {
            f32x4 wg0 = W[n][0], wg1 = W[n][1], wg2 = W[n][2], bg = W[n][3], wv0 = W[n][4], wv1 = W[n][5], wv2 = W[n][6], bv = W[n][7];
            asm volatile("" : "+v"(wg0), "+v"(wg1), "+v"(wg2), "+v"(bg), "+v"(wv0), "+v"(wv1), "+v"(wv2), "+v"(bv));
#pragma unroll
            for (int ai = 0; ai < 2; ++ai) {
                f32x4 ep0 = *(const LAS f32x4*)(E + (4 * ai) * 256 + 4 * n), ep1 = *(const LAS f32x4*)(E + (4 * ai) * 256 + 128 + 4 * n);
                f32x4 en0 = *(const LAS f32x4*)(E + (4 * ai + 3) * 256 + 4 * n), en1 = *(const LAS f32x4*)(E + (4 * ai + 3) * 256 + 128 + 4 * n);
                asm volatile("" : "+v"(ep0), "+v"(ep1), "+v"(en0), "+v"(en1));
                f32x4 T[4];
#pragma unroll
                for (int m = 0; m < 4; ++m) {
                    asm volatile("" : "+v"(acc[ai][0][m][n]), "+v"(acc[ai][1][m][n]));
#pragma unroll
                    for (int q = 0; q < 4; q += 2) {
                        f32x2 g, v, gp, vp, gn, vn;
#pragma unroll
                        for (int e = 0; e < 2; ++e) { const int qq = q + e;
                            g[e] = acc[ai][0][m][n][qq]; v[e] = acc[ai][1][m][n][qq];
                            gp[e] = m > 0 ? acc[ai][0][m > 0 ? m - 1 : 0][n][qq] : dpp_f<DPP_SHR1>(ep0[qq], acc[ai][0][3][n][qq]);
                            vp[e] = m > 0 ? acc[ai][1][m > 0 ? m - 1 : 0][n][qq] : dpp_f<DPP_SHR1>(ep1[qq], acc[ai][1][3][n][qq]);
                            gn[e] = m < 3 ? acc[ai][0][m < 3 ? m + 1 : 3][n][qq] : dpp_f<DPP_SHL1>(en0[qq], acc[ai][0][0][n][qq]);
                            vn[e] = m < 3 ? acc[ai][1][m < 3 ? m + 1 : 3][n][qq] : dpp_f<DPP_SHL1>(en1[qq], acc[ai][1][0][n][qq]); }
                        const f32x2 w0g = (f32x2){wg0[q], wg0[q + 1]}, w1g = (f32x2){wg1[q], wg1[q + 1]}, w2g = (f32x2){wg2[q], wg2[q + 1]}, b0g = (f32x2){bg[q], bg[q + 1]};
                        const f32x2 w0v = (f32x2){wv0[q], wv0[q + 1]}, w1v = (f32x2){wv1[q], wv1[q + 1]}, w2v = (f32x2){wv2[q], wv2[q + 1]}, b0v = (f32x2){bv[q], bv[q + 1]};
                        const f32x2 gg = b0g + w0g * gp + w1g * g + w2g * gn;
                        const f32x2 vv = b0v + w0v * vp + w1v * v + w2v * vn;
                        const f32x2 arg = gg * ((gg * gg) * (-2.302208198f * 0.044715f) + (-2.302208198f));
                        f32x2 d; d.x = __builtin_amdgcn_exp2f(arg.x); d.y = __builtin_amdgcn_exp2f(arg.y); d = d + 1.0f;
                        f32x2 r; r.x = __builtin_amdgcn_rcpf(d.x); r.y = __builtin_amdgcn_rcpf(d.y);
                        const f32x2 o = (gg * vv) * r;
                        T[m][q] = o.x; T[m][q + 1] = o.y; }
                    asm volatile("" : "+v"(T[m])); }
#pragma unroll
                for (int m = 0; m < 4; ++m) acc[ai][0][m][n] = T[m]; } }
        bf16_t* p0 = act + (size_t)(u.pm * 256 + wr * 64 + 4 * fr) * DFF + u.pn * 128 + colw;
#pragma unroll
        for (int ai = 0; ai < 2; ++ai)
#pragma unroll
            for (int m = 0; m < 4; ++m) { const f32x4 v0 = acc[ai][0][m][0], v1 = acc[ai][0][m][1];
                u32x4 w; w.x = cvt_pk_bf16(v0[0], v0[1]); w.y = cvt_pk_bf16(v0[2], v0[3]); w.z = cvt_pk_bf16(v1[0], v1[1]); w.w = cvt_pk_bf16(v1[2], v1[3]);
                *(u32x4*)(p0 + (size_t)(ai * 128 + m) * DFF) = w; }
    }
};

constexpr int XB_STRIDE = 136, AR_STRIDE = 132;
constexpr int LDS_XB = 0, LDS_AF = 17408, LDS_IF = LDS_AF + 33792, LDS_AB = LDS_IF + 33792, LDS_IB = LDS_AB + 33792;
static_assert(LDS_IB + 33792 <= LDS_BAR, "lds");

__device__ __forceinline__ void lru_load(const Frame& F, int L, u32x4 (&U)[2][4]) {
    const bf16_t* Ux = (const bf16_t*)(F.ws + WS_UX);
    const int h = L & 7, s = L >> 3, b = s / NCHUNK, j = s % NCHUNK;
    const bool isctx = j < 4; const int rowbase = isctx ? MLAT + b * CTXL : b * SEQ, t0 = isctx ? j * 64 : (j - 4) * 64, len = isctx ? CTXL : SEQ;
#pragma unroll
    for (int i = 0; i < 2; ++i) { const int idx = F.tid + 512 * i, tok = idx >> 4, cg8 = idx & 15;
#pragma unroll
        for (int k = 0; k < 4; ++k) { int tt = t0 + tok + k - 2; tt = tt < 0 ? 0 : (tt >= len ? len - 1 : tt);
            U[i][k] = *(const u32x4*)(Ux + (size_t)(rowbase + tt) * 1024 + h * 128 + cg8 * 8); } }
}
__device__ __forceinline__ void lru_phase(const Frame& F) {
    const bf16_t* WgT = (const bf16_t*)(F.ws + WS_WG);
    bf16_t* So = (bf16_t*)(F.ws + WS_S); bf16_t* Pfo = (bf16_t*)(F.ws + WS_PF); bf16_t* Pbo = (bf16_t*)(F.ws + WS_PB);
    float* agg = (float*)(F.ws + WS_AGG);
    LAS bf16_t* XB = (LAS bf16_t*)(F.lds + LDS_XB);
    const int w = F.wave, fr = F.lane & 15, fq = F.lane >> 4;
    constexpr int NU = NB * NCHUNK * 8;
    int cur_h = -1;
    bf16x8 Wf[4][4];
    int L = F.bid; if (L >= NU) return;
    u32x4 U[2][4];
    lru_load(F, L, U);
    for (;;) {
        const int h = L & 7, s = L >> 3, b = s / NCHUNK, j = s % NCHUNK;
        if (h != cur_h) { cur_h = h;
#pragma unroll
            for (int g4 = 0; g4 < 4; ++g4)
#pragma unroll
                for (int kk = 0; kk < 4; ++kk) Wf[g4][kk] = *(const bf16x8*)(WgT + (size_t)(h * 512 + g4 * 128 + 16 * w + fr) * 128 + kk * 32 + fq * 8);
        }
        const bool isctx = j < 4; const int rowbase = isctx ? MLAT + b * CTXL : b * SEQ, t0 = isctx ? j * 64 : (j - 4) * 64, len = isctx ? CTXL : SEQ;
#pragma unroll
        for (int i = 0; i < 2; ++i) { const int idx = F.tid + 512 * i, tok = idx >> 4, cg8 = idx & 15; const int ch = h * 128 + cg8 * 8;
            float o[8]; { const f32x4 b0 = *(const f32x4*)(F.in[I_CLB] + ch), b1 = *(const f32x4*)(F.in[I_CLB] + ch + 4);
                o[0] = b0[0]; o[1] = b0[1]; o[2] = b0[2]; o[3] = b0[3]; o[4] = b1[0]; o[5] = b1[1]; o[6] = b1[2]; o[7] = b1[3]; }
#pragma unroll
            for (int k = 0; k < 4; ++k) { const int tt = t0 + tok + k - 2; const float msk = (tt >= 0 && tt < len) ? 1.0f : 0.0f;
                float uv[8]; unpack8(U[i][k], uv);
                const f32x4 w0 = *(const f32x4*)(F.in[I_CLW] + k * 1024 + ch) * msk, w1 = *(const f32x4*)(F.in[I_CLW] + k * 1024 + ch + 4) * msk;
                o[0] += w0[0] * uv[0]; o[1] += w0[1] * uv[1]; o[2] += w0[2] * uv[2]; o[3] += w0[3] * uv[3];
                o[4] += w1[0] * uv[4]; o[5] += w1[1] * uv[5]; o[6] += w1[2] * uv[6]; o[7] += w1[3] * uv[7]; }
            *(LAS u32x4*)(XB + tok * XB_STRIDE + cg8 * 8) = pack8(o); }
        const int Ln = L + F.G;
        lru_load(F, Ln < NU ? Ln : NU - 1, U);
        LDS_BARRIER();
#pragma unroll
        for (int d = 0; d < 2; ++d) {
            const int C = d * 1024 + h * 128 + 16 * w + 4 * fq;
            const f32x4 nba = *(const f32x4*)(F.in[I_BREC] + C) * -1.44269504f, nbx = *(const f32x4*)(F.in[I_BING] + C) * -1.44269504f, k2 = *(const f32x4*)((const float*)(F.ws + WS_K2) + C);
            f32x4 acc[2][4];
#pragma unroll
            for (int g2 = 0; g2 < 2; ++g2)
#pragma unroll
                for (int m = 0; m < 4; ++m) acc[g2][m] = (f32x4){0.f, 0.f, 0.f, 0.f};
#pragma unroll
            for (int m = 0; m < 4; ++m) { bf16x8 Xf[4];
#pragma unroll
                for (int kk = 0; kk < 4; ++kk) Xf[kk] = *(const LAS bf16x8*)(XB + (16 * m + fr) * XB_STRIDE + kk * 32 + fq * 8);
#pragma unroll
                for (int g2 = 0; g2 < 2; ++g2)
#pragma unroll
                    for (int kk = 0; kk < 4; ++kk) acc[g2][m] = __builtin_amdgcn_mfma_f32_16x16x32_bf16(Wf[2 * d + g2][kk], Xf[kk], acc[g2][m], 0, 0, 0); }
#pragma unroll
            for (int m = 0; m < 4; ++m) { const int tok = 16 * m + fr;
                const u32x2 xw = *(const LAS u32x2*)(XB + tok * XB_STRIDE + 16 * w + 4 * fq);
                const f32x4 xc = (f32x4){bf_lo(xw.x), bf_hi(xw.x), bf_lo(xw.y), bf_hi(xw.y)};
                f32x4 av, iv;
#pragma unroll
                for (int q = 0; q < 4; ++q) {
                    const float ea = __builtin_amdgcn_exp2f(fminf(fmaf(acc[0][m][q], -1.44269504f, nba[q]), 60.f)), ex = __builtin_amdgcn_exp2f(fminf(fmaf(acc[1][m][q], -1.44269504f, nbx[q]), 60.f));
                    const float pa = 1.0f + ea, px = 1.0f + ex, t = __builtin_amdgcn_rcpf(pa * px), r = t * px, ig = t * pa;
                    const float la2 = r * k2[q]; const float a = __builtin_amdgcn_exp2f(la2); const float u = la2 * 1.38629436f;
                    const float poly = -u * (1.0f + u * (0.5f + u * 0.16666667f));
                    const float em = u > -0.02f ? poly : fmaf(-a, a, 1.0f);
                    av[q] = a; iv[q] = __builtin_amdgcn_sqrtf(fmaxf(em, 0.f)) * ig * xc[q]; }
                *(LAS f32x4*)(F.lds + (d ? LDS_AB : LDS_AF) + (tok * AR_STRIDE + 16 * w + 4 * fq) * 4) = av;
                *(LAS f32x4*)(F.lds + (d ? LDS_IB : LDS_IF) + (tok * AR_STRIDE + 16 * w + 4 * fq) * 4) = iv; }
            asm volatile("" ::: "memory");
        }
        LDS_BARRIER();
        LAS float* ENDS = (LAS float*)(F.lds + LDS_XB);
        { const int half = F.tid >> 8, d = (F.tid >> 7) & 1, ch = F.tid & 127;
            LAS float* A = (LAS float*)(F.lds + (d ? LDS_AB : LDS_AF)) + ch; LAS float* I = (LAS float*)(F.lds + (d ? LDS_IB : LDS_IF)) + ch;
            float hs = 0.f, P = 1.f;
            if (d == 0) { const int tb = half * 32;
#pragma unroll 8
                for (int t = 0; t < 32; ++t) { const float a = A[(tb + t) * AR_STRIDE], x = I[(tb + t) * AR_STRIDE]; hs = a * hs + x; P *= a; I[(tb + t) * AR_STRIDE] = hs; A[(tb + t) * AR_STRIDE] = P; }
            } else { const int tb = 63 - half * 32;
#pragma unroll 8
                for (int t = 0; t < 32; ++t) { const float a = A[(tb - t) * AR_STRIDE], x = I[(tb - t) * AR_STRIDE]; hs = a * hs + x; P *= a; I[(tb - t) * AR_STRIDE] = hs; A[(tb - t) * AR_STRIDE] = P; }
            }
            ENDS[((d * 2 + half) * 2 + 0) * 128 + ch] = P; ENDS[((d * 2 + half) * 2 + 1) * 128 + ch] = hs; }
        LDS_BARRIER();
        if (F.tid < 256) { const int d = F.tid >> 7, ch = F.tid & 127;
            const float P0 = ENDS[((d * 2 + 0) * 2 + 0) * 128 + ch], H0 = ENDS[((d * 2 + 0) * 2 + 1) * 128 + ch], P1 = ENDS[((d * 2 + 1) * 2 + 0) * 128 + ch], H1 = ENDS[((d * 2 + 1) * 2 + 1) * 128 + ch];
            float* ag = agg + ((size_t)(b * NCHUNK + j) * 4 + d * 2) * 1024 + h * 128 + ch; ag[0] = P0 * P1; ag[1024] = P1 * H0 + H1; }
        if (!isctx) {
#pragma unroll
            for (int i = 0; i < 2; ++i) { const int idx = F.tid + 512 * i, tok = idx >> 4, cg8 = idx & 15; const int o = (tok * AR_STRIDE + cg8 * 8) * 4;
                const bool f2 = tok >= 32, b2 = tok < 32;
                float sv[8], pf[8], pb[8];
#pragma unroll
                for (int hh = 0; hh < 2; ++hh) { const f32x4 x0 = *(const LAS f32x4*)(F.lds + LDS_IF + o + hh * 16), x1 = *(const LAS f32x4*)(F.lds + LDS_IB + o + hh * 16);
                    const f32x4 p0 = *(const LAS f32x4*)(F.lds + LDS_AF + o + hh * 16), p1 = *(const LAS f32x4*)(F.lds + LDS_AB + o + hh * 16);
                    const int c0 = cg8 * 8 + hh * 4;
                    const f32x4 fP = f2 ? *(const LAS f32x4*)(ENDS + 0 * 128 + c0) : (f32x4){1.f, 1.f, 1.f, 1.f}, fH = f2 ? *(const LAS f32x4*)(ENDS + 1 * 128 + c0) : (f32x4){0.f, 0.f, 0.f, 0.f};
                    const f32x4 bP = b2 ? *(const LAS f32x4*)(ENDS + 4 * 128 + c0) : (f32x4){1.f, 1.f, 1.f, 1.f}, bH = b2 ? *(const LAS f32x4*)(ENDS + 5 * 128 + c0) : (f32x4){0.f, 0.f, 0.f, 0.f};
#pragma unroll
                    for (int q = 0; q < 4; ++q) { sv[hh * 4 + q] = (x0[q] + p0[q] * fH[q]) + (x1[q] + p1[q] * bH[q]); pf[hh * 4 + q] = p0[q] * fP[q]; pb[hh * 4 + q] = p1[q] * bP[q]; } }
                const size_t go = (size_t)(rowbase + t0 + tok) * 1024 + h * 128 + cg8 * 8;
                *(u32x4*)(So + go) = pack8(sv); *(u32x4*)(Pfo + go) = pack8(pf); *(u32x4*)(Pbo + go) = pack8(pb); }
        }
        LDS_BARRIER();
        if (Ln >= NU) break;
        L = Ln;
    }
    __syncthreads();
}

__device__ __forceinline__ void alt_phase(const Frame& F) {
    const bf16_t* PQT = (const bf16_t*)(F.ws + WS_PQT); float* y1024 = (float*)(F.ws + WS_Y1024);
    const bf16_t* ct = (const bf16_t*)(F.ws + WS_CTAB);
    const float sc = __uint_as_float(((unsigned)ct[0]) << 16);
    for (int o = F.bid * 8 + F.wave; o < 8192; o += F.G * 8) {
        const int bg = o >> 8, d = o & 255; const bf16_t* p = PQT + (size_t)(bg * 512 + d) * 2048 + F.lane * 32; float s = 0.f;
#pragma unroll
        for (int i = 0; i < 4; ++i) { float v[8]; unpack8(*(const u32x4*)(p + i * 8), v); s += (v[0] - v[1]) + (v[2] - v[3]) + (v[4] - v[5]) + (v[6] - v[7]); }
        s = wave_sum(s);
        if (F.lane == 0) y1024[(bg >> 2) * 1024 + (bg & 3) * 256 + d] = s * sc;
    }
}

__device__ __forceinline__ void assemble_phase(const Frame& F) {
    const float* agg = (const float*)(F.ws + WS_AGG);
    const bf16_t* S = (const bf16_t*)(F.ws + WS_S); const bf16_t* Pf = (const bf16_t*)(F.ws + WS_PF); const bf16_t* Pb = (const bf16_t*)(F.ws + WS_PB); const bf16_t* Ug = (const bf16_t*)(F.ws + WS_UG);
    const bf16_t* cp = (const bf16_t*)(F.ws + WS_CPSQ); const bf16_t* sq = cp + (size_t)8192 * 1024; const float* y1024 = (const float*)(F.ws + WS_Y1024);
    bf16_t* YA = (bf16_t*)(F.ws + WS_YA);
    LAS float* cf = (LAS float*)F.lds; LAS float* cb = cf + 1024;
    for (int L = F.bid; L < 256; L += F.G) {
        const int b = L >> 5, jc = L & 31, jj = jc + 4;
#pragma unroll
        for (int e = 0; e < 2; ++e) { const int ch = F.tid + 512 * e; const float* a0 = agg + (size_t)b * NCHUNK * 4096 + ch;
            float c = 0.f, c2 = 0.f;
#pragma unroll
            for (int i0 = 0; i0 < NCHUNK; i0 += 12) { float fa[12], fh[12], ba[12], bh[12];
#pragma unroll
                for (int k = 0; k < 12; ++k) { const int i = i0 + k; const int ib = i < 4 ? 3 - i : NCHUNK + 3 - i;
                    fa[k] = a0[(size_t)i * 4096]; fh[k] = a0[(size_t)i * 4096 + 1024]; ba[k] = a0[(size_t)ib * 4096 + 2048]; bh[k] = a0[(size_t)ib * 4096 + 3072]; }
#pragma unroll
                for (int k = 0; k < 12; ++k) { const int i = i0 + k; const int ib = i < 4 ? 3 - i : NCHUNK + 3 - i;
                    if (i < jj) c = fa[k] * c + fh[k];
                    if (ib < 4 || ib > jj) c2 = ba[k] * c2 + bh[k]; } }
            cf[ch] = c; cb[ch] = c2; }
        __syncthreads();
        const int row0 = b * SEQ + jc * 64;
        for (int i0 = 0; i0 < 16; i0 += 4) { u32x4 sw[4], fw[4], bw[4], gw[4];
#pragma unroll
            for (int k = 0; k < 4; ++k) { const int idx = F.tid + 512 * (i0 + k), row = idx >> 7, cg8 = idx & 127; const size_t go = (size_t)(row0 + row) * 1024 + cg8 * 8;
                sw[k] = *(const u32x4*)(S + go); fw[k] = *(const u32x4*)(Pf + go); bw[k] = *(const u32x4*)(Pb + go); gw[k] = *(const u32x4*)(Ug + go); }
#pragma unroll
            for (int k = 0; k < 4; ++k) { const int idx = F.tid + 512 * (i0 + k), row = idx >> 7, cg8 = idx & 127;
                float sv[8], pf[8], pb[8], ug[8], o[8]; unpack8(sw[k], sv); unpack8(fw[k], pf); unpack8(bw[k], pb); unpack8(gw[k], ug);
#pragma unroll
                for (int q = 0; q < 8; ++q) o[q] = (sv[q] + pf[q] * cf[cg8 * 8 + q] + pb[q] * cb[cg8 * 8 + q]) * gelu_tanh(ug[q]);
                *(u32x4*)(YA + (size_t)(row0 + row) * D + 1024 + cg8 * 8) = pack8(o); } }
        for (int i0 = 0; i0 < 32; i0 += 8) { u32x2 c4v[8], s4v[8];
#pragma unroll
            for (int k = 0; k < 8; ++k) { const int idx = F.tid + 512 * (i0 + k), row = idx >> 8, c4 = (idx & 255) * 4; const int kk = jc * 64 + row;
                const int ks = kk <= 1024 ? kk : 2048 - kk;
                const size_t o = (size_t)(b * 1024 + (ks < 1024 ? ks : 1023)) * 1024 + c4;
                c4v[k] = *(const u32x2*)(cp + o); s4v[k] = *(const u32x2*)(sq + o); }
#pragma unroll
            for (int k = 0; k < 8; ++k) { const int idx = F.tid + 512 * (i0 + k), row = idx >> 8, c4 = (idx & 255) * 4; const int kk = jc * 64 + row;
                const f32x4 cv = (f32x4){bf_lo(c4v[k].x), bf_hi(c4v[k].x), bf_lo(c4v[k].y), bf_hi(c4v[k].y)}, sv4 = (f32x4){bf_lo(s4v[k].x), bf_hi(s4v[k].x), bf_lo(s4v[k].y), bf_hi(s4v[k].y)};
                f32x4 y = kk < 1024 ? cv - sv4 : cv + sv4;
                if (kk == 1024) y = *(const f32x4*)(y1024 + b * 1024 + c4);
                y += *(const f32x4*)(F.in[I_BFOU] + c4);
                u32x2 w; w.x = cvt_pk_bf16(y[0], y[1]); w.y = cvt_pk_bf16(y[2], y[3]);
                *(u32x2*)(YA + (size_t)(row0 + row) * D + c4) = w; } }
        __syncthreads();
    }
}

__device__ __forceinline__ f32x4 ld_bf4(const bf16_t* p) { const u32x2 w = *(const u32x2*)p; return (f32x4){bf_lo(w.x), bf_hi(w.x), bf_lo(w.y), bf_hi(w.y)}; }
__device__ __forceinline__ void p7_norm2_staged(const Frame& F) {
    const float* pt = (const float*)(F.ws + WS_POS); const float* mod = (const float*)(F.ws + WS_MOD);
    const bf16_t* Y = (const bf16_t*)(F.ws + WS_Y); const float* rss = (const float*)(F.ws + WS_RSS1); bf16_t* H2 = (bf16_t*)(F.ws + WS_H2);
    const float* gpost = F.in[I_GMIXPOST]; const float* gpre = F.in[I_GFFNPRE];
    LAS float* L = (LAS float*)F.lds;
    for (int k0 = 0; k0 < NB; k0 += 2) {
        __syncthreads();
        for (int e = F.tid; e < 2 * 512; e += 512) { const int j = e >> 9, c4 = (e & 511) * 4; const float* mrow = mod + (size_t)(k0 + j) * 12288;
            *(LAS f32x4*)(L + (j * 3 + 0) * 2048 + c4) = *(const f32x4*)(mrow + 4096 + c4) * *(const f32x4*)(gpost + c4);
            *(LAS f32x4*)(L + (j * 3 + 1) * 2048 + c4) = (1.0f + *(const f32x4*)(mrow + 8192 + c4)) * *(const f32x4*)(gpre + c4);
            *(LAS f32x4*)(L + (j * 3 + 2) * 2048 + c4) = *(const f32x4*)(mrow + 6144 + c4); }
        __syncthreads();
        const int t = F.bid * 8 + F.wave;
        f32x4 v[2][8]; u32x2 yw[2][8]; float ssy[2], ss[2] = {0.f, 0.f};
#pragma unroll
        for (int j = 0; j < 2; ++j) { const int r = t + (k0 + j) * 2048; ssy[j] = F.lane < 32 ? rss[(size_t)r * 32 + F.lane] : 0.f;
#pragma unroll
            for (int i = 0; i < 8; ++i) { const int col = (i * 64 + F.lane) * 4; v[j][i] = __builtin_nontemporal_load((const f32x4*)(F.in[I_X] + (size_t)r * D + col)); yw[j][i] = __builtin_nontemporal_load((const u32x2*)(Y + (size_t)r * D + col)); } }
        f32x4 pp[8];
#pragma unroll
        for (int i = 0; i < 8; ++i) pp[i] = pos4(pt, t, (i * 64 + F.lane) * 4);
#pragma unroll
        for (int j = 0; j < 2; ++j) { const float rstdy = rsqrtf(wave_sum(ssy[j]) * (1.0f / D) + EPS);
#pragma unroll
            for (int i = 0; i < 8; ++i) { const int col = (i * 64 + F.lane) * 4;
                const f32x4 yv = (f32x4){bf_lo(yw[j][i].x), bf_hi(yw[j][i].x), bf_lo(yw[j][i].y), bf_hi(yw[j][i].y)};
                v[j][i] = v[j][i] + pp[i] + *(const LAS f32x4*)(L + (j * 3 + 0) * 2048 + col) * (yv * rstdy);
                ss[j] += v[j][i][0] * v[j][i][0] + v[j][i][1] * v[j][i][1] + v[j][i][2] * v[j][i][2] + v[j][i][3] * v[j][i][3]; } }
#pragma unroll
        for (int j = 0; j < 2; ++j) { const int r = t + (k0 + j) * 2048; const float rstd = rsqrtf(wave_sum(ss[j]) * (1.0f / D) + EPS);
#pragma unroll
            for (int i = 0; i < 8; ++i) { const int col = (i * 64 + F.lane) * 4;
                const f32x4 h = (v[j][i] * rstd) * *(const LAS f32x4*)(L + (j * 3 + 1) * 2048 + col) + *(const LAS f32x4*)(L + (j * 3 + 2) * 2048 + col);
                u32x2 w; w.x = cvt_pk_bf16(h[0], h[1]); w.y = cvt_pk_bf16(h[2], h[3]);
                *(u32x2*)(H2 + (size_t)r * D + col) = w; } }
    }
    __syncthreads();
}
__device__ __forceinline__ void p7_norm2(const Frame& F) {
    const float* pt = (const float*)(F.ws + WS_POS); const float* mod = (const float*)(F.ws + WS_MOD);
    const bf16_t* Y = (const bf16_t*)(F.ws + WS_Y); const float* rss = (const float*)(F.ws + WS_RSS1); bf16_t* H2 = (bf16_t*)(F.ws + WS_H2);
    const float* gpost = F.in[I_GMIXPOST]; const float* gpre = F.in[I_GFFNPRE];
    const int nw = F.G * 8;
    for (int r0 = F.bid * 8 + F.wave; r0 < MLAT; r0 += 2 * nw) {
        f32x4 v[2][8]; float ssy[2], ss[2] = {0.f, 0.f};
#pragma unroll
        for (int j = 0; j < 2; ++j) { const int r = r0 + j * nw < MLAT ? r0 + j * nw : r0; ssy[j] = F.lane < 32 ? rss[(size_t)r * 32 + F.lane] : 0.f; }
        u32x2 yw[2][8];
#pragma unroll
        for (int j = 0; j < 2; ++j) { const int r = r0 + j * nw < MLAT ? r0 + j * nw : r0;
#pragma unroll
            for (int i = 0; i < 8; ++i) { const int col = (i * 64 + F.lane) * 4; v[j][i] = *(const f32x4*)(F.in[I_X] + (size_t)r * D + col); yw[j][i] = *(const u32x2*)(Y + (size_t)r * D + col); } }
#pragma unroll
        for (int j = 0; j < 2; ++j) { const int r = r0 + j * nw < MLAT ? r0 + j * nw : r0; const int b = r >> 11, t = r & 2047; const float* mrow = mod + (size_t)b * 12288;
            const float rstdy = rsqrtf(wave_sum(ssy[j]) * (1.0f / D) + EPS);
#pragma unroll
            for (int i = 0; i < 8; ++i) { const int col = (i * 64 + F.lane) * 4;
                const f32x4 yv = (f32x4){bf_lo(yw[j][i].x), bf_hi(yw[j][i].x), bf_lo(yw[j][i].y), bf_hi(yw[j][i].y)}, gp = *(const f32x4*)(gpost + col), gt = *(const f32x4*)(mrow + 4096 + col);
                v[j][i] = v[j][i] + pos4(pt, t, col) + gt * (yv * rstdy * gp);
                ss[j] += v[j][i][0] * v[j][i][0] + v[j][i][1] * v[j][i][1] + v[j][i][2] * v[j][i][2] + v[j][i][3] * v[j][i][3]; } }
#pragma unroll
        for (int j = 0; j < 2; ++j) { const int r = r0 + j * nw; if (r >= MLAT) break; const int b = r >> 11; const float* mrow = mod + (size_t)b * 12288;
            const float rstd = rsqrtf(wave_sum(ss[j]) * (1.0f / D) + EPS);
#pragma unroll
            for (int i = 0; i < 8; ++i) { const int col = (i * 64 + F.lane) * 4; const f32x4 gg = *(const f32x4*)(gpre + col), sh = *(const f32x4*)(mrow + 6144 + col), sc = *(const f32x4*)(mrow + 8192 + col);
                const f32x4 h = (v[j][i] * rstd * gg) * (1.0f + sc) + sh; u32x2 w; w.x = cvt_pk_bf16(h[0], h[1]); w.y = cvt_pk_bf16(h[2], h[3]);
                *(u32x2*)(H2 + (size_t)r * D + col) = w; } }
    }
}

__device__ __forceinline__ void fixup_panel(const Frame& F, int pm) {
    const float* edge = (const float*)(F.ws + WS_EDGE); bf16_t* act = (bf16_t*)(F.ws + WS_ACT);
    const float* cw = F.in[I_CFW]; const float* cb = F.in[I_CFB];
    const int tb = pm & 7;
    for (int idx = F.tid; idx < 2 * 1408; idx += 512) {
        const int e = idx >= 1408, c = (idx - e * 1408) * 4;
        const f32x4 z = (f32x4){0.f, 0.f, 0.f, 0.f};
        f32x4 gp, gc, gn, vp, vc, vn;
        if (e == 0) { const float* pr = edge + ((size_t)(pm - 1) * 4 + 3) * DFF2; const float* cu = edge + ((size_t)pm * 4 + 0) * DFF2; const float* nx = edge + ((size_t)pm * 4 + 1) * DFF2;
            gp = tb ? *(const f32x4*)(pr + c) : z; vp = tb ? *(const f32x4*)(pr + DFF + c) : z; gc = *(const f32x4*)(cu + c); vc = *(const f32x4*)(cu + DFF + c); gn = *(const f32x4*)(nx + c); vn = *(const f32x4*)(nx + DFF + c); }
        else { const float* pr = edge + ((size_t)pm * 4 + 2) * DFF2; const float* cu = edge + ((size_t)pm * 4 + 3) * DFF2; const float* nx = edge + ((size_t)(pm + 1) * 4 + 0) * DFF2;
            gp = *(const f32x4*)(pr + c); vp = *(const f32x4*)(pr + DFF + c); gc = *(const f32x4*)(cu + c); vc = *(const f32x4*)(cu + DFF + c); gn = tb != 7 ? *(const f32x4*)(nx + c) : z; vn = tb != 7 ? *(const f32x4*)(nx + DFF + c) : z; }
        const f32x4 gg = *(const f32x4*)(cb + c) + *(const f32x4*)(cw + c) * gp + *(const f32x4*)(cw + DFF2 + c) * gc + *(const f32x4*)(cw + 2 * DFF2 + c) * gn;
        const f32x4 vv = *(const f32x4*)(cb + DFF + c) + *(const f32x4*)(cw + DFF + c) * vp + *(const f32x4*)(cw + DFF2 + DFF + c) * vc + *(const f32x4*)(cw + 2 * DFF2 + DFF + c) * vn;
        u32x2 w; w.x = cvt_pk_bf16(gelu_tanh(gg[0]) * vv[0], gelu_tanh(gg[1]) * vv[1]); w.y = cvt_pk_bf16(gelu_tanh(gg[2]) * vv[2], gelu_tanh(gg[3]) * vv[3]);
        *(u32x2*)(act + (size_t)(pm * 256 + (e ? 255 : 0)) * DFF + c) = w;
    }
}

__device__ __forceinline__ void final_phase_staged(const Frame& F) {
    const float* pt = (const float*)(F.ws + WS_POS); const float* mod = (const float*)(F.ws + WS_MOD);
    const bf16_t* Y = (const bf16_t*)(F.ws + WS_Y); const bf16_t* Y2 = (const bf16_t*)(F.ws + WS_Y2);
    const float* rss1 = (const float*)(F.ws + WS_RSS1); const float* rss2 = (const float*)(F.ws + WS_RSS2);
    const float* gpost1 = F.in[I_GMIXPOST]; const float* gpost2 = F.in[I_GFFNPOST];
    LAS float* L = (LAS float*)F.lds;
    for (int k0 = 0; k0 < NB; k0 += 2) {
        __syncthreads();
        for (int e = F.tid; e < 2 * 512; e += 512) { const int j = e >> 9, c4 = (e & 511) * 4; const float* mrow = mod + (size_t)(k0 + j) * 12288;
            *(LAS f32x4*)(L + (j * 2 + 0) * 2048 + c4) = *(const f32x4*)(mrow + 4096 + c4) * *(const f32x4*)(gpost1 + c4);
            *(LAS f32x4*)(L + (j * 2 + 1) * 2048 + c4) = *(const f32x4*)(mrow + 10240 + c4) * *(const f32x4*)(gpost2 + c4); }
        __syncthreads();
        const int t = F.bid * 8 + F.wave;
        f32x4 xv[2][8]; u32x2 y1[2][8], y2[2][8]; float s1[2], s2[2];
#pragma unroll
        for (int j = 0; j < 2; ++j) { const int r = t + (k0 + j) * 2048; s1[j] = F.lane < 32 ? rss1[(size_t)r * 32 + F.lane] : 0.f; s2[j] = F.lane < 32 ? rss2[(size_t)r * 32 + F.lane] : 0.f;
#pragma unroll
            for (int i = 0; i < 8; ++i) { const int col = (i * 64 + F.lane) * 4; xv[j][i] = __builtin_nontemporal_load((const f32x4*)(F.in[I_X] + (size_t)r * D + col)); y1[j][i] = __builtin_nontemporal_load((const u32x2*)(Y + (size_t)r * D + col)); y2[j][i] = __builtin_nontemporal_load((const u32x2*)(Y2 + (size_t)r * D + col)); } }
        f32x4 pp[8];
#pragma unroll
        for (int i = 0; i < 8; ++i) pp[i] = pos4(pt, t, (i * 64 + F.lane) * 4);
#pragma unroll
        for (int j = 0; j < 2; ++j) { const int r = t + (k0 + j) * 2048;
            const float rstd1 = rsqrtf(wave_sum(s1[j]) * (1.0f / D) + EPS), rstd2 = rsqrtf(wave_sum(s2[j]) * (1.0f / D) + EPS);
#pragma unroll
            for (int i = 0; i < 8; ++i) { const int col = (i * 64 + F.lane) * 4;
                const f32x4 a1 = (f32x4){bf_lo(y1[j][i].x), bf_hi(y1[j][i].x), bf_lo(y1[j][i].y), bf_hi(y1[j][i].y)}, a2 = (f32x4){bf_lo(y2[j][i].x), bf_hi(y2[j][i].x), bf_lo(y2[j][i].y), bf_hi(y2[j][i].y)};
                __builtin_nontemporal_store(xv[j][i] + pp[i] + *(const LAS f32x4*)(L + (j * 2 + 0) * 2048 + col) * (a1 * rstd1) + *(const LAS f32x4*)(L + (j * 2 + 1) * 2048 + col) * (a2 * rstd2), (f32x4*)(F.out + (size_t)r * D + col)); } }
    }
    __syncthreads();
}
__device__ __forceinline__ void final_phase(const Frame& F) {
    const float* pt = (const float*)(F.ws + WS_POS); const float* mod = (const float*)(F.ws + WS_MOD);
    const bf16_t* Y = (const bf16_t*)(F.ws + WS_Y); const bf16_t* Y2 = (const bf16_t*)(F.ws + WS_Y2);
    const float* rss1 = (const float*)(F.ws + WS_RSS1); const float* rss2 = (const float*)(F.ws + WS_RSS2);
    const float* gpost1 = F.in[I_GMIXPOST]; const float* gpost2 = F.in[I_GFFNPOST];
    for (int r = F.bid * 8 + F.wave; r < MLAT; r += F.G * 8) {
        const int b = r >> 11, t = r & 2047; const float* mrow = mod + (size_t)b * 12288;
        float s1 = F.lane < 32 ? rss1[(size_t)r * 32 + F.lane] : 0.f, s2 = F.lane < 32 ? rss2[(size_t)r * 32 + F.lane] : 0.f;
        s1 = wave_sum(s1); s2 = wave_sum(s2);
        const float rstd1 = rsqrtf(s1 * (1.0f / D) + EPS), rstd2 = rsqrtf(s2 * (1.0f / D) + EPS);
#pragma unroll
        for (int i = 0; i < 8; ++i) { const int col = (i * 64 + F.lane) * 4;
            const f32x4 xv = *(const f32x4*)(F.in[I_X] + (size_t)r * D + col) + pos4(pt, t, col);
            const f32x4 y1 = ld_bf4(Y + (size_t)r * D + col), y2 = ld_bf4(Y2 + (size_t)r * D + col);
            const f32x4 g1 = *(const f32x4*)(gpost1 + col), g2 = *(const f32x4*)(gpost2 + col), gt1 = *(const f32x4*)(mrow + 4096 + col), gt2 = *(const f32x4*)(mrow + 10240 + col);
            __builtin_nontemporal_store(xv + gt1 * (y1 * rstd1 * g1) + gt2 * (y2 * rstd2 * g2), (f32x4*)(F.out + (size_t)r * D + col)); }
    }
}

constexpr int N_PHASES = 13;
__global__ void __launch_bounds__(512, 2) hybrid_fwd(Args args) {
    extern __shared__ __attribute__((aligned(16))) unsigned char lds_raw[];
    Frame F; F.in = args.in; F.out = args.out; F.ws = args.ws; F.lds = (LAS unsigned char*)lds_raw;
    F.tid = threadIdx.x; F.lane = F.tid & 63; F.wave = __builtin_amdgcn_readfirstlane(F.tid >> 6); F.G = gridDim.x; F.bid = blockIdx.x;
    const int lo = args.ph_lo, hi = args.ph_hi;
#ifndef DUP_PHASE
#define DUP_PHASE -1
#endif
#define NREP(k) ((k) == DUP_PHASE ? 2 : 1)
#define IN(k) (lo <= (k) && (k) < hi)
#define SEAM(k) do { if (IN(k) && IN((k) + 1)) xcd_barrier(bar); } while (0)
    unsigned char* ws = args.ws;
    if (lo < 0) cg::this_grid().sync();
    if (F.tid < 16) ((LAS unsigned*)(F.lds + LDS_BAR))[F.tid] = 0u;
    __syncthreads();
    XcdBarrier bar; bar.bar = (unsigned*)ws; bar.x = 0; bar.st = (volatile LAS unsigned*)(F.lds + LDS_BAR);
    if (hi - lo > 1) bar = xcd_barrier_post((unsigned*)ws, (volatile LAS unsigned*)(F.lds + LDS_BAR));
    if (IN(0)) for (int rep_ = 0; rep_ < NREP(0); ++rep_) p0_prologue(F);
    SEAM(0);
    if (IN(1)) p1_norm(F, MLAT, MALL, 0, F.G);
    SEAM(1);
    if (IN(2)) {
        if (F.G >= 64) {
            if (F.bid < 32) { pg8::Gemm g{D, D, D, (size_t)128 * D * 2, (size_t)128 * D * 2};
                SchedWin S{(const bf16_t*)(ws + WS_H), (const bf16_t*)(ws + WS_WIN), 32, F.bid, 768, 800};
                EpiWin E{(bf16_t*)(ws + WS_UF)};
                pg8::gemm_phase(F.lds, g, S, E); }
            else if (((F.G - 32) & 7) == 0) p1_latent_staged(F, 32, F.G - 32); else p1_norm(F, 0, MLAT, 32, F.G - 32);
        } else { p1_norm(F, 0, MLAT, 0, F.G); }
    }
    SEAM(2);
    if (IN(3)) for (int rep_ = 0; rep_ < NREP(3); ++rep_) { pg8::Gemm g{D, D, D, (size_t)128 * D * 2, (size_t)128 * D * 2};
        SchedWin S{(const bf16_t*)(ws + WS_H), (const bf16_t*)(ws + WS_WIN), F.G, F.bid, 0, F.G >= 64 ? 768 : 800};
        EpiWin E{(bf16_t*)(ws + WS_UF)};
        pg8::gemm_phase(F.lds, g, S, E); }
    SEAM(3);
    if (IN(4)) { { pg8::Gemm g{256, 1024, 256, (size_t)128 * 256 * 2, (size_t)128 * 1024 * 2};
        SchedPQ S{(const bf16_t*)(ws + WS_WCS), (const bf16_t*)(ws + WS_UF), F.G, F.bid};
        EpiPQ E{(bf16_t*)(ws + WS_PQT)};
        pg8::gemm_phase(F.lds, g, S, E); }
        lru_phase(F); if (DUP_PHASE == 4) lru_phase(F); }
    SEAM(4);
    if (IN(5)) for (int rep_ = 0; rep_ < NREP(5); ++rep_) { pg8::Gemm g{2048, 2048, 2048, (size_t)128 * 2048 * 2, (size_t)128 * 2048 * 2};
        SchedDFT S{(const bf16_t*)(ws + WS_CTAB), (const bf16_t*)(ws + WS_STAB), (const bf16_t*)(ws + WS_PQT), F.G, F.bid};
        EpiDFT E{(bf16_t*)(ws + WS_CPSQ)};
        pg8::gemm_phase(F.lds, g, S, E);
        alt_phase(F); }
    SEAM(5);
    if (IN(6)) for (int rep_ = 0; rep_ < NREP(6); ++rep_) assemble_phase(F);
    SEAM(6);
    if (IN(7)) for (int rep_ = 0; rep_ < NREP(7); ++rep_) { pg8::Gemm g{D, D, D, (size_t)128 * D * 2, (size_t)128 * D * 2};
        SchedStd S{(const bf16_t*)(ws + WS_YA), (const bf16_t*)(ws + WS_WOUT), 64, 8, D, D, F.G, F.bid, OUTREP};
        EpiY E{(bf16_t*)(ws + WS_Y), (float*)(ws + WS_RSS1)};
        pg8::gemm_phase(F.lds, g, S, E); }
    SEAM(7);
    if (IN(8)) for (int rep_ = 0; rep_ < NREP(8); ++rep_) { if (F.G == 256) p7_norm2_staged(F); else p7_norm2(F); }
    SEAM(8);
    if (IN(9)) for (int rep_ = 0; rep_ < NREP(9); ++rep_) { pg8::Gemm g{D, D, D, (size_t)128 * D * 2, (size_t)DFF * D * 2};
        if (F.tid < 256) { ((LAS float*)(F.lds + LDS_EDGE))[F.tid] = 0.f; ((LAS float*)(F.lds + LDS_EDGE))[9 * 256 + F.tid] = 0.f; }
        __syncthreads();
        SchedUp S{(const bf16_t*)(ws + WS_H2), (const bf16_t*)(ws + WS_WUP), F.G, F.bid};
        EpiUpConv E{(bf16_t*)(ws + WS_ACT), (float*)(ws + WS_EDGE), F.in[I_CFW], F.in[I_CFB], F.lds};
        pg8::gemm_phase(F.lds, g, S, E); }
    if (IN(9) && IN(11)) xcd_barrier(bar);
    if (IN(11)) for (int rep_ = 0; rep_ < NREP(11); ++rep_) { pg8::Gemm g{DFF, DFF, DFF, (size_t)128 * DFF * 2, (size_t)128 * DFF * 2};
        SchedStd S{(const bf16_t*)(ws + WS_ACT), (const bf16_t*)(ws + WS_WDOWN), 64, 8, DFF, DFF, F.G, F.bid, DOWNREP};
        { pg8::Unit u; int last = -1;
          for (int i = 0; S.next(i, u); ++i) if (u.pm != last) { fixup_panel(F, u.pm); last = u.pm; }
          asm volatile("s_waitcnt vmcnt(0)" ::: "memory"); __syncthreads(); }
        EpiY E{(bf16_t*)(ws + WS_Y2), (float*)(ws + WS_RSS2)};
        pg8::gemm_phase(F.lds, g, S, E); }
    SEAM(11);
    if (IN(12)) for (int rep_ = 0; rep_ < NREP(12); ++rep_) { if (F.G == 256) final_phase_staged(F); else final_phase(F); }
#undef IN
#undef SEAM
}

extern "C" void kernel_launch(void* const* d_in, const int* in_sizes, int n_in, void* d_out, int out_size, void* d_ws, size_t ws_size, hipStream_t stream) {
    static int grid = 0;
    if (grid == 0) {
        if (n_in != 25 || out_size != MLAT * D || ws_size < WS_NEED) { fprintf(stderr, "kernel_launch: unexpected shapes n_in %d out %d ws %zu\n", n_in, out_size, ws_size); grid = -1; return; }
        int dev = 0, cus = 0, per_cu = 0;
        hipGetDevice(&dev); hipDeviceGetAttribute(&cus, hipDeviceAttributeMultiprocessorCount, dev);
        if (hipFuncSetAttribute((const void*)hybrid_fwd, hipFuncAttributeMaxDynamicSharedMemorySize, LDS_BYTES) != hipSuccess) { fprintf(stderr, "kernel_launch: hipFuncSetAttribute failed\n"); grid = -1; return; }
        if (hipOccupancyMaxActiveBlocksPerMultiprocessor(&per_cu, (const void*)hybrid_fwd, 512, LDS_BYTES) != hipSuccess || per_cu < 1) { fprintf(stderr, "kernel_launch: occupancy query failed (%d)\n", per_cu); (void)hipGetLastError(); per_cu = 1; }
        grid = cus * 1;
        if (grid % 8 != 0 || grid <= 0) grid = (grid / 8) * 8;
        fprintf(stderr, "kernel_launch: cus %d per_cu %d grid %d\n", cus, per_cu, grid);
    }
    if (grid <= 0) return;
    if (hipMemsetAsync(d_ws, 0, XCD_BAR_WORDS * 4, stream) != hipSuccess) { fprintf(stderr, "kernel_launch: memset of barrier words failed\n"); return; }
    Args a{};
    for (int i = 0; i < 25; ++i) a.in[i] = (const float*)d_in[i];
    a.out = (float*)d_out; a.ws = (unsigned char*)d_ws;
#if N_LAUNCH_MODE == 1
    a.ph_lo = 0; a.ph_hi = N_PHASES;
    void* kargs[] = {&a};
    hipError_t e = hipLaunchCooperativeKernel((const void*)hybrid_fwd, dim3(grid), dim3(512), kargs, LDS_BYTES, stream);
    if (e != hipSuccess) fprintf(stderr, "cooperative launch failed: %s (grid %d)\n", hipGetErrorString(e), grid);
#else
    for (int p = 0; p < N_PHASES; ++p) { a.ph_lo = p; a.ph_hi = p + 1; hipLaunchKernelGGL(hybrid_fwd, dim3(grid), dim3(512), LDS_BYTES, stream, a); }
#endif
}
```

```cpp
#include <hip/hip_runtime.h>
#include <hip/hip_cooperative_groups.h>
#include <cstdio>
#include <cstdint>
namespace cg = cooperative_groups;

#ifndef N_LAUNCH_MODE
#define N_LAUNCH_MODE 1
#endif

#define LAS __attribute__((address_space(3)))
typedef unsigned short bf16_t;
typedef short bf16x8 __attribute__((ext_vector_type(8)));
typedef float f32x4 __attribute__((ext_vector_type(4)));
typedef float f32x2 __attribute__((ext_vector_type(2)));
typedef unsigned u32x4 __attribute__((ext_vector_type(4)));
typedef unsigned u32x2 __attribute__((ext_vector_type(2)));

constexpr int D = 2048, NB = 8, SEQ = 2048, CTXL = 256, DFF = 5632, DFF2 = 11264;
constexpr int MLAT = NB * SEQ, MCTX = NB * CTXL, MALL = MLAT + MCTX;
constexpr int DLRU = 1024, DFOU = 1024, NPROJ = 3072;
constexpr int NCHUNK = 36;
constexpr float EPS = 1e-6f;

constexpr size_t MiB = 1u << 20;
constexpr size_t WS_MOD = 1 * MiB;
constexpr size_t WS_POS = 2 * MiB;
constexpr size_t WS_RSS1 = 3 * MiB;
constexpr size_t WS_RSS2 = 5 * MiB;
constexpr size_t WS_AGG = 7 * MiB;
constexpr size_t WS_Y1024 = 11 * MiB + 512 * 1024;
constexpr size_t WS_K2 = 11 * MiB + 768 * 1024;
constexpr size_t WS_WUP = 12 * MiB;
constexpr size_t WS_WDOWN = 56 * MiB;
constexpr size_t WS_WIN = 78 * MiB;
constexpr size_t WS_WOUT = 90 * MiB;
constexpr size_t WS_CTAB = 98 * MiB;
constexpr size_t WS_STAB = 102 * MiB;
constexpr size_t WS_WG = 106 * MiB;
constexpr size_t WS_WCS = 107 * MiB;
constexpr size_t WS_H = 108 * MiB;
constexpr size_t WS_UF = 180 * MiB;
constexpr size_t WS_UX = 212 * MiB;
constexpr size_t WS_UG = 248 * MiB;
constexpr size_t WS_S = 280 * MiB;
constexpr size_t WS_PF = 312 * MiB;
constexpr size_t WS_PB = 344 * MiB;
constexpr size_t WS_PQT = 108 * MiB;
constexpr size_t WS_CPSQ = 376 * MiB;
constexpr size_t WS_YA = 108 * MiB;
constexpr size_t WS_Y = 384 * MiB;
constexpr size_t WS_H2 = 78 * MiB;
constexpr size_t WS_ACT = 142 * MiB;
constexpr size_t WS_EDGE = 318 * MiB;
constexpr size_t WS_Y2 = 448 * MiB;
constexpr size_t WS_NEED = 512 * MiB;

constexpr int LDS_BAR = 152576;
constexpr int LDS_BYTES = 152576 + 64;
static_assert(WS_UX - WS_UF == 32 * MiB && WS_UG - WS_UF == 68 * MiB && WS_STAB - WS_CTAB == 4 * MiB, "pointer arithmetic in EpiWin / SchedDFT");

#define LDS_BARRIER() do { asm volatile("s_waitcnt lgkmcnt(0)" ::: "memory"); __builtin_amdgcn_s_barrier(); asm volatile("" ::: "memory"); } while (0)
__device__ __forceinline__ unsigned cvt_pk_bf16(float lo, float hi) { unsigned r; asm volatile("v_cvt_pk_bf16_f32 %0, %1, %2" : "=v"(r) : "v"(lo), "v"(hi)); return r; }
__device__ __forceinline__ float bf_lo(unsigned w) { return __uint_as_float(w << 16); }
__device__ __forceinline__ float bf_hi(unsigned w) { return __uint_as_float(w & 0xffff0000u); }
__device__ __forceinline__ float fast_sigmoid(float z) { return __builtin_amdgcn_rcpf(1.0f + __builtin_amdgcn_exp2f(-1.44269504f * z)); }
__device__ __forceinline__ float gelu_tanh(float x) { const float u = x * (1.0f + 0.044715f * x * x); return x * __builtin_amdgcn_rcpf(1.0f + __builtin_amdgcn_exp2f(-2.302208198f * u)); }
__device__ __forceinline__ float wave_sum(float v) { for (int o = 32; o >= 1; o >>= 1) v += __shfl_xor(v, o); return v; }
__device__ __forceinline__ u32x4 pack8(const float (&v)[8]) { u32x4 w; w.x = cvt_pk_bf16(v[0], v[1]); w.y = cvt_pk_bf16(v[2], v[3]); w.z = cvt_pk_bf16(v[4], v[5]); w.w = cvt_pk_bf16(v[6], v[7]); return w; }
__device__ __forceinline__ void unpack8(const u32x4 w, float (&v)[8]) { v[0] = bf_lo(w.x); v[1] = bf_hi(w.x); v[2] = bf_lo(w.y); v[3] = bf_hi(w.y); v[4] = bf_lo(w.z); v[5] = bf_hi(w.z); v[6] = bf_lo(w.w); v[7] = bf_hi(w.w); }

namespace pg8 {
constexpr int BM = 256, BK = 64, HALF = 128, HTB = HALF * BK * 2, STAGE_BYTES = 8 * HTB, NXCD = 8;
__host__ __device__ __forceinline__ int lds_byte(int r, int c) { const int st = (r >> 4) * 2 + (c >> 5), rr = r & 15, cc = c & 31, ob = rr * 64 + cc * 2; return st * 1024 + (ob ^ (((ob >> 9) & 1) << 5)); }
__host__ __device__ __forceinline__ void stage_rc(int b, int& R, int& C) { const int st = b / 1024, sb = b % 1024, swz = sb ^ (((sb >> 9) & 1) << 5); R = (st >> 1) * 16 + swz / 64; C = (st & 1) * 32 + (swz % 64) / 2; }
__host__ __device__ __forceinline__ int perm32(int rho) { const int n = rho >> 4, i = rho & 15; return 8 * (i >> 2) + 4 * n + (i & 3); }

struct Unit { int pm, pn, z; };
struct Gemm { int lda, ldb, K; size_t hstepA, hstepB; };

__device__ __forceinline__ void std_order(int L, int nM, int nN, int& pm, int& pn, const int WGM = 8) {
    const int nwg = nM * nN; int wgid = L;
    { const int q = nwg / NXCD, r = nwg % NXCD, xcd = wgid % NXCD, off = wgid / NXCD; wgid = (xcd < r ? xcd * (q + 1) : r * (q + 1) + (xcd - r) * q) + off; }
    const int nig = WGM * nN, gid = wgid / nig, fm = gid * WGM, gsz = (nM - fm) < WGM ? (nM - fm) : WGM;
    pm = fm + ((wgid % nig) % gsz); pn = (wgid % nig) / gsz;
}

__device__ __forceinline__ void store_tile_bf16(const f32x4 (&acc)[2][2][4][2], bf16_t* tile, size_t ldc, int wr, int wc, int fr, int fq) {
    bf16_t* p0 = tile + (size_t)(wr * 64 + fr) * ldc + wc * 32 + 8 * fq;
#pragma unroll
    for (int ai = 0; ai < 2; ++ai)
#pragma unroll
        for (int m = 0; m < 4; ++m) { bf16_t* rowp = p0 + (size_t)(ai * HALF + m * 16) * ldc;
#pragma unroll
            for (int bj = 0; bj < 2; ++bj) { const f32x4 v0 = acc[ai][bj][m][0], v1 = acc[ai][bj][m][1];
                u32x4 w; w.x = cvt_pk_bf16(v0[0], v0[1]); w.y = cvt_pk_bf16(v0[2], v0[3]); w.z = cvt_pk_bf16(v1[0], v1[1]); w.w = cvt_pk_bf16(v1[2], v1[3]);
                *(u32x4*)(rowp + bj * HALF) = w; } }
}
__device__ __forceinline__ void store_tile_f32(const f32x4 (&acc)[2][2][4][2], float* tile, size_t ldc, int wr, int wc, int fr, int fq) {
    float* p0 = tile + (size_t)(wr * 64 + fr) * ldc + wc * 32 + 4 * fq;
#pragma unroll
    for (int ai = 0; ai < 2; ++ai)
#pragma unroll
        for (int m = 0; m < 4; ++m) { float* rowp = p0 + (size_t)(ai * HALF + m * 16) * ldc;
#pragma unroll
            for (int bj = 0; bj < 2; ++bj)
#pragma unroll
                for (int n = 0; n < 2; ++n) *(f32x4*)(rowp + bj * HALF + n * 16) = acc[ai][bj][m][n]; }
}

template <class Epi, class Sched>
__device__ __forceinline__ void gemm_phase(LAS unsigned char* lds, const Gemm g, const Sched& S, const Epi& E) {
    const int tid = threadIdx.x, wid = __builtin_amdgcn_readfirstlane(tid >> 6), lane = tid & 63, wr = wid >> 2, wc = wid & 3, fr = lane & 15, fq = lane >> 4;
    const int K = g.K, nt = K / BK;
    unsigned voffA[2], voffB[2];
#pragma unroll
    for (int i = 0; i < 2; ++i) { int R, C; stage_rc(tid * 16 + i * 8192, R, C); const int Rb = Epi::PERM ? ((R & ~31) + perm32(R & 31)) : R;
        const int Ra = Epi::PERMA ? ((R & ~63) + 4 * (R & 15) + ((R >> 4) & 3)) : R;
        voffA[i] = (unsigned)(Ra * g.lda + C) * 2u; voffB[i] = (unsigned)(Rb * g.ldb + C) * 2u; }
    const size_t kstep = (size_t)(BK * 2);
    const size_t hstepA = g.hstepA, hstepB = g.hstepB;
    const unsigned ldsw = (unsigned)wid * 1024u;
    const int aoff = lds_byte(wr * 64 + fr, fq * 8), boff = lds_byte(wc * 32 + fr, fq * 8);
#define PG8_SA(b, h) (((b) * 2 + (h)) * HTB)
#define PG8_SB(b, h) ((4 + (b) * 2 + (h)) * HTB)
#define PG8_STAGE(bufoff, gbase, voff) do { _Pragma("unroll") for (int _i = 0; _i < 2; ++_i) \
        __builtin_amdgcn_global_load_lds((const unsigned*)((const char*)(gbase) + (voff)[_i]), (LAS unsigned*)(lds + (bufoff) + ldsw + _i * 8192), 16, 0, 0); } while (0)
#define PG8_LDA(dst, b, h) do { _Pragma("unroll") for (int m = 0; m < 4; ++m) _Pragma("unroll") for (int k = 0; k < 2; ++k) dst[m][k] = *(const LAS bf16x8*)(lds + PG8_SA(b, h) + aoff + m * 2048 + k * 1024); } while (0)
#define PG8_LDB(dst, b, h) do { _Pragma("unroll") for (int n = 0; n < 2; ++n) _Pragma("unroll") for (int k = 0; k < 2; ++k) dst[n][k] = *(const LAS bf16x8*)(lds + PG8_SB(b, h) + boff + n * 2048 + k * 1024); } while (0)
#define PG8_MMA(ai, bj, At, Bt) do { __builtin_amdgcn_s_setprio(1); _Pragma("unroll") for (int m = 0; m < 4; ++m) _Pragma("unroll") for (int n = 0; n < 2; ++n) _Pragma("unroll") for (int k = 0; k < 2; ++k) \
        acc[ai][bj][m][n] = __builtin_amdgcn_mfma_f32_16x16x32_bf16(Bt[n][k], At[m][k], acc[ai][bj][m][n], 0, 0, 0); __builtin_amdgcn_s_setprio(0); } while (0)
#define PG8_WAIT_V(n) asm volatile("s_waitcnt vmcnt(" #n ")" ::: "memory")
#define PG8_WAIT_L(n) asm volatile("s_waitcnt lgkmcnt(" #n ")" ::: "memory")
#define PG8_BAR __builtin_amdgcn_s_barrier()
#define PG8_SCHED __builtin_amdgcn_sched_barrier(0)
    Unit cur, nxt; int ui = 0;
    if (!S.next(0, cur)) return;
    f32x4 acc[2][2][4][2];
#pragma unroll
    for (int a = 0; a < 2; ++a)
#pragma unroll
        for (int b = 0; b < 2; ++b)
#pragma unroll
            for (int m = 0; m < 4; ++m)
#pragma unroll
                for (int n = 0; n < 2; ++n) acc[a][b][m][n] = (f32x4){0.f, 0.f, 0.f, 0.f};
    bf16x8 At[4][2], B0[2][2], B1[2][2];
    const char* cA; const char* cB; S.ptrs(cur, cA, cB);
    PG8_STAGE(PG8_SB(0, 0), cB, voffB); PG8_STAGE(PG8_SB(0, 1), cB + hstepB, voffB); PG8_STAGE(PG8_SA(0, 0), cA, voffA); PG8_STAGE(PG8_SA(0, 1), cA + hstepA, voffA);
    if (wr == 1) PG8_BAR;
    PG8_WAIT_V(2); PG8_BAR;
    PG8_STAGE(PG8_SB(1, 0), cB + kstep, voffB); PG8_STAGE(PG8_SA(1, 0), cA + kstep, voffA); PG8_STAGE(PG8_SB(1, 1), cB + hstepB + kstep, voffB);
    PG8_WAIT_V(6); PG8_BAR;
    for (;;) {
        const bool has_next = S.next(ui + 1, nxt);
        const char* nA = cA; const char* nB = cB; if (has_next) S.ptrs(nxt, nA, nB);
#pragma unroll 1
        for (int t = 0; t < nt; t += 2) {
            const bool last = (t == nt - 2);
            const char* a1 = cA + (size_t)(t + 1) * kstep;
            const char* a2 = last ? nA : cA + (size_t)(t + 2) * kstep; const char* b2 = last ? nB : cB + (size_t)(t + 2) * kstep;
            const char* a3 = a2 + kstep; const char* b3 = b2 + kstep;
            PG8_LDB(B0, 0, 0); PG8_LDB(B1, 0, 1); PG8_SCHED; PG8_LDA(At, 0, 0); PG8_STAGE(PG8_SA(1, 1), a1 + hstepA, voffA);
            PG8_WAIT_V(8); PG8_WAIT_L(0); PG8_BAR; PG8_MMA(0, 0, At, B0); PG8_MMA(0, 1, At, B1); PG8_BAR; PG8_SCHED;
            PG8_LDA(At, 0, 1); PG8_STAGE(PG8_SB(0, 0), b2, voffB); PG8_STAGE(PG8_SB(0, 1), b2 + hstepB, voffB); PG8_STAGE(PG8_SA(0, 0), a2, voffA);
            PG8_WAIT_V(8); PG8_WAIT_L(0); PG8_BAR; PG8_MMA(1, 0, At, B0); PG8_MMA(1, 1, At, B1); PG8_BAR; PG8_SCHED;
            PG8_LDB(B0, 1, 0); PG8_LDB(B1, 1, 1); PG8_SCHED; PG8_LDA(At, 1, 0); PG8_STAGE(PG8_SA(0, 1), a2 + hstepA, voffA);
            PG8_WAIT_V(8); PG8_WAIT_L(0); PG8_BAR; PG8_MMA(0, 0, At, B0); PG8_MMA(0, 1, At, B1); PG8_BAR; PG8_SCHED;
            PG8_LDA(At, 1, 1); PG8_STAGE(PG8_SB(1, 0), b3, voffB); PG8_STAGE(PG8_SB(1, 1), b3 + hstepB, voffB); PG8_STAGE(PG8_SA(1, 0), a3, voffA);
            PG8_WAIT_V(8); PG8_WAIT_L(0); PG8_BAR; PG8_MMA(1, 0, At, B0); PG8_MMA(1, 1, At, B1); PG8_BAR; PG8_SCHED;
        }
        if (wr == 0) PG8_BAR;
        E(acc, cur, wr, wc, fr, fq);
        if (!has_next) break;
#pragma unroll
        for (int a = 0; a < 2; ++a)
#pragma unroll
            for (int b = 0; b < 2; ++b)
#pragma unroll
                for (int m = 0; m < 4; ++m)
#pragma unroll
                    for (int n = 0; n < 2; ++n) acc[a][b][m][n] = (f32x4){0.f, 0.f, 0.f, 0.f};
        cur = nxt; cA = nA; cB = nB; ++ui;
        if (wr == 1) PG8_BAR;
    }
    PG8_WAIT_V(0);
    PG8_BAR;
#undef PG8_SA
#undef PG8_SB
#undef PG8_STAGE
#undef PG8_LDA
#undef PG8_LDB
#undef PG8_MMA
#undef PG8_WAIT_V
#undef PG8_WAIT_L
#undef PG8_BAR
#undef PG8_SCHED
}
}

#define XB_TMO      128
#define XB_XCNT(j)  (256  + 64 * (j))
#define XB_XSUB(j)  (1280 + 64 * (j))
#define XB_XGEN(j)  (2304 + 64 * (j))
#define XB_TOP      3328
#define XB_TOPGEN   3392
#define XCD_BAR_WORDS 3456
#define XB_SPIN_CAP (1u << 18)
__device__ __forceinline__ unsigned xb_ld(unsigned* p)              { return __hip_atomic_load(p, __ATOMIC_RELAXED, __HIP_MEMORY_SCOPE_AGENT); }
__device__ __forceinline__ unsigned xb_add(unsigned* p, unsigned v) { return __hip_atomic_fetch_add(p, v, __ATOMIC_RELAXED, __HIP_MEMORY_SCOPE_AGENT); }
__device__ __forceinline__ unsigned xb_xcc_id() { return (unsigned)__builtin_amdgcn_s_getreg((3 << 11) | 20) & 0xFu; }
#define XB_SPIN(cond, bar) do { unsigned _sp = 0; while (cond) { __builtin_amdgcn_s_sleep(1); \
    if ((++_sp & 255u) == 0u) { if (xb_ld(&(bar)[XB_TMO])) break; if (_sp > XB_SPIN_CAP) { atomicAdd(&(bar)[XB_TMO], 1u); break; } } } } while (0)
struct XcdBarrier { unsigned* bar; unsigned x; volatile LAS unsigned* st; };
__device__ __forceinline__ XcdBarrier xcd_barrier_post(unsigned* bar, volatile LAS unsigned* st) {
    XcdBarrier b; b.bar = bar; b.x = xb_xcc_id(); b.st = st;
    if (threadIdx.x == 0) (void)xb_add(&bar[XB_XCNT(b.x)], 1u);
    return b;
}
__device__ __forceinline__ void xcd_barrier_complete(unsigned* bar, unsigned x, unsigned& nloc, unsigned& nx) {
    const unsigned G = gridDim.x * gridDim.y * gridDim.z;
    unsigned sum, cnt, mine, sp = 0u;
    for (;;) {
        sum = 0u; cnt = 0u; mine = 0u;
#pragma unroll
        for (unsigned j = 0; j < 16; ++j) { const unsigned c = xb_ld(&bar[XB_XCNT(j)]); sum += c; cnt += (c > 0u) ? 1u : 0u; mine = (j == x) ? c : mine; }
        if (sum == G) break;
        __builtin_amdgcn_s_sleep(1);
        if ((++sp & 255u) == 0u) { if (xb_ld(&bar[XB_TMO])) break; if (sp > XB_SPIN_CAP) { atomicAdd(&bar[XB_TMO], 1u); break; } }
    }
    nloc = mine > 0u ? mine : 1u; nx = cnt > 0u ? cnt : 1u;
}
__device__ __forceinline__ void xcd_barrier(const XcdBarrier& b) {
    asm volatile("s_waitcnt vmcnt(0)" ::: "memory");
    __syncthreads();
    if (threadIdx.x == 0) {
        unsigned* bar = b.bar;
        __builtin_amdgcn_s_waitcnt(0);
        unsigned nloc = b.st[0], nx = b.st[1];
        if (nloc == 0u) { xcd_barrier_complete(bar, b.x, nloc, nx); b.st[0] = nloc; b.st[1] = nx; }
        const unsigned old = xb_add(&bar[XB_XSUB(b.x)], 1u);
        const unsigned gen = old / nloc;
        if (old + 1u == (gen + 1u) * nloc) {
            __builtin_amdgcn_fence(__ATOMIC_RELEASE, "agent");
            asm volatile("s_waitcnt vmcnt(0)" ::: "memory");
            const unsigned og = xb_add(&bar[XB_TOP], 1u);
            const unsigned tg = og / nx;
            if (og + 1u == (tg + 1u) * nx) xb_add(&bar[XB_TOPGEN], 1u);
            else XB_SPIN(xb_ld(&bar[XB_TOPGEN]) == tg, bar);
            __builtin_amdgcn_fence(__ATOMIC_ACQUIRE, "agent");
            xb_add(&bar[XB_XGEN(b.x)], 1u);
            asm volatile("s_waitcnt vmcnt(0)" ::: "memory");
        } else {
            XB_SPIN(xb_ld(&bar[XB_XGEN(b.x)]) == gen, bar);
            __builtin_amdgcn_fence(__ATOMIC_ACQUIRE, "agent");
            asm volatile("s_waitcnt vmcnt(0)" ::: "memory");
        }
    }
    __syncthreads();
}

struct Args { const float* in[25]; float* out; unsigned char* ws; int ph_lo, ph_hi; };
struct Frame {
    const float* const* in; float* out; unsigned char* ws; LAS unsigned char* lds; int tid, lane, wave, G, bid;
};
enum { I_X = 0, I_C, I_CTX, I_CCTX, I_WADA, I_BADA, I_GMIXPRE, I_GMIXPOST, I_GFFNPRE, I_GFFNPOST, I_WIN, I_CLW, I_CLB, I_WREC, I_BREC, I_WING, I_BING, I_LAM, I_WFOU, I_BFOU, I_WOUT, I_WUP, I_CFW, I_CFB, I_WDOWN };

constexpr int IT_MOD = 192;
constexpr int IT_TR_WIN = 16 * 48, IT_TR_WOUT = 16 * 32, IT_TR_WUP = 16 * 176, IT_TR_WDOWN = 44 * 32, IT_TR_G = 64;
constexpr int IT_TR = IT_TR_WIN + IT_TR_WOUT + IT_TR_WUP + IT_TR_WDOWN + IT_TR_G;
constexpr int IT_TAB = 128, IT_WCS = 256, IT_POS = 96;

__device__ __forceinline__ void mod_item(const Frame& F, int it) {
    LAS float* sil = (LAS float*)F.lds;
    LAS float* red = (LAS float*)(F.lds + 73728);
    const float* c = F.in[I_C]; const float* cc = F.in[I_CCTX];
    for (int idx = F.tid; idx < 9 * 2048; idx += 512) { const int bb = idx >> 11, k = idx & 2047; const float v = bb < 8 ? c[bb * 2048 + k] : cc[k]; sil[idx] = v * fast_sigmoid(v); }
    __syncthreads();
    const int n0 = it * 64, rg = F.tid >> 4, l16 = F.tid & 15;
    const float* w = F.in[I_WADA] + n0 + l16 * 4;
    f32x4 acc[9];
#pragma unroll
    for (int b = 0; b < 9; ++b) acc[b] = (f32x4){0.f, 0.f, 0.f, 0.f};
    for (int i0 = 0; i0 < 64; i0 += 8) { f32x4 wv[8];
#pragma unroll
        for (int i = 0; i < 8; ++i) wv[i] = __builtin_nontemporal_load((const f32x4*)(w + (size_t)(rg + 32 * (i0 + i)) * 12288));
#pragma unroll
        for (int i = 0; i < 8; ++i) { const int k = rg + 32 * (i0 + i);
#pragma unroll
            for (int b = 0; b < 9; ++b) acc[b] += sil[b * 2048 + k] * wv[i]; } }
#pragma unroll
    for (int b = 0; b < 9; ++b) *(LAS f32x4*)(red + (rg * 9 + b) * 64 + l16 * 4) = acc[b];
    __syncthreads();
    for (int o = F.tid; o < 576; o += 512) { const int bb = o >> 6, col = o & 63; float s = 0.f; for (int r = 0; r < 32; ++r) s += red[(r * 9 + bb) * 64 + col];
        ((float*)(F.ws + WS_MOD))[bb * 12288 + n0 + col] = s + F.in[I_BADA][n0 + col]; }
    __syncthreads();
}

struct TrDesc { const float* src; bf16_t* dst; int N, ldd, k0, n0; };
__device__ __forceinline__ TrDesc tr_decode(const Frame& F, int it) {
    TrDesc t;
    if (it < IT_TR_WIN) { t.src = F.in[I_WIN]; t.N = NPROJ; t.dst = (bf16_t*)(F.ws + WS_WIN); t.ldd = D; t.k0 = (it % 16) * 128; t.n0 = (it / 16) * 64; return t; }
    it -= IT_TR_WIN;
    if (it < IT_TR_WOUT) { t.src = F.in[I_WOUT]; t.N = D; t.dst = (bf16_t*)(F.ws + WS_WOUT); t.ldd = D; t.k0 = (it % 16) * 128; t.n0 = (it / 16) * 64; return t; }
    it -= IT_TR_WOUT;
    if (it < IT_TR_WUP) { t.src = F.in[I_WUP]; t.N = DFF2; t.dst = (bf16_t*)(F.ws + WS_WUP); t.ldd = D; t.k0 = (it % 16) * 128; t.n0 = (it / 16) * 64; return t; }
    it -= IT_TR_WUP;
    if (it < IT_TR_WDOWN) { t.src = F.in[I_WDOWN]; t.N = D; t.dst = (bf16_t*)(F.ws + WS_WDOWN); t.ldd = DFF; t.k0 = (it % 44) * 128; t.n0 = (it / 44) * 64; return t; }
    it -= IT_TR_WDOWN;
    { const int half = it & 1, mat = it >> 1, type = mat & 1, dir = (mat >> 1) & 1, h = mat >> 2;
      t.src = (type ? F.in[I_WING] : F.in[I_WREC]) + (size_t)(dir * 8 + h) * 128 * 128; t.N = 128;
      t.dst = (bf16_t*)(F.ws + WS_WG) + (size_t)(h * 512 + (dir * 2 + type) * 128) * 128; t.ldd = 128; t.k0 = 0; t.n0 = half * 64; }
    return t;
}
__device__ __forceinline__ void tr_load(const Frame& F, int it, f32x4 (&v)[4]) {
    const TrDesc t = tr_decode(F, it); const int kr0 = F.tid >> 4, c4 = F.tid & 15;
#pragma unroll
    for (int i = 0; i < 4; ++i) v[i] = __builtin_nontemporal_load((const f32x4*)(t.src + (size_t)(t.k0 + kr0 + 32 * i) * t.N + t.n0 + c4 * 4));
}
__device__ __forceinline__ void tr_store(const Frame& F, int it, const f32x4 (&v)[4]) {
    const TrDesc t = tr_decode(F, it);
    LAS bf16_t* T = (LAS bf16_t*)F.lds;
    const int kr0 = F.tid >> 4, c4 = F.tid & 15;
#pragma unroll
    for (int i = 0; i < 4; ++i) { const int kr = kr0 + 32 * i;
        const unsigned p0 = cvt_pk_bf16(v[i][0], v[i][1]), p1 = cvt_pk_bf16(v[i][2], v[i][3]);
        T[(c4 * 4 + 0) * 136 + kr] = (bf16_t)(p0 & 0xffff); T[(c4 * 4 + 1) * 136 + kr] = (bf16_t)(p0 >> 16);
        T[(c4 * 4 + 2) * 136 + kr] = (bf16_t)(p1 & 0xffff); T[(c4 * 4 + 3) * 136 + kr] = (bf16_t)(p1 >> 16); }
    LDS_BARRIER();
#pragma unroll
    for (int i = 0; i < 2; ++i) { const int n = (F.tid >> 4) + 32 * i, kg = F.tid & 15;
        const u32x4 w = *(const LAS u32x4*)(T + n * 136 + kg * 8);
        *(u32x4*)(t.dst + (size_t)(t.n0 + n) * t.ldd + t.k0 + kg * 8) = w; }
    LDS_BARRIER();
}

__device__ __forceinline__ void tr_range(const Frame& F, int lo, int hi, int b, int nb) {
    int it = lo + b; if (it >= hi) return;
    f32x4 A[4], B[4];
    tr_load(F, it, A);
    for (;;) {
        const int i1 = it + nb; tr_load(F, i1 < hi ? i1 : hi - 1, B);
        tr_store(F, it, A);
        if (i1 >= hi) break;
        const int i2 = i1 + nb; tr_load(F, i2 < hi ? i2 : hi - 1, A);
        tr_store(F, i1, B);
        if (i2 >= hi) break;
        it = i2;
    }
}

__device__ __forceinline__ void tab_items(const Frame& F, int b, int nb) {
    if (b >= IT_TAB) return;
    LAS float* tc = (LAS float*)F.lds; LAS float* ts = tc + 2048;
    const float sc = 0.02209708691f;
    for (int j = F.tid; j < 2048; j += 512) { float s, c; sincospif((float)j * (1.0f / 1024.0f), &s, &c); tc[j] = c * sc; ts[j] = s * sc; }
    __syncthreads();
    bf16_t* ct = (bf16_t*)(F.ws + WS_CTAB); bf16_t* st = (bf16_t*)(F.ws + WS_STAB);
    for (int it = b; it < IT_TAB; it += nb)
        for (int r = 0; r < 8; ++r) { const int k = it * 8 + r; const int n = F.tid * 4; float cv[4], sv[4];
#pragma unroll
            for (int j = 0; j < 4; ++j) { const int idx = (k * (n + j)) & 2047; cv[j] = tc[idx]; sv[j] = ts[idx]; }
            u32x2 cw, sw; cw.x = cvt_pk_bf16(cv[0], cv[1]); cw.y = cvt_pk_bf16(cv[2], cv[3]); sw.x = cvt_pk_bf16(sv[0], sv[1]); sw.y = cvt_pk_bf16(sv[2], sv[3]);
            *(u32x2*)(ct + (size_t)k * 2048 + n) = cw; *(u32x2*)(st + (size_t)k * 2048 + n) = sw; }
    __syncthreads();
}

__device__ __forceinline__ void wcs_items(const Frame& F, int b, int nb) {
    LAS float* tab = (LAS float*)F.lds;
    if (F.tid < 256) { float s, c; sincospif((float)F.tid * (1.0f / 128.0f), &s, &c); tab[F.tid] = c; tab[256 + F.tid] = s; }
    __syncthreads();
    for (int it = b; it < IT_WCS; it += nb) {
        const int g = it >> 6, c0 = (it & 63) * 4, d = F.tid & 255, s = F.tid >> 8;
        const float* wf = F.in[I_WFOU] + (size_t)g * 65536 + d; const LAS float* tb = tab + s * 256;
        const float sg = s ? -1.0f : 1.0f;
        float a0 = 0.f, a1 = 0.f, a2 = 0.f, a3 = 0.f;
        for (int m0 = 1; m0 < 128; m0 += 8) { float e[8];
#pragma unroll
            for (int j = 0; j < 8; ++j) { const int m = m0 + j; e[j] = m < 128 ? wf[m * 256] + sg * wf[(256 - m) * 256] : 0.f; }
#pragma unroll
            for (int j = 0; j < 8; ++j) { const int m = m0 + j;
                a0 += tb[(m * (c0 + 0)) & 255] * e[j]; a1 += tb[(m * (c0 + 1)) & 255] * e[j]; a2 += tb[(m * (c0 + 2)) & 255] * e[j]; a3 += tb[(m * (c0 + 3)) & 255] * e[j]; } }
        if (s == 0) { const float w0 = wf[0], w128 = wf[128 * 256]; a0 += w0 + w128; a1 += w0 - w128; a2 += w0 + w128; a3 += w0 - w128; }
        u32x2 w; w.x = cvt_pk_bf16(a0 * 0.0625f, a1 * 0.0625f); w.y = cvt_pk_bf16(a2 * 0.0625f, a3 * 0.0625f);
        *(u32x2*)((bf16_t*)(F.ws + WS_WCS) + (size_t)(g * 512 + s * 256 + d) * 256 + c0) = w;
    }
    __syncthreads();
}

__device__ __forceinline__ void pos_item(const Frame& F, int p) {
    float* pt = (float*)(F.ws + WS_POS) + (size_t)p * 1024;
    const float pe = (float)(p < 32 ? p : p - 32);
    for (int e = F.tid; e < 1024; e += 512) { const int half = e >> 9, i = e & 511;
        const float f = powf(10000.0f, -(float)i / 512.0f); const float ang = pe * f;
        pt[e] = half ? cosf(ang) : sinf(ang); }
}

__device__ __forceinline__ void p0_prologue(const Frame& F) {
    const int NC = F.G >= 128 ? 64 : 0;
    const bool comp = NC == 0 || F.bid < NC, mem = NC == 0 || F.bid >= NC;
    const int cb = F.bid, cn = NC ? NC : F.G, mb = F.bid - NC, mn = F.G - NC;
    if (mem) {
        for (int it = mb; it < IT_MOD; it += mn) mod_item(F, it);
        tr_range(F, 0, IT_TR, mb, mn);
        __syncthreads();
    }
    if (comp) {
        wcs_items(F, cb, cn);
        tab_items(F, cb, cn);
        for (int it = cb; it < IT_POS; it += cn) pos_item(F, it);
        if (cb == 0) for (int e = F.tid; e < 2048; e += 512) ((float*)(F.ws + WS_K2))[e] = -8.0f * 1.44269504f * log1pf(expf(-F.in[I_LAM][e]));
    }
}

__device__ __forceinline__ f32x4 pos4(const float* pt, int t, int col) {
    const float* p = col < 1024 ? pt + (size_t)(t >> 6) * 1024 + col : pt + (size_t)(32 + (t & 63)) * 1024 + (col - 1024);
    return *(const f32x4*)p;
}
__device__ __forceinline__ void p1_norm(const Frame& F, int r_lo, int r_hi, int b0, int nb) {
    const float* pt = (const float*)(F.ws + WS_POS); const float* mod = (const float*)(F.ws + WS_MOD);
    const float* g = F.in[I_GMIXPRE]; bf16_t* H = (bf16_t*)(F.ws + WS_H);
    for (int r = r_lo + (F.bid - b0) * 8 + F.wave; r < r_hi; r += nb * 8) {
        const bool lat = r < MLAT; const int b = lat ? (r >> 11) : ((r - MLAT) >> 8), t = r & 2047;
        const float* src = lat ? F.in[I_X] + (size_t)r * D : F.in[I_CTX] + (size_t)(r - MLAT) * D;
        const float* mrow = mod + (size_t)(lat ? b : 8) * 12288;
        f32x4 v[8]; float ss = 0.f;
#pragma unroll
        for (int i = 0; i < 8; ++i) { const int col = (i * 64 + F.lane) * 4; v[i] = *(const f32x4*)(src + col); if (lat) v[i] += pos4(pt, t, col);
            ss += v[i][0] * v[i][0] + v[i][1] * v[i][1] + v[i][2] * v[i][2] + v[i][3] * v[i][3]; }
        ss = wave_sum(ss); const float rstd = rsqrtf(ss * (1.0f / D) + EPS);
#pragma unroll
        for (int i = 0; i < 8; ++i) { const int col = (i * 64 + F.lane) * 4; const f32x4 gg = *(const f32x4*)(g + col), sh = *(const f32x4*)(mrow + col), sc = *(const f32x4*)(mrow + 2048 + col);
            const f32x4 h = (v[i] * rstd * gg) * (1.0f + sc) + sh; u32x2 w; w.x = cvt_pk_bf16(h[0], h[1]); w.y = cvt_pk_bf16(h[2], h[3]);
            *(u32x2*)(H + (size_t)r * D + col) = w; }
    }
}

__device__ __forceinline__ void p1_latent_staged(const Frame& F, int b0, int nb) {
    const float* pt = (const float*)(F.ws + WS_POS); const float* mod = (const float*)(F.ws + WS_MOD);
    const float* g = F.in[I_GMIXPRE]; bf16_t* H = (bf16_t*)(F.ws + WS_H);
    const int j = F.bid - b0, per = nb >> 3, b = j / per, jb = j - b * per;
    LAS float* L = (LAS float*)F.lds;
    const float* mrow = mod + (size_t)b * 12288;
    __syncthreads();
    for (int e = F.tid; e < 512; e += 512) { const int c4 = e * 4;
        *(LAS f32x4*)(L + c4) = (1.0f + *(const f32x4*)(mrow + 2048 + c4)) * *(const f32x4*)(g + c4);
        *(LAS f32x4*)(L + 2048 + c4) = *(const f32x4*)(mrow + c4); }
    __syncthreads();
    const int step = per * 8;
    for (int t0 = jb * 8 + F.wave; t0 < SEQ; t0 += 2 * step) {
        f32x4 v[2][8]; float ss[2] = {0.f, 0.f};
#pragma unroll
        for (int q = 0; q < 2; ++q) { const int t = t0 + q * step < SEQ ? t0 + q * step : t0; const size_t r = (size_t)b * SEQ + t;
#pragma unroll
            for (int i = 0; i < 8; ++i) v[q][i] = __builtin_nontemporal_load((const f32x4*)(F.in[I_X] + r * D + (i * 64 + F.lane) * 4)); }
#pragma unroll
        for (int q = 0; q < 2; ++q) { const int t = t0 + q * step < SEQ ? t0 + q * step : t0;
#pragma unroll
            for (int i = 0; i < 8; ++i) { v[q][i] += pos4(pt, t, (i * 64 + F.lane) * 4); ss[q] += v[q][i][0] * v[q][i][0] + v[q][i][1] * v[q][i][1] + v[q][i][2] * v[q][i][2] + v[q][i][3] * v[q][i][3]; } }
#pragma unroll
        for (int q = 0; q < 2; ++q) { const int t = t0 + q * step; if (t >= SEQ) break; const size_t r = (size_t)b * SEQ + t;
            const float rstd = rsqrtf(wave_sum(ss[q]) * (1.0f / D) + EPS);
#pragma unroll
            for (int i = 0; i < 8; ++i) { const int col = (i * 64 + F.lane) * 4;
                const f32x4 h = (v[q][i] * rstd) * *(const LAS f32x4*)(L + col) + *(const LAS f32x4*)(L + 2048 + col);
                u32x2 w; w.x = cvt_pk_bf16(h[0], h[1]); w.y = cvt_pk_bf16(h[2], h[3]);
                *(u32x2*)(H + r * D + col) = w; } }
    }
    __syncthreads();
}
struct SchedWin {
    const bf16_t* A; const bf16_t* B; int G, c;
    int lo, hi;
    __device__ __forceinline__ bool next(int i, pg8::Unit& u) const { const int L = lo + i * G + c; if (L >= hi) return false;
        if (L < 768) pg8::std_order(L, 64, 12, u.pm, u.pn); else { const int l = L - 768; u.pm = 64 + (l >> 2); u.pn = 4 + (l & 3); } u.z = 0; return true; }
    __device__ __forceinline__ void ptrs(const pg8::Unit& u, const char*& a, const char*& b) const { a = (const char*)(A + (size_t)u.pm * 256 * D); b = (const char*)(B + (size_t)u.pn * 256 * D); }
};
struct EpiWin { static constexpr bool PERM = true, PERMA = false; bf16_t* uf;
    __device__ __forceinline__ void operator()(const f32x4 (&acc)[2][2][4][2], const pg8::Unit& u, int wr, int wc, int fr, int fq) const {
        const int seg = u.pn >> 2; bf16_t* base = uf + (size_t)seg * (16u << 20) + (size_t)(seg >> 1) * (2u << 20);
        pg8::store_tile_bf16(acc, base + (size_t)u.pm * 256 * 1024 + (u.pn & 3) * 256, 1024, wr, wc, fr, fq); }
};
struct SchedPQ {
    const bf16_t* A; const bf16_t* B; int G, c;
    __device__ __forceinline__ bool next(int i, pg8::Unit& u) const { const int L = i * G + c; if (L >= 512) return false; u.z = L >> 4; u.pm = (L >> 3) & 1; u.pn = L & 7; return true; }
    __device__ __forceinline__ void ptrs(const pg8::Unit& u, const char*& a, const char*& b) const { const int bb = u.z >> 2, g = u.z & 3;
        a = (const char*)(A + (size_t)(g * 512 + u.pm * 256) * 256); b = (const char*)(B + (size_t)(bb * 2048 + u.pn * 256) * 1024 + g * 256); }
};
struct EpiPQ { static constexpr bool PERM = true, PERMA = false; bf16_t* o;
    __device__ __forceinline__ void operator()(const f32x4 (&acc)[2][2][4][2], const pg8::Unit& u, int wr, int wc, int fr, int fq) const {
        pg8::store_tile_bf16(acc, o + (size_t)(u.z * 512 + u.pm * 256) * 2048 + u.pn * 256, 2048, wr, wc, fr, fq); }
};
struct SchedDFT {
    const bf16_t* ct; const bf16_t* st; const bf16_t* B; int G, c;
    __device__ __forceinline__ bool next(int i, pg8::Unit& u) const { const int L = i * G + c; if (L >= 256) return false; u.pm = L & 3; u.pn = (L >> 2) & 1; u.z = L >> 3; return true; }
    __device__ __forceinline__ void ptrs(const pg8::Unit& u, const char*& a, const char*& b) const {
        a = (const char*)(ct + (size_t)u.pn * (2u << 20) + (size_t)u.pm * 256 * 2048); b = (const char*)(B + (size_t)(u.z * 512 + u.pn * 256) * 2048); }
};
struct EpiDFT { static constexpr bool PERM = true, PERMA = false; bf16_t* o;
    __device__ __forceinline__ void operator()(const f32x4 (&acc)[2][2][4][2], const pg8::Unit& u, int wr, int wc, int fr, int fq) const { const int bb = u.z >> 2, g = u.z & 3;
        pg8::store_tile_bf16(acc, o + (size_t)u.pn * 8192 * 1024 + (size_t)(bb * 1024 + u.pm * 256) * 1024 + g * 256, 1024, wr, wc, fr, fq); }
};
struct SchedStd {
    const bf16_t* A; const bf16_t* B; int nM, nN, lda, ldb, G, c, nrep;
    __device__ __forceinline__ bool next(int i, pg8::Unit& u) const { int L = i * G + c; if (L >= nM * nN * nrep) return false; L %= nM * nN; pg8::std_order(L, nM, nN, u.pm, u.pn, 4); u.z = 0; return true; }
    __device__ __forceinline__ void ptrs(const pg8::Unit& u, const char*& a, const char*& b) const { a = (const char*)(A + (size_t)u.pm * 256 * lda); b = (const char*)(B + (size_t)u.pn * 256 * ldb); }
};
struct EpiY { static constexpr bool PERM = true, PERMA = false; bf16_t* y; float* rss;
    __device__ __forceinline__ void operator()(const f32x4 (&acc)[2][2][4][2], const pg8::Unit& u, int wr, int wc, int fr, int fq) const {
        pg8::store_tile_bf16(acc, y + (size_t)u.pm * 256 * D + u.pn * 256, D, wr, wc, fr, fq);
#pragma unroll
        for (int ai = 0; ai < 2; ++ai)
#pragma unroll
            for (int m = 0; m < 4; ++m) { float s = 0.f;
#pragma unroll
                for (int bj = 0; bj < 2; ++bj)
#pragma unroll
                    for (int n = 0; n < 2; ++n) { const f32x4 v = acc[ai][bj][m][n]; s += (v[0] * v[0] + v[1] * v[1]) + (v[2] * v[2] + v[3] * v[3]); }
                s += __shfl_xor(s, 16); s += __shfl_xor(s, 32);
                if (fq == 0) rss[(size_t)(u.pm * 256 + ai * 128 + wr * 64 + m * 16 + fr) * 32 + u.pn * 4 + wc] = s; }
    }
};
template <int CTRL> __device__ __forceinline__ float dpp_f(float old, float src) { return __int_as_float(__builtin_amdgcn_update_dpp(__float_as_int(old), __float_as_int(src), CTRL, 0xF, 0xF, false)); }
constexpr int DPP_SHL1 = 0x101, DPP_SHR1 = 0x111, DPP_ROR1 = 0x121, DPP_ROR15 = 0x12F;
constexpr int LDS_EDGE = 131072;
#ifndef OUTREP
#define OUTREP 1
#endif
#ifndef DOWNREP
#define DOWNREP 1
#endif
#ifndef UPREP
#define UPREP 1
#endif
struct SchedUp {
    const bf16_t* A; const bf16_t* B; int G, c;
    __device__ __forceinline__ bool next(int i, pg8::Unit& u) const { int L = i * G + c; if (L >= 64 * 44 * UPREP) return false; L %= 64 * 44; pg8::std_order(L, 64, 44, u.pm, u.pn, 4); u.z = 0; return true; }
    __device__ __forceinline__ void ptrs(const pg8::Unit& u, const char*& a, const char*& b) const { a = (const char*)(A + (size_t)u.pm * 256 * D); b = (const char*)(B + (size_t)u.pn * 128 * D); }
};
struct EpiUpConv { static constexpr bool PERM = true, PERMA = true; bf16_t* act; float* edge; const float* cw; const float* cb; LAS unsigned char* lds;
    __device__ __forceinline__ void operator()(f32x4 (&acc)[2][2][4][2], const pg8::Unit& u, int wr, int wc, int fr, int fq) const {
        const int colw = 32 * wc + 8 * fq;
        LAS float* E = (LAS float*)(lds + LDS_EDGE) + wr * 512 + colw;
#pragma unroll
        for (int ai = 0; ai < 2; ++ai)
#pragma unroll
            for (int bj = 0; bj < 2; ++bj)
#pragma unroll
                for (int n = 0; n < 2; ++n) {
                    if (fr == 0) *(LAS f32x4*)(E + (4 * ai + 1) * 256 + bj * 128 + 4 * n) = acc[ai][bj][0][n];
                    if (fr == 15) *(LAS f32x4*)(E + (4 * ai + 2) * 256 + bj * 128 + 4 * n) = acc[ai][bj][3][n]; }
        { float* eg = edge + (size_t)u.pm * 4 * DFF2 + u.pn * 128 + colw;
          if (wr == 0) { if (fr == 0) {
#pragma unroll
              for (int bj = 0; bj < 2; ++bj)
#pragma unroll
                  for (int n = 0; n < 2; ++n) { *(f32x4*)(eg + bj * DFF + 4 * n) = acc[0][bj][0][n]; *(f32x4*)(eg + DFF2 + bj * DFF + 4 * n) = acc[0][bj][1][n]; } } }
          else { if (fr == 15) {
#pragma unroll
              for (int bj = 0; bj < 2; ++bj)
#pragma unroll
                  for (int n = 0; n < 2; ++n) { *(f32x4*)(eg + 2 * DFF2 + bj * DFF + 4 * n) = acc[1][bj][2][n]; *(f32x4*)(eg + 3 * DFF2 + bj * DFF + 4 * n) = acc[1][bj][3][n]; } } } }
        const float* cwp = cw + u.pn * 128 + colw; const float* cbp = cb + u.pn * 128 + colw;
        f32x4 W[2][8];
#pragma unroll
        for (int n = 0; n < 2; ++n) { W[n][0] = *(const f32x4*)(cwp + 4 * n); W[n][1] = *(const f32x4*)(cwp + DFF2 + 4 * n); W[n][2] = *(const f32x4*)(cwp + 2 * DFF2 + 4 * n); W[n][3] = *(const f32x4*)(cbp + 4 * n);
            W[n][4] = *(const f32x4*)(cwp + DFF + 4 * n); W[n][5] = *(const f32x4*)(cwp + DFF2 + DFF + 4 * n); W[n][6] = *(const f32x4*)(cwp + 2 * DFF2 + DFF + 4 * n); W[n][7] = *(const f32x4*)(cbp + DFF + 4 * n); }
        asm volatile("s_waitcnt lgkmcnt(0)" ::: "memory"); __builtin_amdgcn_s_barrier(); __builtin_amdgcn_s_barrier(); asm volatile("" ::: "memory");
#pragma unroll
        for (int n = 0; n < 2; ++n) {
            f32x4 wg0 = W[n][0], wg1 = W[n][1], wg2 = W[n][2], bg = W[n][3], wv0 = W[n][4], wv1 = W[n][5], wv2 = W[n][6], bv = W[n][7];
            asm volatile("" : "+v"(wg0), "+v"(wg1), "+v"(wg2), "+v"(bg), "+v"(wv0), "+v"(wv1), "+v"(wv2), "+v"(bv));
#pragma unroll
            for (int ai = 0; ai < 2; ++ai) {
                f32x4 ep0 = *(const LAS f32x4*)(E + (4 * ai) * 256 + 4 * n), ep1 = *(const LAS f32x4*)(E + (4 * ai) * 256 + 128 + 4 * n);
                f32x4 en0 = *(const LAS f32x4*)(E + (4 * ai + 3) * 256 + 4 * n), en1 = *(const LAS f32x4*)(E + (4 * ai + 3) * 256 + 128 + 4 * n);
                asm volatile("" : "+v"(ep0), "+v"(ep1), "+v"(en0), "+v"(en1));
                f32x4 T[4];
#pragma unroll
                for (int m = 0; m < 4; ++m) {
                    asm volatile("" : "+v"(acc[ai][0][m][n]), "+v"(acc[ai][1][m][n]));
#pragma unroll
                    for (int q = 0; q < 4; q += 2) {
                        f32x2 g, v, gp, vp, gn, vn;
#pragma unroll
                        for (int e = 0; e < 2; ++e) { const int qq = q + e;
                            g[e] = acc[ai][0][m][n][qq]; v[e] = acc[ai][1][m][n][qq];
                            gp[e] = m > 0 ? acc[ai][0][m > 0 ? m - 1 : 0][n][qq] : dpp_f<DPP_SHR1>(ep0[qq], acc[ai][0][3][n][qq]);
                            vp[e] = m > 0 ? acc[ai][1][m > 0 ? m - 1 : 0][n][qq] : dpp_f<DPP_SHR1>(ep1[qq], acc[ai][1][3][n][qq]);
                            gn[e] = m < 3 ? acc[ai][0][m < 3 ? m + 1 : 3][n][qq] : dpp_f<DPP_SHL1>(en0[qq], acc[ai][0][0][n][qq]);
                            vn[e] = m < 3 ? acc[ai][1][m < 3 ? m + 1 : 3][n][qq] : dpp_f<DPP_SHL1>(en1[qq], acc[ai][1][0][n][qq]); }
                        const f32x2 w0g = (f32x2){wg0[q], wg0[q + 1]}, w1g = (f32x2){wg1[q], wg1[q + 1]}, w2g = (f32x2){wg2[q], wg2[q + 1]}, b0g = (f32x2){bg[q], bg[q + 1]};
                        const f32x2 w0v = (f32x2){wv0[q], wv0[q + 1]}, w1v = (f32x2){wv1[q], wv1[q + 1]}, w2v = (f32x2){wv2[q], wv2[q + 1]}, b0v = (f32x2){bv[q], bv[q + 1]};
                        const f32x2 gg = b0g + w0g * gp + w1g * g + w2g * gn;
                        const f32x2 vv = b0v + w0v * vp + w1v * v + w2v * vn;
                        const f32x2 arg = gg * ((gg * gg) * (-2.302208198f * 0.044715f) + (-2.302208198f));
                        f32x2 d; d.x = __builtin_amdgcn_exp2f(arg.x); d.y = __builtin_amdgcn_exp2f(arg.y); d = d + 1.0f;
                        f32x2 r; r.x = __builtin_amdgcn_rcpf(d.x); r.y = __builtin_amdgcn_rcpf(d.y);
                        const f32x2 o = (gg * vv) * r;
                        T[m][q] = o.x; T[m][q + 1] = o.y; }
                    asm volatile("" : "+v"(T[m])); }
#pragma unroll
                for (int m = 0; m < 4; ++m) acc[ai][0][m][n] = T[m]; } }
        bf16_t* p0 = act + (size_t)(u.pm * 256 + wr * 64 + 4 * fr) * DFF + u.pn * 128 + colw;
#pragma unroll
        for (int ai = 0; ai < 2; ++ai)
#pragma unroll
            for (int m = 0; m < 4; ++m) { const f32x4 v0 = acc[ai][0][m][0], v1 = acc[ai][0][m][1];
                u32x4 w; w.x = cvt_pk_bf16(v0[0], v0[1]); w.y = cvt_pk_bf16(v0[2], v0[3]); w.z = cvt_pk_bf16(v1[0], v1[1]); w.w = cvt_pk_bf16(v1[2], v1[3]);
                *(u32x4*)(p0 + (size_t)(ai * 128 + m) * DFF) = w; }
    }
};

constexpr int XB_STRIDE = 136, AR_STRIDE = 132;
constexpr int LDS_XB = 0, LDS_AF = 17408, LDS_IF = LDS_AF + 33792, LDS_AB = LDS_IF + 33792, LDS_IB = LDS_AB + 33792;
static_assert(LDS_IB + 33792 <= LDS_BAR, "lds");

__device__ __forceinline__ void lru_load(const Frame& F, int L, u32x4 (&U)[2][4]) {
    const bf16_t* Ux = (const bf16_t*)(F.ws + WS_UX);
    const int h = L & 7, s = L >> 3, b = s / NCHUNK, j = s % NCHUNK;
    const bool isctx = j < 4; const int rowbase = isctx ? MLAT + b * CTXL : b * SEQ, t0 = isctx ? j * 64 : (j - 4) * 64, len = isctx ? CTXL : SEQ;
#pragma unroll
    for (int i = 0; i < 2; ++i) { const int idx = F.tid + 512 * i, tok = idx >> 4, cg8 = idx & 15;
#pragma unroll
        for (int k = 0; k < 4; ++k) { int tt = t0 + tok + k - 2; tt = tt < 0 ? 0 : (tt >= len ? len - 1 : tt);
            U[i][k] = *(const u32x4*)(Ux + (size_t)(rowbase + tt) * 1024 + h * 128 + cg8 * 8); } }
}
__device__ __forceinline__ void lru_phase(const Frame& F) {
    const bf16_t* WgT = (const bf16_t*)(F.ws + WS_WG);
    bf16_t* So = (bf16_t*)(F.ws + WS_S); bf16_t* Pfo = (bf16_t*)(F.ws + WS_PF); bf16_t* Pbo = (bf16_t*)(F.ws + WS_PB);
    float* agg = (float*)(F.ws + WS_AGG);
    LAS bf16_t* XB = (LAS bf16_t*)(F.lds + LDS_XB);
    const int w = F.wave, fr = F.lane & 15, fq = F.lane >> 4;
    constexpr int NU = NB * NCHUNK * 8;
    int cur_h = -1;
    bf16x8 Wf[4][4];
    int L = F.bid; if (L >= NU) return;
    u32x4 U[2][4];
    lru_load(F, L, U);
    for (;;) {
        const int h = L & 7, s = L >> 3, b = s / NCHUNK, j = s % NCHUNK;
        if (h != cur_h) { cur_h = h;
#pragma unroll
            for (int g4 = 0; g4 < 4; ++g4)
#pragma unroll
                for (int kk = 0; kk < 4; ++kk) Wf[g4][kk] = *(const bf16x8*)(WgT + (size_t)(h * 512 + g4 * 128 + 16 * w + fr) * 128 + kk * 32 + fq * 8);
        }
        const bool isctx = j < 4; const int rowbase = isctx ? MLAT + b * CTXL : b * SEQ, t0 = isctx ? j * 64 : (j - 4) * 64, len = isctx ? CTXL : SEQ;
#pragma unroll
        for (int i = 0; i < 2; ++i) { const int idx = F.tid + 512 * i, tok = idx >> 4, cg8 = idx & 15; const int ch = h * 128 + cg8 * 8;
            float o[8]; { const f32x4 b0 = *(const f32x4*)(F.in[I_CLB] + ch), b1 = *(const f32x4*)(F.in[I_CLB] + ch + 4);
                o[0] = b0[0]; o[1] = b0[1]; o[2] = b0[2]; o[3] = b0[3]; o[4] = b1[0]; o[5] = b1[1]; o[6] = b1[2]; o[7] = b1[3]; }
#pragma unroll
            for (int k = 0; k < 4; ++k) { const int tt = t0 + tok + k - 2; const float msk = (tt >= 0 && tt < len) ? 1.0f : 0.0f;
                float uv[8]; unpack8(U[i][k], uv);
                const f32x4 w0 = *(const f32x4*)(F.in[I_CLW] + k * 1024 + ch) * msk, w1 = *(const f32x4*)(F.in[I_CLW] + k * 1024 + ch + 4) * msk;
                o[0] += w0[0] * uv[0]; o[1] += w0[1] * uv[1]; o[2] += w0[2] * uv[2]; o[3] += w0[3] * uv[3];
                o[4] += w1[0] * uv[4]; o[5] += w1[1] * uv[5]; o[6] += w1[2] * uv[6]; o[7] += w1[3] * uv[7]; }
            *(LAS u32x4*)(XB + tok * XB_STRIDE + cg8 * 8) = pack8(o); }
        const int Ln = L + F.G;
        lru_load(F, Ln < NU ? Ln : NU - 1, U);
        LDS_BARRIER();
#pragma unroll
        for (int d = 0; d < 2; ++d) {
            const int C = d * 1024 + h * 128 + 16 * w + 4 * fq;
            const f32x4 nba = *(const f32x4*)(F.in[I_BREC] + C) * -1.44269504f, nbx = *(const f32x4*)(F.in[I_BING] + C) * -1.44269504f, k2 = *(const f32x4*)((const float*)(F.ws + WS_K2) + C);
            f32x4 acc[2][4];
#pragma unroll
            for (int g2 = 0; g2 < 2; ++g2)
#pragma unroll
                for (int m = 0; m < 4; ++m) acc[g2][m] = (f32x4){0.f, 0.f, 0.f, 0.f};
#pragma unroll
            for (int m = 0; m < 4; ++m) { bf16x8 Xf[4];
#pragma unroll
                for (int kk = 0; kk < 4; ++kk) Xf[kk] = *(const LAS bf16x8*)(XB + (16 * m + fr) * XB_STRIDE + kk * 32 + fq * 8);
#pragma unroll
                for (int g2 = 0; g2 < 2; ++g2)
#pragma unroll
                    for (int kk = 0; kk < 4; ++kk) acc[g2][m] = __builtin_amdgcn_mfma_f32_16x16x32_bf16(Wf[2 * d + g2][kk], Xf[kk], acc[g2][m], 0, 0, 0); }
#pragma unroll
            for (int m = 0; m < 4; ++m) { const int tok = 16 * m + fr;
                const u32x2 xw = *(const LAS u32x2*)(XB + tok * XB_STRIDE + 16 * w + 4 * fq);
                const f32x4 xc = (f32x4){bf_lo(xw.x), bf_hi(xw.x), bf_lo(xw.y), bf_hi(xw.y)};
                f32x4 av, iv;
#pragma unroll
                for (int q = 0; q < 4; ++q) {
                    const float ea = __builtin_amdgcn_exp2f(fminf(fmaf(acc[0][m][q], -1.44269504f, nba[q]), 60.f)), ex = __builtin_amdgcn_exp2f(fminf(fmaf(acc[1][m][q], -1.44269504f, nbx[q]), 60.f));
                    const float pa = 1.0f + ea, px = 1.0f + ex, t = __builtin_amdgcn_rcpf(pa * px), r = t * px, ig = t * pa;
                    const float la2 = r * k2[q]; const float a = __builtin_amdgcn_exp2f(la2); const float u = la2 * 1.38629436f;
                    const float poly = -u * (1.0f + u * (0.5f + u * 0.16666667f));
                    const float em = u > -0.02f ? poly : fmaf(-a, a, 1.0f);
                    av[q] = a; iv[q] = __builtin_amdgcn_sqrtf(fmaxf(em, 0.f)) * ig * xc[q]; }
                *(LAS f32x4*)(F.lds + (d ? LDS_AB : LDS_AF) + (tok * AR_STRIDE + 16 * w + 4 * fq) * 4) = av;
                *(LAS f32x4*)(F.lds + (d ? LDS_IB : LDS_IF) + (tok * AR_STRIDE + 16 * w + 4 * fq) * 4) = iv; }
            asm volatile("" ::: "memory");
        }
        LDS_BARRIER();
        LAS float* ENDS = (LAS float*)(F.lds + LDS_XB);
        { const int half = F.tid >> 8, d = (F.tid >> 7) & 1, ch = F.tid & 127;
            LAS float* A = (LAS float*)(F.lds + (d ? LDS_AB : LDS_AF)) + ch; LAS float* I = (LAS float*)(F.lds + (d ? LDS_IB : LDS_IF)) + ch;
            float hs = 0.f, P = 1.f;
            if (d == 0) { const int tb = half * 32;
#pragma unroll 8
                for (int t = 0; t < 32; ++t) { const float a = A[(tb + t) * AR_STRIDE], x = I[(tb + t) * AR_STRIDE]; hs = a * hs + x; P *= a; I[(tb + t) * AR_STRIDE] = hs; A[(tb + t) * AR_STRIDE] = P; }
            } else { const int tb = 63 - half * 32;
#pragma unroll 8
                for (int t = 0; t < 32; ++t) { const float a = A[(tb - t) * AR_STRIDE], x = I[(tb - t) * AR_STRIDE]; hs = a * hs + x; P *= a; I[(tb - t) * AR_STRIDE] = hs; A[(tb - t) * AR_STRIDE] = P; }
            }
            ENDS[((d * 2 + half) * 2 + 0) * 128 + ch] = P; ENDS[((d * 2 + half) * 2 + 1) * 128 + ch] = hs; }
        LDS_BARRIER();
        if (F.tid < 256) { const int d = F.tid >> 7, ch = F.tid & 127;
            const float P0 = ENDS[((d * 2 + 0) * 2 + 0) * 128 + ch], H0 = ENDS[((d * 2 + 0) * 2 + 1) * 128 + ch], P1 = ENDS[((d * 2 + 1) * 2 + 0) * 128 + ch], H1 = ENDS[((d * 2 + 1) * 2 + 1) * 128 + ch];
            float* ag = agg + ((size_t)(b * NCHUNK + j) * 4 + d * 2) * 1024 + h * 128 + ch; ag[0] = P0 * P1; ag[1024] = P1 * H0 + H1; }
        if (!isctx) {
#pragma unroll
            for (int i = 0; i < 2; ++i) { const int idx = F.tid + 512 * i, tok = idx >> 4, cg8 = idx & 15; const int o = (tok * AR_STRIDE + cg8 * 8) * 4;
                const bool f2 = tok >= 32, b2 = tok < 32;
                float sv[8], pf[8], pb[8];
#pragma unroll
                for (int hh = 0; hh < 2; ++hh) { const f32x4 x0 = *(const LAS f32x4*)(F.lds + LDS_IF + o + hh * 16), x1 = *(const LAS f32x4*)(F.lds + LDS_IB + o + hh * 16);
                    const f32x4 p0 = *(const LAS f32x4*)(F.lds + LDS_AF + o + hh * 16), p1 = *(const LAS f32x4*)(F.lds + LDS_AB + o + hh * 16);
                    const int c0 = cg8 * 8 + hh * 4;
                    const f32x4 fP = f2 ? *(const LAS f32x4*)(ENDS + 0 * 128 + c0) : (f32x4){1.f, 1.f, 1.f, 1.f}, fH = f2 ? *(const LAS f32x4*)(ENDS + 1 * 128 + c0) : (f32x4){0.f, 0.f, 0.f, 0.f};
                    const f32x4 bP = b2 ? *(const LAS f32x4*)(ENDS + 4 * 128 + c0) : (f32x4){1.f, 1.f, 1.f, 1.f}, bH = b2 ? *(const LAS f32x4*)(ENDS + 5 * 128 + c0) : (f32x4){0.f, 0.f, 0.f, 0.f};
#pragma unroll
                    for (int q = 0; q < 4; ++q) { sv[hh * 4 + q] = (x0[q] + p0[q] * fH[q]) + (x1[q] + p1[q] * bH[q]); pf[hh * 4 + q] = p0[q] * fP[q]; pb[hh * 4 + q] = p1[q] * bP[q]; } }
                const size_t go = (size_t)(rowbase + t0 + tok) * 1024 + h * 128 + cg8 * 8;
                *(u32x4*)(So + go) = pack8(sv); *(u32x4*)(Pfo + go) = pack8(pf); *(u32x4*)(Pbo + go) = pack8(pb); }
        }
        LDS_BARRIER();
        if (Ln >= NU) break;
        L = Ln;
    }
    __syncthreads();
}

__device__ __forceinline__ void alt_phase(const Frame& F) {
    const bf16_t* PQT = (const bf16_t*)(F.ws + WS_PQT); float* y1024 = (float*)(F.ws + WS_Y1024);
    const bf16_t* ct = (const bf16_t*)(F.ws + WS_CTAB);
    const float sc = __uint_as_float(((unsigned)ct[0]) << 16);
    for (int o = F.bid * 8 + F.wave; o < 8192; o += F.G * 8) {
        const int bg = o >> 8, d = o & 255; const bf16_t* p = PQT + (size_t)(bg * 512 + d) * 2048 + F.lane * 32; float s = 0.f;
#pragma unroll
        for (int i = 0; i < 4; ++i) { float v[8]; unpack8(*(const u32x4*)(p + i * 8), v); s += (v[0] - v[1]) + (v[2] - v[3]) + (v[4] - v[5]) + (v[6] - v[7]); }
        s = wave_sum(s);
        if (F.lane == 0) y1024[(bg >> 2) * 1024 + (bg & 3) * 256 + d] = s * sc;
    }
}

__device__ __forceinline__ void assemble_phase(const Frame& F) {
    const float* agg = (const float*)(F.ws + WS_AGG);
    const bf16_t* S = (const bf16_t*)(F.ws + WS_S); const bf16_t* Pf = (const bf16_t*)(F.ws + WS_PF); const bf16_t* Pb = (const bf16_t*)(F.ws + WS_PB); const bf16_t* Ug = (const bf16_t*)(F.ws + WS_UG);
    const bf16_t* cp = (const bf16_t*)(F.ws + WS_CPSQ); const bf16_t* sq = cp + (size_t)8192 * 1024; const float* y1024 = (const float*)(F.ws + WS_Y1024);
    bf16_t* YA = (bf16_t*)(F.ws + WS_YA);
    LAS float* cf = (LAS float*)F.lds; LAS float* cb = cf + 1024;
    for (int L = F.bid; L < 256; L += F.G) {
        const int b = L >> 5, jc = L & 31, jj = jc + 4;
#pragma unroll
        for (int e = 0; e < 2; ++e) { const int ch = F.tid + 512 * e; const float* a0 = agg + (size_t)b * NCHUNK * 4096 + ch;
            float c = 0.f, c2 = 0.f;
#pragma unroll
            for (int i0 = 0; i0 < NCHUNK; i0 += 12) { float fa[12], fh[12], ba[12], bh[12];
#pragma unroll
                for (int k = 0; k < 12; ++k) { const int i = i0 + k; const int ib = i < 4 ? 3 - i : NCHUNK + 3 - i;
                    fa[k] = a0[(size_t)i * 4096]; fh[k] = a0[(size_t)i * 4096 + 1024]; ba[k] = a0[(size_t)ib * 4096 + 2048]; bh[k] = a0[(size_t)ib * 4096 + 3072]; }
#pragma unroll
                for (int k = 0; k < 12; ++k) { const int i = i0 + k; const int ib = i < 4 ? 3 - i : NCHUNK + 3 - i;
                    if (i < jj) c = fa[k] * c + fh[k];
                    if (ib < 4 || ib > jj) c2 = ba[k] * c2 + bh[k]; } }
            cf[ch] = c; cb[ch] = c2; }
        __syncthreads();
        const int row0 = b * SEQ + jc * 64;
        for (int i0 = 0; i0 < 16; i0 += 4) { u32x4 sw[4], fw[4], bw[4], gw[4];
#pragma unroll
            for (int k = 0; k < 4; ++k) { const int idx = F.tid + 512 * (i0 + k), row = idx >> 7, cg8 = idx & 127; const size_t go = (size_t)(row0 + row) * 1024 + cg8 * 8;
                sw[k] = __builtin_nontemporal_load((const u32x4*)(S + go)); fw[k] = __builtin_nontemporal_load((const u32x4*)(Pf + go)); bw[k] = __builtin_nontemporal_load((const u32x4*)(Pb + go)); gw[k] = __builtin_nontemporal_load((const u32x4*)(Ug + go)); }
#pragma unroll
            for (int k = 0; k < 4; ++k) { const int idx = F.tid + 512 * (i0 + k), row = idx >> 7, cg8 = idx & 127;
                float sv[8], pf[8], pb[8], ug[8], o[8]; unpack8(sw[k], sv); unpack8(fw[k], pf); unpack8(bw[k], pb); unpack8(gw[k], ug);
#pragma unroll
                for (int q = 0; q < 8; ++q) o[q] = (sv[q] + pf[q] * cf[cg8 * 8 + q] + pb[q] * cb[cg8 * 8 + q]) * gelu_tanh(ug[q]);
                *(u32x4*)(YA + (size_t)(row0 + row) * D + 1024 + cg8 * 8) = pack8(o); } }
        for (int i0 = 0; i0 < 32; i0 += 8) { u32x2 c4v[8], s4v[8];
#pragma unroll
            for (int k = 0; k < 8; ++k) { const int idx = F.tid + 512 * (i0 + k), row = idx >> 8, c4 = (idx & 255) * 4; const int kk = jc * 64 + row;
                const int ks = kk <= 1024 ? kk : 2048 - kk;
                const size_t o = (size_t)(b * 1024 + (ks < 1024 ? ks : 1023)) * 1024 + c4;
                c4v[k] = __builtin_nontemporal_load((const u32x2*)(cp + o)); s4v[k] = __builtin_nontemporal_load((const u32x2*)(sq + o)); }
#pragma unroll
            for (int k = 0; k < 8; ++k) { const int idx = F.tid + 512 * (i0 + k), row = idx >> 8, c4 = (idx & 255) * 4; const int kk = jc * 64 + row;
                const f32x4 cv = (f32x4){bf_lo(c4v[k].x), bf_hi(c4v[k].x), bf_lo(c4v[k].y), bf_hi(c4v[k].y)}, sv4 = (f32x4){bf_lo(s4v[k].x), bf_hi(s4v[k].x), bf_lo(s4v[k].y), bf_hi(s4v[k].y)};
                f32x4 y = kk < 1024 ? cv - sv4 : cv + sv4;
                if (kk == 1024) y = *(const f32x4*)(y1024 + b * 1024 + c4);
                y += *(const f32x4*)(F.in[I_BFOU] + c4);
                u32x2 w; w.x = cvt_pk_bf16(y[0], y[1]); w.y = cvt_pk_bf16(y[2], y[3]);
                *(u32x2*)(YA + (size_t)(row0 + row) * D + c4) = w; } }
        __syncthreads();
    }
}

__device__ __forceinline__ f32x4 ld_bf4(const bf16_t* p) { const u32x2 w = *(const u32x2*)p; return (f32x4){bf_lo(w.x), bf_hi(w.x), bf_lo(w.y), bf_hi(w.y)}; }
__device__ __forceinline__ void p7_norm2_staged(const Frame& F) {
    const float* pt = (const float*)(F.ws + WS_POS); const float* mod = (const float*)(F.ws + WS_MOD);
    const bf16_t* Y = (const bf16_t*)(F.ws + WS_Y); const float* rss = (const float*)(F.ws + WS_RSS1); bf16_t* H2 = (bf16_t*)(F.ws + WS_H2);
    const float* gpost = F.in[I_GMIXPOST]; const float* gpre = F.in[I_GFFNPRE];
    LAS float* L = (LAS float*)F.lds;
    for (int k0 = 0; k0 < NB; k0 += 2) {
        __syncthreads();
        for (int e = F.tid; e < 2 * 512; e += 512) { const int j = e >> 9, c4 = (e & 511) * 4; const float* mrow = mod + (size_t)(k0 + j) * 12288;
            *(LAS f32x4*)(L + (j * 3 + 0) * 2048 + c4) = *(const f32x4*)(mrow + 4096 + c4) * *(const f32x4*)(gpost + c4);
            *(LAS f32x4*)(L + (j * 3 + 1) * 2048 + c4) = (1.0f + *(const f32x4*)(mrow + 8192 + c4)) * *(const f32x4*)(gpre + c4);
            *(LAS f32x4*)(L + (j * 3 + 2) * 2048 + c4) = *(const f32x4*)(mrow + 6144 + c4); }
        __syncthreads();
        const int t = F.bid * 8 + F.wave;
        f32x4 v[2][8]; u32x2 yw[2][8]; float ssy[2], ss[2] = {0.f, 0.f};
#pragma unroll
        for (int j = 0; j < 2; ++j) { const int r = t + (k0 + j) * 2048; ssy[j] = F.lane < 32 ? rss[(size_t)r * 32 + F.lane] : 0.f;
#pragma unroll
            for (int i = 0; i < 8; ++i) { const int col = (i * 64 + F.lane) * 4; v[j][i] = __builtin_nontemporal_load((const f32x4*)(F.in[I_X] + (size_t)r * D + col)); yw[j][i] = __builtin_nontemporal_load((const u32x2*)(Y + (size_t)r * D + col)); } }
        f32x4 pp[8];
#pragma unroll
        for (int i = 0; i < 8; ++i) pp[i] = pos4(pt, t, (i * 64 + F.lane) * 4);
#pragma unroll
        for (int j = 0; j < 2; ++j) { const float rstdy = rsqrtf(wave_sum(ssy[j]) * (1.0f / D) + EPS);
#pragma unroll
            for (int i = 0; i < 8; ++i) { const int col = (i * 64 + F.lane) * 4;
                const f32x4 yv = (f32x4){bf_lo(yw[j][i].x), bf_hi(yw[j][i].x), bf_lo(yw[j][i].y), bf_hi(yw[j][i].y)};
                v[j][i] = v[j][i] + pp[i] + *(const LAS f32x4*)(L + (j * 3 + 0) * 2048 + col) * (yv * rstdy);
                ss[j] += v[j][i][0] * v[j][i][0] + v[j][i][1] * v[j][i][1] + v[j][i][2] * v[j][i][2] + v[j][i][3] * v[j][i][3]; } }
#pragma unroll
        for (int j = 0; j < 2; ++j) { const int r = t + (k0 + j) * 2048; const float rstd = rsqrtf(wave_sum(ss[j]) * (1.0f / D) + EPS);
#pragma unroll
            for (int i = 0; i < 8; ++i) { const int col = (i * 64 + F.lane) * 4;
                const f32x4 h = (v[j][i] * rstd) * *(const LAS f32x4*)(L + (j * 3 + 1) * 2048 + col) + *(const LAS f32x4*)(L + (j * 3 + 2) * 2048 + col);
                u32x2 w; w.x = cvt_pk_bf16(h[0], h[1]); w.y = cvt_pk_bf16(h[2], h[3]);
                *(u32x2*)(H2 + (size_t)r * D + col) = w; } }
    }
    __syncthreads();
}
__device__ __forceinline__ void p7_norm2(const Frame& F) {
    const float* pt = (const float*)(F.ws + WS_POS); const float* mod = (const float*)(F.ws + WS_MOD);
    const bf16_t* Y = (const bf16_t*)(F.ws + WS_Y); const float* rss = (const float*)(F.ws + WS_RSS1); bf16_t* H2 = (bf16_t*)(F.ws + WS_H2);
    const float* gpost = F.in[I_GMIXPOST]; const float* gpre = F.in[I_GFFNPRE];
    const int nw = F.G * 8;
    for (int r0 = F.bid * 8 + F.wave; r0 < MLAT; r0 += 2 * nw) {
        f32x4 v[2][8]; float ssy[2], ss[2] = {0.f, 0.f};
#pragma unroll
        for (int j = 0; j < 2; ++j) { const int r = r0 + j * nw < MLAT ? r0 + j * nw : r0; ssy[j] = F.lane < 32 ? rss[(size_t)r * 32 + F.lane] : 0.f; }
        u32x2 yw[2][8];
#pragma unroll
        for (int j = 0; j < 2; ++j) { const int r = r0 + j * nw < MLAT ? r0 + j * nw : r0;
#pragma unroll
            for (int i = 0; i < 8; ++i) { const int col = (i * 64 + F.lane) * 4; v[j][i] = *(const f32x4*)(F.in[I_X] + (size_t)r * D + col); yw[j][i] = *(const u32x2*)(Y + (size_t)r * D + col); } }
#pragma unroll
        for (int j = 0; j < 2; ++j) { const int r = r0 + j * nw < MLAT ? r0 + j * nw : r0; const int b = r >> 11, t = r & 2047; const float* mrow = mod + (size_t)b * 12288;
            const float rstdy = rsqrtf(wave_sum(ssy[j]) * (1.0f / D) + EPS);
#pragma unroll
            for (int i = 0; i < 8; ++i) { const int col = (i * 64 + F.lane) * 4;
                const f32x4 yv = (f32x4){bf_lo(yw[j][i].x), bf_hi(yw[j][i].x), bf_lo(yw[j][i].y), bf_hi(yw[j][i].y)}, gp = *(const f32x4*)(gpost + col), gt = *(const f32x4*)(mrow + 4096 + col);
                v[j][i] = v[j][i] + pos4(pt, t, col) + gt * (yv * rstdy * gp);
                ss[j] += v[j][i][0] * v[j][i][0] + v[j][i][1] * v[j][i][1] + v[j][i][2] * v[j][i][2] + v[j][i][3] * v[j][i][3]; } }
#pragma unroll
        for (int j = 0; j < 2; ++j) { const int r = r0 + j * nw; if (r >= MLAT) break; const int b = r >> 11; const float* mrow = mod + (size_t)b * 12288;
            const float rstd = rsqrtf(wave_sum(ss[j]) * (1.0f / D) + EPS);
#pragma unroll
            for (int i = 0; i < 8; ++i) { const int col = (i * 64 + F.lane) * 4; const f32x4 gg = *(const f32x4*)(gpre + col), sh = *(const f32x4*)(mrow + 6144 + col), sc = *(const f32x4*)(mrow + 8192 + col);
                const f32x4 h = (v[j][i] * rstd * gg) * (1.0f + sc) + sh; u32x2 w; w.x = cvt_pk_bf16(h[0], h[1]); w.y = cvt_pk_bf16(h[2], h[3]);
                *(u32x2*)(H2 + (size_t)r * D + col) = w; } }
    }
}

__device__ __forceinline__ void fixup_panel(const Frame& F, int pm) {
    const float* edge = (const float*)(F.ws + WS_EDGE); bf16_t* act = (bf16_t*)(F.ws + WS_ACT);
    const float* cw = F.in[I_CFW]; const float* cb = F.in[I_CFB];
    const int tb = pm & 7;
    for (int idx = F.tid; idx < 2 * 1408; idx += 512) {
        const int e = idx >= 1408, c = (idx - e * 1408) * 4;
        const f32x4 z = (f32x4){0.f, 0.f, 0.f, 0.f};
        f32x4 gp, gc, gn, vp, vc, vn;
        if (e == 0) { const float* pr = edge + ((size_t)(pm - 1) * 4 + 3) * DFF2; const float* cu = edge + ((size_t)pm * 4 + 0) * DFF2; const float* nx = edge + ((size_t)pm * 4 + 1) * DFF2;
            gp = tb ? *(const f32x4*)(pr + c) : z; vp = tb ? *(const f32x4*)(pr + DFF + c) : z; gc = *(const f32x4*)(cu + c); vc = *(const f32x4*)(cu + DFF + c); gn = *(const f32x4*)(nx + c); vn = *(const f32x4*)(nx + DFF + c); }
        else { const float* pr = edge + ((size_t)pm * 4 + 2) * DFF2; const float* cu = edge + ((size_t)pm * 4 + 3) * DFF2; const float* nx = edge + ((size_t)(pm + 1) * 4 + 0) * DFF2;
            gp = *(const f32x4*)(pr + c); vp = *(const f32x4*)(pr + DFF + c); gc = *(const f32x4*)(cu + c); vc = *(const f32x4*)(cu + DFF + c); gn = tb != 7 ? *(const f32x4*)(nx + c) : z; vn = tb != 7 ? *(const f32x4*)(nx + DFF + c) : z; }
        const f32x4 gg = *(const f32x4*)(cb + c) + *(const f32x4*)(cw + c) * gp + *(const f32x4*)(cw + DFF2 + c) * gc + *(const f32x4*)(cw + 2 * DFF2 + c) * gn;
        const f32x4 vv = *(const f32x4*)(cb + DFF + c) + *(const f32x4*)(cw + DFF + c) * vp + *(const f32x4*)(cw + DFF2 + DFF + c) * vc + *(const f32x4*)(cw + 2 * DFF2 + DFF + c) * vn;
        u32x2 w; w.x = cvt_pk_bf16(gelu_tanh(gg[0]) * vv[0], gelu_tanh(gg[1]) * vv[1]); w.y = cvt_pk_bf16(gelu_tanh(gg[2]) * vv[2], gelu_tanh(gg[3]) * vv[3]);
        *(u32x2*)(act + (size_t)(pm * 256 + (e ? 255 : 0)) * DFF + c) = w;
    }
}

__device__ __forceinline__ void final_phase_staged(const Frame& F) {
    const float* pt = (const float*)(F.ws + WS_POS); const float* mod = (const float*)(F.ws + WS_MOD);
    const bf16_t* Y = (const bf16_t*)(F.ws + WS_Y); const bf16_t* Y2 = (const bf16_t*)(F.ws + WS_Y2);
    const float* rss1 = (const float*)(F.ws + WS_RSS1); const float* rss2 = (const float*)(F.ws + WS_RSS2);
    const float* gpost1 = F.in[I_GMIXPOST]; const float* gpost2 = F.in[I_GFFNPOST];
    LAS float* L = (LAS float*)F.lds;
    for (int k0 = 0; k0 < NB; k0 += 2) {
        __syncthreads();
        for (int e = F.tid; e < 2 * 512; e += 512) { const int j = e >> 9, c4 = (e & 511) * 4; const float* mrow = mod + (size_t)(k0 + j) * 12288;
            *(LAS f32x4*)(L + (j * 2 + 0) * 2048 + c4) = *(const f32x4*)(mrow + 4096 + c4) * *(const f32x4*)(gpost1 + c4);
            *(LAS f32x4*)(L + (j * 2 + 1) * 2048 + c4) = *(const f32x4*)(mrow + 10240 + c4) * *(const f32x4*)(gpost2 + c4); }
        __syncthreads();
        const int t = F.bid * 8 + F.wave;
        f32x4 xv[2][8]; u32x2 y1[2][8], y2[2][8]; float s1[2], s2[2];
#pragma unroll
        for (int j = 0; j < 2; ++j) { const int r = t + (k0 + j) * 2048; s1[j] = F.lane < 32 ? rss1[(size_t)r * 32 + F.lane] : 0.f; s2[j] = F.lane < 32 ? rss2[(size_t)r * 32 + F.lane] : 0.f;
#pragma unroll
            for (int i = 0; i < 8; ++i) { const int col = (i * 64 + F.lane) * 4; xv[j][i] = __builtin_nontemporal_load((const f32x4*)(F.in[I_X] + (size_t)r * D + col)); y1[j][i] = __builtin_nontemporal_load((const u32x2*)(Y + (size_t)r * D + col)); y2[j][i] = __builtin_nontemporal_load((const u32x2*)(Y2 + (size_t)r * D + col)); } }
        f32x4 pp[8];
#pragma unroll
        for (int i = 0; i < 8; ++i) pp[i] = pos4(pt, t, (i * 64 + F.lane) * 4);
#pragma unroll
        for (int j = 0; j < 2; ++j) { const int r = t + (k0 + j) * 2048;
            const float rstd1 = rsqrtf(wave_sum(s1[j]) * (1.0f / D) + EPS), rstd2 = rsqrtf(wave_sum(s2[j]) * (1.0f / D) + EPS);
#pragma unroll
            for (int i = 0; i < 8; ++i) { const int col = (i * 64 + F.lane) * 4;
                const f32x4 a1 = (f32x4){bf_lo(y1[j][i].x), bf_hi(y1[j][i].x), bf_lo(y1[j][i].y), bf_hi(y1[j][i].y)}, a2 = (f32x4){bf_lo(y2[j][i].x), bf_hi(y2[j][i].x), bf_lo(y2[j][i].y), bf_hi(y2[j][i].y)};
                __builtin_nontemporal_store(xv[j][i] + pp[i] + *(const LAS f32x4*)(L + (j * 2 + 0) * 2048 + col) * (a1 * rstd1) + *(const LAS f32x4*)(L + (j * 2 + 1) * 2048 + col) * (a2 * rstd2), (f32x4*)(F.out + (size_t)r * D + col)); } }
    }
    __syncthreads();
}
__device__ __forceinline__ void final_phase(const Frame& F) {
    const float* pt = (const float*)(F.ws + WS_POS); const float* mod = (const float*)(F.ws + WS_MOD);
    const bf16_t* Y = (const bf16_t*)(F.ws + WS_Y); const bf16_t* Y2 = (const bf16_t*)(F.ws + WS_Y2);
    const float* rss1 = (const float*)(F.ws + WS_RSS1); const float* rss2 = (const float*)(F.ws + WS_RSS2);
    const float* gpost1 = F.in[I_GMIXPOST]; const float* gpost2 = F.in[I_GFFNPOST];
    for (int r = F.bid * 8 + F.wave; r < MLAT; r += F.G * 8) {
        const int b = r >> 11, t = r & 2047; const float* mrow = mod + (size_t)b * 12288;
        float s1 = F.lane < 32 ? rss1[(size_t)r * 32 + F.lane] : 0.f, s2 = F.lane < 32 ? rss2[(size_t)r * 32 + F.lane] : 0.f;
        s1 = wave_sum(s1); s2 = wave_sum(s2);
        const float rstd1 = rsqrtf(s1 * (1.0f / D) + EPS), rstd2 = rsqrtf(s2 * (1.0f / D) + EPS);
#pragma unroll
        for (int i = 0; i < 8; ++i) { const int col = (i * 64 + F.lane) * 4;
            const f32x4 xv = *(const f32x4*)(F.in[I_X] + (size_t)r * D + col) + pos4(pt, t, col);
            const f32x4 y1 = ld_bf4(Y + (size_t)r * D + col), y2 = ld_bf4(Y2 + (size_t)r * D + col);
            const f32x4 g1 = *(const f32x4*)(gpost1 + col), g2 = *(const f32x4*)(gpost2 + col), gt1 = *(const f32x4*)(mrow + 4096 + col), gt2 = *(const f32x4*)(mrow + 10240 + col);
            __builtin_nontemporal_store(xv + gt1 * (y1 * rstd1 * g1) + gt2 * (y2 * rstd2 * g2), (f32x4*)(F.out + (size_t)r * D + col)); }
    }
}

constexpr int N_PHASES = 13;
__global__ void __launch_bounds__(512, 2) hybrid_fwd(Args args) {
    extern __shared__ __attribute__((aligned(16))) unsigned char lds_raw[];
    Frame F; F.in = args.in; F.out = args.out; F.ws = args.ws; F.lds = (LAS unsigned char*)lds_raw;
    F.tid = threadIdx.x; F.lane = F.tid & 63; F.wave = __builtin_amdgcn_readfirstlane(F.tid >> 6); F.G = gridDim.x; F.bid = blockIdx.x;
    const int lo = args.ph_lo, hi = args.ph_hi;
#ifndef DUP_PHASE
#define DUP_PHASE -1
#endif
#define NREP(k) ((k) == DUP_PHASE ? 2 : 1)
#define IN(k) (lo <= (k) && (k) < hi)
#define SEAM(k) do { if (IN(k) && IN((k) + 1)) xcd_barrier(bar); } while (0)
    unsigned char* ws = args.ws;
    if (lo < 0) cg::this_grid().sync();
    if (F.tid < 16) ((LAS unsigned*)(F.lds + LDS_BAR))[F.tid] = 0u;
    __syncthreads();
    XcdBarrier bar; bar.bar = (unsigned*)ws; bar.x = 0; bar.st = (volatile LAS unsigned*)(F.lds + LDS_BAR);
    if (hi - lo > 1) bar = xcd_barrier_post((unsigned*)ws, (volatile LAS unsigned*)(F.lds + LDS_BAR));
    if (IN(0)) for (int rep_ = 0; rep_ < NREP(0); ++rep_) p0_prologue(F);
    SEAM(0);
    if (IN(1)) p1_norm(F, MLAT, MALL, 0, F.G);
    SEAM(1);
    if (IN(2)) {
        if (F.G >= 64) {
            if (F.bid < 32) { pg8::Gemm g{D, D, D, (size_t)128 * D * 2, (size_t)128 * D * 2};
                SchedWin S{(const bf16_t*)(ws + WS_H), (const bf16_t*)(ws + WS_WIN), 32, F.bid, 768, 800};
                EpiWin E{(bf16_t*)(ws + WS_UF)};
                pg8::gemm_phase(F.lds, g, S, E); }
            else if (((F.G - 32) & 7) == 0) p1_latent_staged(F, 32, F.G - 32); else p1_norm(F, 0, MLAT, 32, F.G - 32);
        } else { p1_norm(F, 0, MLAT, 0, F.G); }
    }
    SEAM(2);
    if (IN(3)) for (int rep_ = 0; rep_ < NREP(3); ++rep_) { pg8::Gemm g{D, D, D, (size_t)128 * D * 2, (size_t)128 * D * 2};
        SchedWin S{(const bf16_t*)(ws + WS_H), (const bf16_t*)(ws + WS_WIN), F.G, F.bid, 0, F.G >= 64 ? 768 : 800};
        EpiWin E{(bf16_t*)(ws + WS_UF)};
        pg8::gemm_phase(F.lds, g, S, E); }
    SEAM(3);
    if (IN(4)) { { pg8::Gemm g{256, 1024, 256, (size_t)128 * 256 * 2, (size_t)128 * 1024 * 2};
        SchedPQ S{(const bf16_t*)(ws + WS_WCS), (const bf16_t*)(ws + WS_UF), F.G, F.bid};
        EpiPQ E{(bf16_t*)(ws + WS_PQT)};
        pg8::gemm_phase(F.lds, g, S, E); }
        lru_phase(F); if (DUP_PHASE == 4) lru_phase(F); }
    SEAM(4);
    if (IN(5)) for (int rep_ = 0; rep_ < NREP(5); ++rep_) { pg8::Gemm g{2048, 2048, 2048, (size_t)128 * 2048 * 2, (size_t)128 * 2048 * 2};
        SchedDFT S{(const bf16_t*)(ws + WS_CTAB), (const bf16_t*)(ws + WS_STAB), (const bf16_t*)(ws + WS_PQT), F.G, F.bid};
        EpiDFT E{(bf16_t*)(ws + WS_CPSQ)};
        pg8::gemm_phase(F.lds, g, S, E);
        alt_phase(F); }
    SEAM(5);
    if (IN(6)) for (int rep_ = 0; rep_ < NREP(6); ++rep_) assemble_phase(F);
    SEAM(6);
    if (IN(7)) for (int rep_ = 0; rep_ < NREP(7); ++rep_) { pg8::Gemm g{D, D, D, (size_t)128 * D * 2, (size_t)128 * D * 2};
        SchedStd S{(const bf16_t*)(ws + WS_YA), (const bf16_t*)(ws + WS_WOUT), 64, 8, D, D, F.G, F.bid, OUTREP};
        EpiY E{(bf16_t*)(ws + WS_Y), (float*)(ws + WS_RSS1)};
        pg8::gemm_phase(F.lds, g, S, E); }
    SEAM(7);
    if (IN(8)) for (int rep_ = 0; rep_ < NREP(8); ++rep_) { if (F.G == 256) p7_norm2_staged(F); else p7_norm2(F); }
    SEAM(8);
    if (IN(9)) for (int rep_ = 0; rep_ < NREP(9); ++rep_) { pg8::Gemm g{D, D, D, (size_t)128 * D * 2, (size_t)DFF * D * 2};
        if (F.tid < 256) { ((LAS float*)(F.lds + LDS_EDGE))[F.tid] = 0.f; ((LAS float*)(F.lds + LDS_EDGE))[9 * 256 + F.tid] = 0.f; }
        __syncthreads();
        SchedUp S{(const bf16_t*)(ws + WS_H2), (const bf16_t*)(ws + WS_WUP), F.G, F.bid};
        EpiUpConv E{(bf16_t*)(ws + WS_ACT), (float*)(ws + WS_EDGE), F.in[I_CFW], F.in[I_CFB], F.lds};
        pg8::gemm_phase(F.lds, g, S, E); }
    if (IN(9) && IN(11)) xcd_barrier(bar);
    if (IN(11)) for (int rep_ = 0; rep_ < NREP(11); ++rep_) { pg8::Gemm g{DFF, DFF, DFF, (size_t)128 * DFF * 2, (size_t)128 * DFF * 2};
        SchedStd S{(const bf16_t*)(ws + WS_ACT), (const bf16_t*)(ws + WS_WDOWN), 64, 8, DFF, DFF, F.G, F.bid, DOWNREP};
        { pg8::Unit u; int last = -1;
          for (int i = 0; S.next(i, u); ++i) if (u.pm != last) { fixup_panel(F, u.pm); last = u.pm; }
          asm volatile("s_waitcnt vmcnt(0)" ::: "memory"); __syncthreads(); }
        EpiY E{(bf16_t*)(ws + WS_Y2), (float*)(ws + WS_RSS2)};
        pg8::gemm_phase(F.lds, g, S, E); }
    SEAM(11);
    if (IN(12)) for (int rep_ = 0; rep_ < NREP(12); ++rep_) { if (F.G == 256) final_phase_staged(F); else final_phase(F); }
#undef IN
#undef SEAM
}

extern "C" void kernel_launch(void* const* d_in, const int* in_sizes, int n_in, void* d_out, int out_size, void* d_ws, size_t ws_size, hipStream_t stream) {
    static int grid = 0;
    if (grid == 0) {
        if (n_in != 25 || out_size != MLAT * D || ws_size < WS_NEED) { fprintf(stderr, "kernel_launch: unexpected shapes n_in %d out %d ws %zu\n", n_in, out_size, ws_size); grid = -1; return; }
        int dev = 0, cus = 0, per_cu = 0;
        hipGetDevice(&dev); hipDeviceGetAttribute(&cus, hipDeviceAttributeMultiprocessorCount, dev);
        if (hipFuncSetAttribute((const void*)hybrid_fwd, hipFuncAttributeMaxDynamicSharedMemorySize, LDS_BYTES) != hipSuccess) { fprintf(stderr, "kernel_launch: hipFuncSetAttribute failed\n"); grid = -1; return; }
        if (hipOccupancyMaxActiveBlocksPerMultiprocessor(&per_cu, (const void*)hybrid_fwd, 512, LDS_BYTES) != hipSuccess || per_cu < 1) { fprintf(stderr, "kernel_launch: occupancy query failed (%d)\n", per_cu); (void)hipGetLastError(); per_cu = 1; }
        grid = cus * 1;
        if (grid % 8 != 0 || grid <= 0) grid = (grid / 8) * 8;
        fprintf(stderr, "kernel_launch: cus %d per_cu %d grid %d\n", cus, per_cu, grid);
    }
    if (grid <= 0) return;
    if (hipMemsetAsync(d_ws, 0, XCD_BAR_WORDS * 4, stream) != hipSuccess) { fprintf(stderr, "kernel_launch: memset of barrier words failed\n"); return; }
    Args a{};
    for (int i = 0; i < 25; ++i) a.in[i] = (const float*)d_in[i];
    a.out = (float*)d_out; a.ws = (unsigned char*)d_ws;
#if N_LAUNCH_MODE == 1
    a.ph_lo = 0; a.ph_hi = N_PHASES;
    void* kargs[] = {&a};
    hipError_t e = hipLaunchCooperativeKernel((const void*)hybrid_fwd, dim3(grid), dim3(512), kargs, LDS_BYTES, stream);
    if (e != hipSuccess) fprintf(stderr, "cooperative launch failed: %s (grid %d)\n", hipGetErrorString(e), grid);
#else
    for (int p = 0; p < N_PHASES; ++p) { a.ph_lo = p; a.ph_hi = p + 1; hipLaunchKernelGGL(hybrid_fwd, dim3(grid), dim3(512), LDS_BYTES, stream, a); }
#endif
}
```

```cpp
#include <hip/hip_runtime.h>
#include <hip/hip_cooperative_groups.h>
#include <cstdio>
#include <cstdint>
namespace cg = cooperative_groups;

#ifndef N_LAUNCH_MODE
#define N_LAUNCH_MODE 1
#endif

#define LAS __attribute__((address_space(3)))
typedef unsigned short bf16_t;
typedef short bf16x8 __attribute__((ext_vector_type(8)));
typedef float f32x4 __attribute__((ext_vector_type(4)));
typedef float f32x2 __attribute__((ext_vector_type(2)));
typedef unsigned u32x4 __attribute__((ext_vector_type(4)));
typedef unsigned u32x2 __attribute__((ext_vector_type(2)));

constexpr int D = 2048, NB = 8, SEQ = 2048, CTXL = 256, DFF = 5632, DFF2 = 11264;
constexpr int MLAT = NB * SEQ, MCTX = NB * CTXL, MALL = MLAT + MCTX;
constexpr int DLRU = 1024, DFOU = 1024, NPROJ = 3072;
constexpr int NCHUNK = 36;
constexpr float EPS = 1e-6f;

constexpr size_t MiB = 1u << 20;
constexpr size_t WS_MOD = 1 * MiB;
constexpr size_t WS_POS = 2 * MiB;
constexpr size_t WS_RSS1 = 3 * MiB;
constexpr size_t WS_RSS2 = 5 * MiB;
constexpr size_t WS_AGG = 7 * MiB;
constexpr size_t WS_Y1024 = 11 * MiB + 512 * 1024;
constexpr size_t WS_K2 = 11 * MiB + 768 * 1024;
constexpr size_t WS_WUP = 12 * MiB;
constexpr size_t WS_WDOWN = 56 * MiB;
constexpr size_t WS_WIN = 78 * MiB;
constexpr size_t WS_WOUT = 90 * MiB;
constexpr size_t WS_CTAB = 98 * MiB;
constexpr size_t WS_STAB = 102 * MiB;
constexpr size_t WS_WG = 106 * MiB;
constexpr size_t WS_WCS = 107 * MiB;
constexpr size_t WS_H = 108 * MiB;
constexpr size_t WS_UF = 180 * MiB;
constexpr size_t WS_UX = 212 * MiB;
constexpr size_t WS_UG = 248 * MiB;
constexpr size_t WS_S = 280 * MiB;
constexpr size_t WS_PF = 312 * MiB;
constexpr size_t WS_PB = 344 * MiB;
constexpr size_t WS_PQT = 108 * MiB;
constexpr size_t WS_CPSQ = 376 * MiB;
constexpr size_t WS_YA = 108 * MiB;
constexpr size_t WS_Y = 384 * MiB;
constexpr size_t WS_H2 = 78 * MiB;
constexpr size_t WS_ACT = 142 * MiB;
constexpr size_t WS_EDGE = 318 * MiB;
constexpr size_t WS_Y2 = 448 * MiB;
constexpr size_t WS_NEED = 512 * MiB;

constexpr int LDS_BAR = 152576;
constexpr int LDS_BYTES = 152576 + 64;
static_assert(WS_UX - WS_UF == 32 * MiB && WS_UG - WS_UF == 68 * MiB && WS_STAB - WS_CTAB == 4 * MiB, "pointer arithmetic in EpiWin / SchedDFT");

#define LDS_BARRIER() do { asm volatile("s_waitcnt lgkmcnt(0)" ::: "memory"); __builtin_amdgcn_s_barrier(); asm volatile("" ::: "memory"); } while (0)
__device__ __forceinline__ unsigned cvt_pk_bf16(float lo, float hi) { unsigned r; asm volatile("v_cvt_pk_bf16_f32 %0, %1, %2" : "=v"(r) : "v"(lo), "v"(hi)); return r; }
__device__ __forceinline__ float bf_lo(unsigned w) { return __uint_as_float(w << 16); }
__device__ __forceinline__ float bf_hi(unsigned w) { return __uint_as_float(w & 0xffff0000u); }
__device__ __forceinline__ float fast_sigmoid(float z) { return __builtin_amdgcn_rcpf(1.0f + __builtin_amdgcn_exp2f(-1.44269504f * z)); }
__device__ __forceinline__ float gelu_tanh(float x) { const float u = x * (1.0f + 0.044715f * x * x); return x * __builtin_amdgcn_rcpf(1.0f + __builtin_amdgcn_exp2f(-2.302208198f * u)); }
__device__ __forceinline__ float wave_sum(float v) { for (int o = 32; o >= 1; o >>= 1) v += __shfl_xor(v, o); return v; }
__device__ __forceinline__ u32x4 pack8(const float (&v)[8]) { u32x4 w; w.x = cvt_pk_bf16(v[0], v[1]); w.y = cvt_pk_bf16(v[2], v[3]); w.z = cvt_pk_bf16(v[4], v[5]); w.w = cvt_pk_bf16(v[6], v[7]); return w; }
__device__ __forceinline__ void unpack8(const u32x4 w, float (&v)[8]) { v[0] = bf_lo(w.x); v[1] = bf_hi(w.x); v[2] = bf_lo(w.y); v[3] = bf_hi(w.y); v[4] = bf_lo(w.z); v[5] = bf_hi(w.z); v[6] = bf_lo(w.w); v[7] = bf_hi(w.w); }

namespace pg8 {
constexpr int BM = 256, BK = 64, HALF = 128, HTB = HALF * BK * 2, STAGE_BYTES = 8 * HTB, NXCD = 8;
__host__ __device__ __forceinline__ int lds_byte(int r, int c) { const int st = (r >> 4) * 2 + (c >> 5), rr = r & 15, cc = c & 31, ob = rr * 64 + cc * 2; return st * 1024 + (ob ^ (((ob >> 9) & 1) << 5)); }
__host__ __device__ __forceinline__ void stage_rc(int b, int& R, int& C) { const int st = b / 1024, sb = b % 1024, swz = sb ^ (((sb >> 9) & 1) << 5); R = (st >> 1) * 16 + swz / 64; C = (st & 1) * 32 + (swz % 64) / 2; }
__host__ __device__ __forceinline__ int perm32(int rho) { const int n = rho >> 4, i = rho & 15; return 8 * (i >> 2) + 4 * n + (i & 3); }

struct Unit { int pm, pn, z; };
struct Gemm { int lda, ldb, K; size_t hstepA, hstepB; };

__device__ __forceinline__ void std_order(int L, int nM, int nN, int& pm, int& pn, const int WGM = 8) {
    const int nwg = nM * nN; int wgid = L;
    { const int q = nwg / NXCD, r = nwg % NXCD, xcd = wgid % NXCD, off = wgid / NXCD; wgid = (xcd < r ? xcd * (q + 1) : r * (q + 1) + (xcd - r) * q) + off; }
    const int nig = WGM * nN, gid = wgid / nig, fm = gid * WGM, gsz = (nM - fm) < WGM ? (nM - fm) : WGM;
    pm = fm + ((wgid % nig) % gsz); pn = (wgid % nig) / gsz;
}

__device__ __forceinline__ void store_tile_bf16(const f32x4 (&acc)[2][2][4][2], bf16_t* tile, size_t ldc, int wr, int wc, int fr, int fq) {
    bf16_t* p0 = tile + (size_t)(wr * 64 + fr) * ldc + wc * 32 + 8 * fq;
#pragma unroll
    for (int ai = 0; ai < 2; ++ai)
#pragma unroll
        for (int m = 0; m < 4; ++m) { bf16_t* rowp = p0 + (size_t)(ai * HALF + m * 16) * ldc;
#pragma unroll
            for (int bj = 0; bj < 2; ++bj) { const f32x4 v0 = acc[ai][bj][m][0], v1 = acc[ai][bj][m][1];
                u32x4 w; w.x = cvt_pk_bf16(v0[0], v0[1]); w.y = cvt_pk_bf16(v0[2], v0[3]); w.z = cvt_pk_bf16(v1[0], v1[1]); w.w = cvt_pk_bf16(v1[2], v1[3]);
                *(u32x4*)(rowp + bj * HALF) = w; } }
}
__device__ __forceinline__ void store_tile_f32(const f32x4 (&acc)[2][2][4][2], float* tile, size_t ldc, int wr, int wc, int fr, int fq) {
    float* p0 = tile + (size_t)(wr * 64 + fr) * ldc + wc * 32 + 4 * fq;
#pragma unroll
    for (int ai = 0; ai < 2; ++ai)
#pragma unroll
        for (int m = 0; m < 4; ++m) { float* rowp = p0 + (size_t)(ai * HALF + m * 16) * ldc;
#pragma unroll
            for (int bj = 0; bj < 2; ++bj)
#pragma unroll
                for (int n = 0; n < 2; ++n) *(f32x4*)(rowp + bj * HALF + n * 16) = acc[ai][bj][m][n]; }
}

template <class Epi, class Sched>
__device__ __forceinline__ void gemm_phase(LAS unsigned char* lds, const Gemm g, const Sched& S, const Epi& E) {
    const int tid = threadIdx.x, wid = __builtin_amdgcn_readfirstlane(tid >> 6), lane = tid & 63, wr = wid >> 2, wc = wid & 3, fr = lane & 15, fq = lane >> 4;
    const int K = g.K, nt = K / BK;
    unsigned voffA[2], voffB[2];
#pragma unroll
    for (int i = 0; i < 2; ++i) { int R, C; stage_rc(tid * 16 + i * 8192, R, C); const int Rb = Epi::PERM ? ((R & ~31) + perm32(R & 31)) : R;
        const int Ra = Epi::PERMA ? ((R & ~63) + 4 * (R & 15) + ((R >> 4) & 3)) : R;
        voffA[i] = (unsigned)(Ra * g.lda + C) * 2u; voffB[i] = (unsigned)(Rb * g.ldb + C) * 2u; }
    const size_t kstep = (size_t)(BK * 2);
    const size_t hstepA = g.hstepA, hstepB = g.hstepB;
    const unsigned ldsw = (unsigned)wid * 1024u;
    const int aoff = lds_byte(wr * 64 + fr, fq * 8), boff = lds_byte(wc * 32 + fr, fq * 8);
#define PG8_SA(b, h) (((b) * 2 + (h)) * HTB)
#define PG8_SB(b, h) ((4 + (b) * 2 + (h)) * HTB)
#define PG8_STAGE(bufoff, gbase, voff) do { _Pragma("unroll") for (int _i = 0; _i < 2; ++_i) \
        __builtin_amdgcn_global_load_lds((const unsigned*)((const char*)(gbase) + (voff)[_i]), (LAS unsigned*)(lds + (bufoff) + ldsw + _i * 8192), 16, 0, 0); } while (0)
#define PG8_LDA(dst, b, h) do { _Pragma("unroll") for (int m = 0; m < 4; ++m) _Pragma("unroll") for (int k = 0; k < 2; ++k) dst[m][k] = *(const LAS bf16x8*)(lds + PG8_SA(b, h) + aoff + m * 2048 + k * 1024); } while (0)
#define PG8_LDB(dst, b, h) do { _Pragma("unroll") for (int n = 0; n < 2; ++n) _Pragma("unroll") for (int k = 0; k < 2; ++k) dst[n][k] = *(const LAS bf16x8*)(lds + PG8_SB(b, h) + boff + n * 2048 + k * 1024); } while (0)
#define PG8_MMA(ai, bj, At, Bt) do { __builtin_amdgcn_s_setprio(1); _Pragma("unroll") for (int m = 0; m < 4; ++m) _Pragma("unroll") for (int n = 0; n < 2; ++n) _Pragma("unroll") for (int k = 0; k < 2; ++k) \
        acc[ai][bj][m][n] = __builtin_amdgcn_mfma_f32_16x16x32_bf16(Bt[n][k], At[m][k], acc[ai][bj][m][n], 0, 0, 0); __builtin_amdgcn_s_setprio(0); } while (0)
#define PG8_WAIT_V(n) asm volatile("s_waitcnt vmcnt(" #n ")" ::: "memory")
#define PG8_WAIT_L(n) asm volatile("s_waitcnt lgkmcnt(" #n ")" ::: "memory")
#define PG8_BAR __builtin_amdgcn_s_barrier()
#define PG8_SCHED __builtin_amdgcn_sched_barrier(0)
    Unit cur, nxt; int ui = 0;
    if (!S.next(0, cur)) return;
    f32x4 acc[2][2][4][2];
#pragma unroll
    for (int a = 0; a < 2; ++a)
#pragma unroll
        for (int b = 0; b < 2; ++b)
#pragma unroll
            for (int m = 0; m < 4; ++m)
#pragma unroll
                for (int n = 0; n < 2; ++n) acc[a][b][m][n] = (f32x4){0.f, 0.f, 0.f, 0.f};
    bf16x8 At[4][2], B0[2][2], B1[2][2];
    const char* cA; const char* cB; S.ptrs(cur, cA, cB);
    PG8_STAGE(PG8_SB(0, 0), cB, voffB); PG8_STAGE(PG8_SB(0, 1), cB + hstepB, voffB); PG8_STAGE(PG8_SA(0, 0), cA, voffA); PG8_STAGE(PG8_SA(0, 1), cA + hstepA, voffA);
    if (wr == 1) PG8_BAR;
    PG8_WAIT_V(2); PG8_BAR;
    PG8_STAGE(PG8_SB(1, 0), cB + kstep, voffB); PG8_STAGE(PG8_SA(1, 0), cA + kstep, voffA); PG8_STAGE(PG8_SB(1, 1), cB + hstepB + kstep, voffB);
    PG8_WAIT_V(6); PG8_BAR;
    for (;;) {
        const bool has_next = S.next(ui + 1, nxt);
        const char* nA = cA; const char* nB = cB; if (has_next) S.ptrs(nxt, nA, nB);
#pragma unroll 1
        for (int t = 0; t < nt; t += 2) {
            const bool last = (t == nt - 2);
            const char* a1 = cA + (size_t)(t + 1) * kstep;
            const char* a2 = last ? nA : cA + (size_t)(t + 2) * kstep; const char* b2 = last ? nB : cB + (size_t)(t + 2) * kstep;
            const char* a3 = a2 + kstep; const char* b3 = b2 + kstep;
            PG8_LDB(B0, 0, 0); PG8_LDB(B1, 0, 1); PG8_SCHED; PG8_LDA(At, 0, 0); PG8_STAGE(PG8_SA(1, 1), a1 + hstepA, voffA);
            PG8_WAIT_V(8); PG8_WAIT_L(0); PG8_BAR; PG8_MMA(0, 0, At, B0); PG8_MMA(0, 1, At, B1); PG8_BAR; PG8_SCHED;
            PG8_LDA(At, 0, 1); PG8_STAGE(PG8_SB(0, 0), b2, voffB); PG8_STAGE(PG8_SB(0, 1), b2 + hstepB, voffB); PG8_STAGE(PG8_SA(0, 0), a2, voffA);
            PG8_WAIT_V(8); PG8_WAIT_L(0); PG8_BAR; PG8_MMA(1, 0, At, B0); PG8_MMA(1, 1, At, B1); PG8_BAR; PG8_SCHED;
            PG8_LDB(B0, 1, 0); PG8_LDB(B1, 1, 1); PG8_SCHED; PG8_LDA(At, 1, 0); PG8_STAGE(PG8_SA(0, 1), a2 + hstepA, voffA);
            PG8_WAIT_V(8); PG8_WAIT_L(0); PG8_BAR; PG8_MMA(0, 0, At, B0); PG8_MMA(0, 1, At, B1); PG8_BAR; PG8_SCHED;
            PG8_LDA(At, 1, 1); PG8_STAGE(PG8_SB(1, 0), b3, voffB); PG8_STAGE(PG8_SB(1, 1), b3 + hstepB, voffB); PG8_STAGE(PG8_SA(1, 0), a3, voffA);
            PG8_WAIT_V(8); PG8_WAIT_L(0); PG8_BAR; PG8_MMA(1, 0, At, B0); PG8_MMA(1, 1, At, B1); PG8_BAR; PG8_SCHED;
        }
        if (wr == 0) PG8_BAR;
        E(acc, cur, wr, wc, fr, fq);
        if (!has_next) break;
#pragma unroll
        for (int a = 0; a < 2; ++a)
#pragma unroll
            for (int b = 0; b < 2; ++b)
#pragma unroll
                for (int m = 0; m < 4; ++m)
#pragma unroll
                    for (int n = 0; n < 2; ++n) acc[a][b][m][n] = (f32x4){0.f, 0.f, 0.f, 0.f};
        cur = nxt; cA = nA; cB = nB; ++ui;
        if (wr == 1) PG8_BAR;
    }
    PG8_WAIT_V(0);
    PG8_BAR;
#undef PG8_SA
#undef PG8_SB
#undef PG8_STAGE
#undef PG8_LDA
#undef PG8_LDB
#undef PG8_MMA
#undef PG8_WAIT_V
#undef PG8_WAIT_L
#undef PG8_BAR
#undef PG8_SCHED
}
}

#define XB_TMO      128
#define XB_XCNT(j)  (256  + 64 * (j))
#define XB_XSUB(j)  (1280 + 64 * (j))
#define XB_XGEN(j)  (2304 + 64 * (j))
#define XB_TOP      3328
#define XB_TOPGEN   3392
#define XCD_BAR_WORDS 3456
#define XB_SPIN_CAP (1u << 18)
__device__ __forceinline__ unsigned xb_ld(unsigned* p)              { return __hip_atomic_load(p, __ATOMIC_RELAXED, __HIP_MEMORY_SCOPE_AGENT); }
__device__ __forceinline__ unsigned xb_add(unsigned* p, unsigned v) { return __hip_atomic_fetch_add(p, v, __ATOMIC_RELAXED, __HIP_MEMORY_SCOPE_AGENT); }
__device__ __forceinline__ unsigned xb_xcc_id() { return (unsigned)__builtin_amdgcn_s_getreg((3 << 11) | 20) & 0xFu; }
#define XB_SPIN(cond, bar) do { unsigned _sp = 0; while (cond) { __builtin_amdgcn_s_sleep(1); \
    if ((++_sp & 255u) == 0u) { if (xb_ld(&(bar)[XB_TMO])) break; if (_sp > XB_SPIN_CAP) { atomicAdd(&(bar)[XB_TMO], 1u); break; } } } } while (0)
struct XcdBarrier { unsigned* bar; unsigned x; volatile LAS unsigned* st; };
__device__ __forceinline__ XcdBarrier xcd_barrier_post(unsigned* bar, volatile LAS unsigned* st) {
    XcdBarrier b; b.bar = bar; b.x = xb_xcc_id(); b.st = st;
    if (threadIdx.x == 0) (void)xb_add(&bar[XB_XCNT(b.x)], 1u);
    return b;
}
__device__ __forceinline__ void xcd_barrier_complete(unsigned* bar, unsigned x, unsigned& nloc, unsigned& nx) {
    const unsigned G = gridDim.x * gridDim.y * gridDim.z;
    unsigned sum, cnt, mine, sp = 0u;
    for (;;) {
        sum = 0u; cnt = 0u; mine = 0u;
#pragma unroll
        for (unsigned j = 0; j < 16; ++j) { const unsigned c = xb_ld(&bar[XB_XCNT(j)]); sum += c; cnt += (c > 0u) ? 1u : 0u; mine = (j == x) ? c : mine; }
        if (sum == G) break;
        __builtin_amdgcn_s_sleep(1);
        if ((++sp & 255u) == 0u) { if (xb_ld(&bar[XB_TMO])) break; if (sp > XB_SPIN_CAP) { atomicAdd(&bar[XB_TMO], 1u); break; } }
    }
    nloc = mine > 0u ? mine : 1u; nx = cnt > 0u ? cnt : 1u;
}
__device__ __forceinline__ void xcd_barrier(const XcdBarrier& b) {
    asm volatile("s_waitcnt vmcnt(0)" ::: "memory");
    __syncthreads();
    if (threadIdx.x == 0) {
        unsigned* bar = b.bar;
        __builtin_amdgcn_s_waitcnt(0);
        unsigned nloc = b.st[0], nx = b.st[1];
        if (nloc == 0u) { xcd_barrier_complete(bar, b.x, nloc, nx); b.st[0] = nloc; b.st[1] = nx; }
        const unsigned old = xb_add(&bar[XB_XSUB(b.x)], 1u);
        const unsigned gen = old / nloc;
        if (old + 1u == (gen + 1u) * nloc) {
            __builtin_amdgcn_fence(__ATOMIC_RELEASE, "agent");
            asm volatile("s_waitcnt vmcnt(0)" ::: "memory");
            const unsigned og = xb_add(&bar[XB_TOP], 1u);
            const unsigned tg = og / nx;
            if (og + 1u == (tg + 1u) * nx) xb_add(&bar[XB_TOPGEN], 1u);
            else XB_SPIN(xb_ld(&bar[XB_TOPGEN]) == tg, bar);
            __builtin_amdgcn_fence(__ATOMIC_ACQUIRE, "agent");
            xb_add(&bar[XB_XGEN(b.x)], 1u);
            asm volatile("s_waitcnt vmcnt(0)" ::: "memory");
        } else {
            XB_SPIN(xb_ld(&bar[XB_XGEN(b.x)]) == gen, bar);
            __builtin_amdgcn_fence(__ATOMIC_ACQUIRE, "agent");
            asm volatile("s_waitcnt vmcnt(0)" ::: "memory");
        }
    }
    __syncthreads();
}

struct Args { const float* in[25]; float* out; unsigned char* ws; int ph_lo, ph_hi; };
struct Frame {
    const float* const* in; float* out; unsigned char* ws; LAS unsigned char* lds; int tid, lane, wave, G, bid;
};
enum { I_X = 0, I_C, I_CTX, I_CCTX, I_WADA, I_BADA, I_GMIXPRE, I_GMIXPOST, I_GFFNPRE, I_GFFNPOST, I_WIN, I_CLW, I_CLB, I_WREC, I_BREC, I_WING, I_BING, I_LAM, I_WFOU, I_BFOU, I_WOUT, I_WUP, I_CFW, I_CFB, I_WDOWN };

constexpr int IT_MOD = 192;
constexpr int IT_TR_WIN = 16 * 48, IT_TR_WOUT = 16 * 32, IT_TR_WUP = 16 * 176, IT_TR_WDOWN = 44 * 32, IT_TR_G = 64;
constexpr int IT_TR = IT_TR_WIN + IT_TR_WOUT + IT_TR_WUP + IT_TR_WDOWN + IT_TR_G;
constexpr int IT_TAB = 128, IT_WCS = 256, IT_POS = 96;

__device__ __forceinline__ void mod_item(const Frame& F, int it) {
    LAS float* sil = (LAS float*)F.lds;
    LAS float* red = (LAS float*)(F.lds + 73728);
    const float* c = F.in[I_C]; const float* cc = F.in[I_CCTX];
    for (int idx = F.tid; idx < 9 * 2048; idx += 512) { const int bb = idx >> 11, k = idx & 2047; const float v = bb < 8 ? c[bb * 2048 + k] : cc[k]; sil[idx] = v * fast_sigmoid(v); }
    __syncthreads();
    const int n0 = it * 64, rg = F.tid >> 4, l16 = F.tid & 15;
    const float* w = F.in[I_WADA] + n0 + l16 * 4;
    f32x4 acc[9];
#pragma unroll
    for (int b = 0; b < 9; ++b) acc[b] = (f32x4){0.f, 0.f, 0.f, 0.f};
    for (int i0 = 0; i0 < 64; i0 += 8) { f32x4 wv[8];
#pragma unroll
        for (int i = 0; i < 8; ++i) wv[i] = __builtin_nontemporal_load((const f32x4*)(w + (size_t)(rg + 32 * (i0 + i)) * 12288));
#pragma unroll
        for (int i = 0; i < 8; ++i) { const int k = rg + 32 * (i0 + i);
#pragma unroll
            for (int b = 0; b < 9; ++b) acc[b] += sil[b * 2048 + k] * wv[i]; } }
#pragma unroll
    for (int b = 0; b < 9; ++b) *(LAS f32x4*)(red + (rg * 9 + b) * 64 + l16 * 4) = acc[b];
    __syncthreads();
    for (int o = F.tid; o < 576; o += 512) { const int bb = o >> 6, col = o & 63; float s = 0.f; for (int r = 0; r < 32; ++r) s += red[(r * 9 + bb) * 64 + col];
        ((float*)(F.ws + WS_MOD))[bb * 12288 + n0 + col] = s + F.in[I_BADA][n0 + col]; }
    __syncthreads();
}

struct TrDesc { const float* src; bf16_t* dst; int N, ldd, k0, n0; };
__device__ __forceinline__ TrDesc tr_decode(const Frame& F, int it) {
    TrDesc t;
    if (it < IT_TR_WIN) { t.src = F.in[I_WIN]; t.N = NPROJ; t.dst = (bf16_t*)(F.ws + WS_WIN); t.ldd = D; t.k0 = (it % 16) * 128; t.n0 = (it / 16) * 64; return t; }
    it -= IT_TR_WIN;
    if (it < IT_TR_WOUT) { t.src = F.in[I_WOUT]; t.N = D; t.dst = (bf16_t*)(F.ws + WS_WOUT); t.ldd = D; t.k0 = (it % 16) * 128; t.n0 = (it / 16) * 64; return t; }
    it -= IT_TR_WOUT;
    if (it < IT_TR_WUP) { t.src = F.in[I_WUP]; t.N = DFF2; t.dst = (bf16_t*)(F.ws + WS_WUP); t.ldd = D; t.k0 = (it % 16) * 128; t.n0 = (it / 16) * 64; return t; }
    it -= IT_TR_WUP;
    if (it < IT_TR_WDOWN) { t.src = F.in[I_WDOWN]; t.N = D; t.dst = (bf16_t*)(F.ws + WS_WDOWN); t.ldd = DFF; t.k0 = (it % 44) * 128; t.n0 = (it / 44) * 64; return t; }
    it -= IT_TR_WDOWN;
    { const int half = it & 1, mat = it >> 1, type = mat & 1, dir = (mat >> 1) & 1, h = mat >> 2;
      t.src = (type ? F.in[I_WING] : F.in[I_WREC]) + (size_t)(dir * 8 + h) * 128 * 128; t.N = 128;
      t.dst = (bf16_t*)(F.ws + WS_WG) + (size_t)(h * 512 + (dir * 2 + type) * 128) * 128; t.ldd = 128; t.k0 = 0; t.n0 = half * 64; }
    return t;
}
__device__ __forceinline__ void tr_load(const Frame& F, int it, f32x4 (&v)[4]) {
    const TrDesc t = tr_decode(F, it); const int kr0 = F.tid >> 4, c4 = F.tid & 15;
#pragma unroll
    for (int i = 0; i < 4; ++i) v[i] = __builtin_nontemporal_load((const f32x4*)(t.src + (size_t)(t.k0 + kr0 + 32 * i) * t.N + t.n0 + c4 * 4));
}
__device__ __forceinline__ void tr_store(const Frame& F, int it, const f32x4 (&v)[4]) {
    const TrDesc t = tr_decode(F, it);
    LAS bf16_t* T = (LAS bf16_t*)F.lds;
    const int kr0 = F.tid >> 4, c4 = F.tid & 15;
#pragma unroll
    for (int i = 0; i < 4; ++i) { const int kr = kr0 + 32 * i;
        const unsigned p0 = cvt_pk_bf16(v[i][0], v[i][1]), p1 = cvt_pk_bf16(v[i][2], v[i][3]);
        T[(c4 * 4 + 0) * 136 + kr] = (bf16_t)(p0 & 0xffff); T[(c4 * 4 + 1) * 136 + kr] = (bf16_t)(p0 >> 16);
        T[(c4 * 4 + 2) * 136 + kr] = (bf16_t)(p1 & 0xffff); T[(c4 * 4 + 3) * 136 + kr] = (bf16_t)(p1 >> 16); }
    LDS_BARRIER();
#pragma unroll
    for (int i = 0; i < 2; ++i) { const int n = (F.tid >> 4) + 32 * i, kg = F.tid & 15;
        const u32x4 w = *(const LAS u32x4*)(T + n * 136 + kg * 8);
        *(u32x4*)(t.dst + (size_t)(t.n0 + n) * t.ldd + t.k0 + kg * 8) = w; }
    LDS_BARRIER();
}

__device__ __forceinline__ void tr_range(const Frame& F, int lo, int hi, int b, int nb) {
    int it = lo + b; if (it >= hi) return;
    f32x4 A[4], B[4];
    tr_load(F, it, A);
    for (;;) {
        const int i1 = it + nb; tr_load(F, i1 < hi ? i1 : hi - 1, B);
        tr_store(F, it, A);
        if (i1 >= hi) break;
        const int i2 = i1 + nb; tr_load(F, i2 < hi ? i2 : hi - 1, A);
        tr_store(F, i1, B);
        if (i2 >= hi) break;
        it = i2;
    }
}

__device__ __forceinline__ void tab_items(const Frame& F, int b, int nb) {
    if (b >= IT_TAB) return;
    LAS float* tc = (LAS float*)F.lds; LAS float* ts = tc + 2048;
    const float sc = 0.02209708691f;
    for (int j = F.tid; j < 2048; j += 512) { float s, c; sincospif((float)j * (1.0f / 1024.0f), &s, &c); tc[j] = c * sc; ts[j] = s * sc; }
    __syncthreads();
    bf16_t* ct = (bf16_t*)(F.ws + WS_CTAB); bf16_t* st = (bf16_t*)(F.ws + WS_STAB);
    for (int it = b; it < IT_TAB; it += nb)
        for (int r = 0; r < 8; ++r) { const int k = it * 8 + r; const int n = F.tid * 4; float cv[4], sv[4];
#pragma unroll
            for (int j = 0; j < 4; ++j) { const int idx = (k * (n + j)) & 2047; cv[j] = tc[idx]; sv[j] = ts[idx]; }
            u32x2 cw, sw; cw.x = cvt_pk_bf16(cv[0], cv[1]); cw.y = cvt_pk_bf16(cv[2], cv[3]); sw.x = cvt_pk_bf16(sv[0], sv[1]); sw.y = cvt_pk_bf16(sv[2], sv[3]);
            *(u32x2*)(ct + (size_t)k * 2048 + n) = cw; *(u32x2*)(st + (size_t)k * 2048 + n) = sw; }
    __syncthreads();
}

__device__ __forceinline__ void wcs_items(const Frame& F, int b, int nb) {
    LAS float* tab = (LAS float*)F.lds;
    if (F.tid < 256) { float s, c; sincospif((float)F.tid * (1.0f / 128.0f), &s, &c); tab[F.tid] = c; tab[256 + F.tid] = s; }
    __syncthreads();
    for (int it = b; it < IT_WCS; it += nb) {
        const int g = it >> 6, c0 = (it & 63) * 4, d = F.tid & 255, s = F.tid >> 8;
        const float* wf = F.in[I_WFOU] + (size_t)g * 65536 + d; const LAS float* tb = tab + s * 256;
        const float sg = s ? -1.0f : 1.0f;
        float a0 = 0.f, a1 = 0.f, a2 = 0.f, a3 = 0.f;
        for (int m0 = 1; m0 < 128; m0 += 8) { float e[8];
#pragma unroll
            for (int j = 0; j < 8; ++j) { const int m = m0 + j; e[j] = m < 128 ? wf[m * 256] + sg * wf[(256 - m) * 256] : 0.f; }
#pragma unroll
            for (int j = 0; j < 8; ++j) { const int m = m0 + j;
                a0 += tb[(m * (c0 + 0)) & 255] * e[j]; a1 += tb[(m * (c0 + 1)) & 255] * e[j]; a2 += tb[(m * (c0 + 2)) & 255] * e[j]; a3 += tb[(m * (c0 + 3)) & 255] * e[j]; } }
        if (s == 0) { const float w0 = wf[0], w128 = wf[128 * 256]; a0 += w0 + w128; a1 += w0 - w128; a2 += w0 + w128; a3 += w0 - w128; }
        u32x2 w; w.x = cvt_pk_bf16(a0 * 0.0625f, a1 * 0.0625f); w.y = cvt_pk_bf16(a2 * 0.0625f, a3 * 0.0625f);
        *(u32x2*)((bf16_t*)(F.ws + WS_WCS) + (size_t)(g * 512 + s * 256 + d) * 256 + c0) = w;
    }
    __syncthreads();
}

__device__ __forceinline__ void pos_item(const Frame& F, int p) {
    float* pt = (float*)(F.ws + WS_POS) + (size_t)p * 1024;
    const float pe = (float)(p < 32 ? p : p - 32);
    for (int e = F.tid; e < 1024; e += 512) { const int half = e >> 9, i = e & 511;
        const float f = powf(10000.0f, -(float)i / 512.0f); const float ang = pe * f;
        pt[e] = half ? cosf(ang) : sinf(ang); }
}

__device__ __forceinline__ void p0_prologue(const Frame& F) {
    const int NC = F.G >= 128 ? 64 : 0;
    const bool comp = NC == 0 || F.bid < NC, mem = NC == 0 || F.bid >= NC;
    const int cb = F.bid, cn = NC ? NC : F.G, mb = F.bid - NC, mn = F.G - NC;
    if (mem) {
        for (int it = mb; it < IT_MOD; it += mn) mod_item(F, it);
        tr_range(F, 0, IT_TR, mb, mn);
        __syncthreads();
    }
    if (comp) {
        wcs_items(F, cb, cn);
        tab_items(F, cb, cn);
        for (int it = cb; it < IT_POS; it += cn) pos_item(F, it);
        if (cb == 0) for (int e = F.tid; e < 2048; e += 512) ((float*)(F.ws + WS_K2))[e] = -8.0f * 1.44269504f * log1pf(expf(-F.in[I_LAM][e]));
    }
}

__device__ __forceinline__ f32x4 pos4(const float* pt, int t, int col) {
    const float* p = col < 1024 ? pt + (size_t)(t >> 6) * 1024 + col : pt + (size_t)(32 + (t & 63)) * 1024 + (col - 1024);
    return *(const f32x4*)p;
}
__device__ __forceinline__ void p1_norm(const Frame& F, int r_lo, int r_hi, int b0, int nb) {
    const float* pt = (const float*)(F.ws + WS_POS); const float* mod = (const float*)(F.ws + WS_MOD);
    const float* g = F.in[I_GMIXPRE]; bf16_t* H = (bf16_t*)(F.ws + WS_H);
    for (int r = r_lo + (F.bid - b0) * 8 + F.wave; r < r_hi; r += nb * 8) {
        const bool lat = r < MLAT; const int b = lat ? (r >> 11) : ((r - MLAT) >> 8), t = r & 2047;
        const float* src = lat ? F.in[I_X] + (size_t)r * D : F.in[I_CTX] + (size_t)(r - MLAT) * D;
        const float* mrow = mod + (size_t)(lat ? b : 8) * 12288;
        f32x4 v[8]; float ss = 0.f;
#pragma unroll
        for (int i = 0; i < 8; ++i) { const int col = (i * 64 + F.lane) * 4; v[i] = *(const f32x4*)(src + col); if (lat) v[i] += pos4(pt, t, col);
            ss += v[i][0] * v[i][0] + v[i][1] * v[i][1] + v[i][2] * v[i][2] + v[i][3] * v[i][3]; }
        ss = wave_sum(ss); const float rstd = rsqrtf(ss * (1.0f / D) + EPS);
#pragma unroll
        for (int i = 0; i < 8; ++i) { const int col = (i * 64 + F.lane) * 4; const f32x4 gg = *(const f32x4*)(g + col), sh = *(const f32x4*)(mrow + col), sc = *(const f32x4*)(mrow + 2048 + col);
            const f32x4 h = (v[i] * rstd * gg) * (1.0f + sc) + sh; u32x2 w; w.x = cvt_pk_bf16(h[0], h[1]); w.y = cvt_pk_bf16(h[2], h[3]);
            *(u32x2*)(H + (size_t)r * D + col) = w; }
    }
}

__device__ __forceinline__ void p1_latent_staged(const Frame& F, int b0, int nb) {
    const float* pt = (const float*)(F.ws + WS_POS); const float* mod = (const float*)(F.ws + WS_MOD);
    const float* g = F.in[I_GMIXPRE]; bf16_t* H = (bf16_t*)(F.ws + WS_H);
    const int j = F.bid - b0, per = nb >> 3, b = j / per, jb = j - b * per;
    LAS float* L = (LAS float*)F.lds;
    const float* mrow = mod + (size_t)b * 12288;
    __syncthreads();
    for (int e = F.tid; e < 512; e += 512) { const int c4 = e * 4;
        *(LAS f32x4*)(L + c4) = (1.0f + *(const f32x4*)(mrow + 2048 + c4)) * *(const f32x4*)(g + c4);
        *(LAS f32x4*)(L + 2048 + c4) = *(const f32x4*)(mrow + c4); }
    __syncthreads();
    const int step = per * 8;
    for (int t0 = jb * 8 + F.wave; t0 < SEQ; t0 += 2 * step) {
        f32x4 v[2][8]; float ss[2] = {0.f, 0.f};
#pragma unroll
        for (int q = 0; q < 2; ++q) { const int t = t0 + q * step < SEQ ? t0 + q * step : t0; const size_t r = (size_t)b * SEQ + t;
#pragma unroll
            for (int i = 0; i < 8; ++i) v[q][i] = __builtin_nontemporal_load((const f32x4*)(F.in[I_X] + r * D + (i * 64 + F.lane) * 4)); }
#pragma unroll
        for (int q = 0; q < 2; ++q) { const int t = t0 + q * step < SEQ ? t0 + q * step : t0;
#pragma unroll
            for (int i = 0; i < 8; ++i) { v[q][i] += pos4(pt, t, (i * 64 + F.lane) * 4); ss[q] += v[q][i][0] * v[q][i][0] + v[q][i][1] * v[q][i][1] + v[q][i][2] * v[q][i][2] + v[q][i][3] * v[q][i][3]; } }
#pragma unroll
        for (int q = 0; q < 2; ++q) { const int t = t0 + q * step; if (t >= SEQ) break; const size_t r = (size_t)b * SEQ + t;
            const float rstd = rsqrtf(wave_sum(ss[q]) * (1.0f / D) + EPS);
#pragma unroll
            for (int i = 0; i < 8; ++i) { const int col = (i * 64 + F.lane) * 4;
                const f32x4 h = (v[q][i] * rstd) * *(const LAS f32x4*)(L + col) + *(const LAS f32x4*)(L + 2048 + col);
                u32x2 w; w.x = cvt_pk_bf16(h[0], h[1]); w.y = cvt_pk_bf16(h[2], h[3]);
                *(u32x2*)(H + r * D + col) = w; } }
    }
    __syncthreads();
}
struct SchedWin {
    const bf16_t* A; const bf16_t* B; int G, c;
    int lo, hi;
    __device__ __forceinline__ bool next(int i, pg8::Unit& u) const { const int L = lo + i * G + c; if (L >= hi) return false;
        if (L < 768) pg8::std_order(L, 64, 12, u.pm, u.pn); else { const int l = L - 768; u.pm = 64 + (l >> 2); u.pn = 4 + (l & 3); } u.z = 0; return true; }
    __device__ __forceinline__ void ptrs(const pg8::Unit& u, const char*& a, const char*& b) const { a = (const char*)(A + (size_t)u.pm * 256 * D); b = (const char*)(B + (size_t)u.pn * 256 * D); }
};
struct EpiWin { static constexpr bool PERM = true, PERMA = false; bf16_t* uf;
    __device__ __forceinline__ void operator()(const f32x4 (&acc)[2][2][4][2], const pg8::Unit& u, int wr, int wc, int fr, int fq) const {
        const int seg = u.pn >> 2; bf16_t* base = uf + (size_t)seg * (16u << 20) + (size_t)(seg >> 1) * (2u << 20);
        pg8::store_tile_bf16(acc, base + (size_t)u.pm * 256 * 1024 + (u.pn & 3) * 256, 1024, wr, wc, fr, fq); }
};
struct SchedPQ {
    const bf16_t* A; const bf16_t* B; int G, c;
    __device__ __forceinline__ bool next(int i, pg8::Unit& u) const { const int L = i * G + c; if (L >= 512) return false; u.z = L >> 4; u.pm = (L >> 3) & 1; u.pn = L & 7; return true; }
    __device__ __forceinline__ void ptrs(const pg8::Unit& u, const char*& a, const char*& b) const { const int bb = u.z >> 2, g = u.z & 3;
        a = (const char*)(A + (size_t)(g * 512 + u.pm * 256) * 256); b = (const char*)(B + (size_t)(bb * 2048 + u.pn * 256) * 1024 + g * 256); }
};
struct EpiPQ { static constexpr bool PERM = true, PERMA = false; bf16_t* o;
    __device__ __forceinline__ void operator()(const f32x4 (&acc)[2][2][4][2], const pg8::Unit& u, int wr, int wc, int fr, int fq) const {
        pg8::store_tile_bf16(acc, o + (size_t)(u.z * 512 + u.pm * 256) * 2048 + u.pn * 256, 2048, wr, wc, fr, fq); }
};
struct SchedDFT {
    const bf16_t* ct; const bf16_t* st; const bf16_t* B; int G, c;
    __device__ __forceinline__ bool next(int i, pg8::Unit& u) const { const int L = i * G + c; if (L >= 256) return false; u.pm = L & 3; u.pn = (L >> 2) & 1; u.z = L >> 3; return true; }
    __device__ __forceinline__ void ptrs(const pg8::Unit& u, const char*& a, const char*& b) const {
        a = (const char*)(ct + (size_t)u.pn * (2u << 20) + (size_t)u.pm * 256 * 2048); b = (const char*)(B + (size_t)(u.z * 512 + u.pn * 256) * 2048); }
};
struct EpiDFT { static constexpr bool PERM = true, PERMA = false; bf16_t* o;
    __device__ __forceinline__ void operator()(const f32x4 (&acc)[2][2][4][2], const pg8::Unit& u, int wr, int wc, int fr, int fq) const { const int bb = u.z >> 2, g = u.z & 3;
        pg8::store_tile_bf16(acc, o + (size_t)u.pn * 8192 * 1024 + (size_t)(bb * 1024 + u.pm * 256) * 1024 + g * 256, 1024, wr, wc, fr, fq); }
};
struct SchedStd {
    const bf16_t* A; const bf16_t* B; int nM, nN, lda, ldb, G, c, nrep;
    __device__ __forceinline__ bool next(int i, pg8::Unit& u) const { int L = i * G + c; if (L >= nM * nN * nrep) return false; L %= nM * nN; pg8::std_order(L, nM, nN, u.pm, u.pn, 4); u.z = 0; return true; }
    __device__ __forceinline__ void ptrs(const pg8::Unit& u, const char*& a, const char*& b) const { a = (const char*)(A + (size_t)u.pm * 256 * lda); b = (const char*)(B + (size_t)u.pn * 256 * ldb); }
};
struct EpiY { static constexpr bool PERM = true, PERMA = false; bf16_t* y; float* rss;
    __device__ __forceinline__ void operator()(const f32x4 (&acc)[2][2][4][2], const pg8::Unit& u, int wr, int wc, int fr, int fq) const {
        pg8::store_tile_bf16(acc, y + (size_t)u.pm * 256 * D + u.pn * 256, D, wr, wc, fr, fq);
#pragma unroll
        for (int ai = 0; ai < 2; ++ai)
#pragma unroll
            for (int m = 0; m < 4; ++m) { float s = 0.f;
#pragma unroll
                for (int bj = 0; bj < 2; ++bj)
#pragma unroll
                    for (int n = 0; n < 2; ++n) { const f32x4 v = acc[ai][bj][m][n]; s += (v[0] * v[0] + v[1] * v[1]) + (v[2] * v[2] + v[3] * v[3]); }
                s += __shfl_xor(s, 16); s += __shfl_xor(s, 32);
                if (fq == 0) rss[(size_t)(u.pm * 256 + ai * 128 + wr * 64 + m * 16 + fr) * 32 + u.pn * 4 + wc] = s; }
    }
};
template <int CTRL> __device__ __forceinline__ float dpp_f(float old, float src) { return __int_as_float(__builtin_amdgcn_update_dpp(__float_as_int(old), __float_as_int(src), CTRL, 0xF, 0xF, false)); }
constexpr int DPP_SHL1 = 0x101, DPP_SHR1 = 0x111, DPP_ROR1 = 0x121, DPP_ROR15 = 0x12F;
constexpr int LDS_EDGE = 131072;
#ifndef OUTREP
#define OUTREP 1
#endif
#ifndef DOWNREP
#define DOWNREP 1
#endif
#ifndef UPREP
#define UPREP 1
#endif
struct SchedUp {
    const bf16_t* A; const bf16_t* B; int G, c;
    __device__ __forceinline__ bool next(int i, pg8::Unit& u) const { int L = i * G + c; if (L >= 64 * 44 * UPREP) return false; L %= 64 * 44; pg8::std_order(L, 64, 44, u.pm, u.pn, 4); u.z = 0; return true; }
    __device__ __forceinline__ void ptrs(const pg8::Unit& u, const char*& a, const char*& b) const { a = (const char*)(A + (size_t)u.pm * 256 * D); b = (const char*)(B + (size_t)u.pn * 128 * D); }
};
struct EpiUpConv { static constexpr bool PERM = true, PERMA = true; bf16_t* act; float* edge; const float* cw; const float* cb; LAS unsigned char* lds;
    __device__ __forceinline__ void operator()(f32x4 (&acc)[2][2][4][2], const pg8::Unit& u, int wr, int wc, int fr, int fq) const {
        const int colw = 32 * wc + 8 * fq;
        LAS float* E = (LAS float*)(lds + LDS_EDGE) + wr * 512 + colw;
#pragma unroll
        for (int ai = 0; ai < 2; ++ai)
#pragma unroll
            for (int bj = 0; bj < 2; ++bj)
#pragma unroll
                for (int n = 0; n < 2; ++n) {
                    if (fr == 0) *(LAS f32x4*)(E + (4 * ai + 1) * 256 + bj * 128 + 4 * n) = acc[ai][bj][0][n];
                    if (fr == 15) *(LAS f32x4*)(E + (4 * ai + 2) * 256 + bj * 128 + 4 * n) = acc[ai][bj][3][n]; }
        { float* eg = edge + (size_t)u.pm * 4 * DFF2 + u.pn * 128 + colw;
          if (wr == 0) { if (fr == 0) {
#pragma unroll
              for (int bj = 0; bj < 2; ++bj)
#pragma unroll
                  for (int n = 0; n < 2; ++n) { *(f32x4*)(eg + bj * DFF + 4 * n) = acc[0][bj][0][n]; *(f32x4*)(eg + DFF2 + bj * DFF + 4 * n) = acc[0][bj][1][n]; } } }
          else { if (fr == 15) {
#pragma unroll
              for (int bj = 0; bj < 2; ++bj)
#pragma unroll
                  for (int n = 0; n < 2; ++n) { *(f32x4*)(eg + 2 * DFF2 + bj * DFF + 4 * n) = acc[1][bj][2][n]; *(f32x4*)(eg + 3 * DFF2 + bj * DFF + 4 * n) = acc[1][bj][3][n]; } } } }
        const float* cwp = cw + u.pn * 128 + colw; const float* cbp = cb + u.pn * 128 + colw;
        f32x4 W[2][8];
#pragma unroll
        for (int n = 0; n < 2; ++n) { W[n][0] = *(const f32x4*)(cwp + 4 * n); W[n][1] = *(const f32x4*)(cwp + DFF2 + 4 * n); W[n][2] = *(const f32x4*)(cwp + 2 * DFF2 + 4 * n); W[n][3] = *(const f32x4*)(cbp + 4 * n);
            W[n][4] = *(const f32x4*)(cwp + DFF + 4 * n); W[n][5] = *(const f32x4*)(cwp + DFF2 + DFF + 4 * n); W[n][6] = *(const f32x4*)(cwp + 2 * DFF2 + DFF + 4 * n); W[n][7] = *(const f32x4*)(cbp + DFF + 4 * n); }
        asm volatile("s_waitcnt lgkmcnt(0)" ::: "memory"); __builtin_amdgcn_s_barrier(); __builtin_amdgcn_s_barrier(); asm volatile("" ::: "memory");
#pragma unroll
        for (int n = 0; n < 2; ++n) {
            f32x4 wg0 = W[n][0], wg1 = W[n][1], wg2 = W[n][2], bg = W[n][3], wv0 = W[n][4], wv1 = W[n][5], wv2 = W[n][6], bv = W[n][7];
            asm volatile("" : "+v"(wg0), "+v"(wg1), "+v"(wg2), "+v"(bg), "+v"(wv0), "+v"(wv1), "+v"(wv2), "+v"(bv));
#pragma unroll
            for (int ai = 0; ai < 2; ++ai) {
                f32x4 ep0 = *(const LAS f32x4*)(E + (4 * ai) * 256 + 4 * n), ep1 = *(const LAS f32x4*)(E + (4 * ai) * 256 + 128 + 4 * n);
                f32x4 en0 = *(const LAS f32x4*)(E + (4 * ai + 3) * 256 + 4 * n), en1 = *(const LAS f32x4*)(E + (4 * ai + 3) * 256 + 128 + 4 * n);
                asm volatile("" : "+v"(ep0), "+v"(ep1), "+v"(en0), "+v"(en1));
                f32x4 T[4];
#pragma unroll
                for (int m = 0; m < 4; ++m) {
                    asm volatile("" : "+v"(acc[ai][0][m][n]), "+v"(acc[ai][1][m][n]));
#pragma unroll
                    for (int q = 0; q < 4; q += 2) {
                        f32x2 g, v, gp, vp, gn, vn;
#pragma unroll
                        for (int e = 0; e < 2; ++e) { const int qq = q + e;
                            g[e] = acc[ai][0][m][n][qq]; v[e] = acc[ai][1][m][n][qq];
                            gp[e] = m > 0 ? acc[ai][0][m > 0 ? m - 1 : 0][n][qq] : dpp_f<DPP_SHR1>(ep0[qq], acc[ai][0][3][n][qq]);
                            vp[e] = m > 0 ? acc[ai][1][m > 0 ? m - 1 : 0][n][qq] : dpp_f<DPP_SHR1>(ep1[qq], acc[ai][1][3][n][qq]);
                            gn[e] = m < 3 ? acc[ai][0][m < 3 ? m + 1 : 3][n][qq] : dpp_f<DPP_SHL1>(en0[qq], acc[ai][0][0][n][qq]);
                            vn[e] = m < 3 ? acc[ai][1][m < 3 ? m + 1 : 3][n][qq] : dpp_f<DPP_SHL1>(en1[qq], acc[ai][1][0][n][qq]); }
                        const f32x2 w0g = (f32x2){wg0[q], wg0[q + 1]}, w1g = (f32x2){wg1[q], wg1[q + 1]}, w2g = (f32x2){wg2[q], wg2[q + 1]}, b0g = (f32x2){bg[q], bg[q + 1]};
                        const f32x2 w0v = (f32x2){wv0[q], wv0[q + 1]}, w1v = (f32x2){wv1[q], wv1[q + 1]}, w2v = (f32x2){wv2[q], wv2[q + 1]}, b0v = (f32x2){bv[q], bv[q + 1]};
                        const f32x2 gg = b0g + w0g * gp + w1g * g + w2g * gn;
                        const f32x2 vv = b0v + w0v * vp + w1v * v + w2v * vn;
                        const f32x2 arg = gg * ((gg * gg) * (-2.302208198f * 0.044715f) + (-2.302208198f));
                        f32x2 d; d.x = __builtin_amdgcn_exp2f(arg.x); d.y = __builtin_amdgcn_exp2f(arg.y); d = d + 1.0f;
                        f32x2 r; r.x = __builtin_amdgcn_rcpf(d.x); r.y = __builtin_amdgcn_rcpf(d.y);
                        const f32x2 o = (gg * vv) * r;
                        T[m][q] = o.x; T[m][q + 1] = o.y; }
                    asm volatile("" : "+v"(T[m])); }
#pragma unroll
                for (int m = 0; m < 4; ++m) acc[ai][0][m][n] = T[m]; } }
        bf16_t* p0 = act + (size_t)(u.pm * 256 + wr * 64 + 4 * fr) * DFF + u.pn * 128 + colw;
#pragma unroll
        for (int ai = 0; ai < 2; ++ai)
#pragma unroll
            for (int m = 0; m < 4; ++m) { const f32x4 v0 = acc[ai][0][m][0], v1 = acc[ai][0][m][1];
                u32x4 w; w.x = cvt_pk_bf16(v0[0], v0[1]); w.y = cvt_pk_bf16(v0[2], v0[3]); w.z = cvt_pk_bf16(v1[0], v1[1]); w.w = cvt_pk_bf16(v1[2], v1[3]);
                *(u32x4*)(p0 + (size_t)(ai * 128 + m) * DFF) = w; }
    }
};

constexpr int XB_STRIDE = 136, AR_STRIDE = 132;
constexpr int LDS_XB = 0, LDS_AF = 17408, LDS_IF = LDS_AF + 33792, LDS_AB = LDS_IF + 33792, LDS_IB = LDS_AB + 33792;
static_assert(LDS_IB + 33792 <= LDS_BAR, "lds");

__device__ __forceinline__ void lru_load(const Frame& F, int L, u32x4 (&U)[2][4]) {
    const bf16_t* Ux = (const bf16_t*)(F.ws + WS_UX);
    const int h = L & 7, s = L >> 3, b = s / NCHUNK, j = s % NCHUNK;
    const bool isctx = j < 4; const int rowbase = isctx ? MLAT + b * CTXL : b * SEQ, t0 = isctx ? j * 64 : (j - 4) * 64, len = isctx ? CTXL : SEQ;
#pragma unroll
    for (int i = 0; i < 2; ++i) { const int idx = F.tid + 512 * i, tok = idx >> 4, cg8 = idx & 15;
#pragma unroll
        for (int k = 0; k < 4; ++k) { int tt = t0 + tok + k - 2; tt = tt < 0 ? 0 : (tt >= len ? len - 1 : tt);
            U[i][k] = __builtin_nontemporal_load((const u32x4*)(Ux + (size_t)(rowbase + tt) * 1024 + h * 128 + cg8 * 8)); } }
}
__device__ __forceinline__ void lru_phase(const Frame& F) {
    const bf16_t* WgT = (const bf16_t*)(F.ws + WS_WG);
    bf16_t* So = (bf16_t*)(F.ws + WS_S); bf16_t* Pfo = (bf16_t*)(F.ws + WS_PF); bf16_t* Pbo = (bf16_t*)(F.ws + WS_PB);
    float* agg = (float*)(F.ws + WS_AGG);
    LAS bf16_t* XB = (LAS bf16_t*)(F.lds + LDS_XB);
    const int w = F.wave, fr = F.lane & 15, fq = F.lane >> 4;
    constexpr int NU = NB * NCHUNK * 8;
    int cur_h = -1;
    bf16x8 Wf[4][4];
    int L = F.bid; if (L >= NU) return;
    u32x4 U[2][4];
    lru_load(F, L, U);
    for (;;) {
        const int h = L & 7, s = L >> 3, b = s / NCHUNK, j = s % NCHUNK;
        if (h != cur_h) { cur_h = h;
#pragma unroll
            for (int g4 = 0; g4 < 4; ++g4)
#pragma unroll
                for (int kk = 0; kk < 4; ++kk) Wf[g4][kk] = *(const bf16x8*)(WgT + (size_t)(h * 512 + g4 * 128 + 16 * w + fr) * 128 + kk * 32 + fq * 8);
        }
        const bool isctx = j < 4; const int rowbase = isctx ? MLAT + b * CTXL : b * SEQ, t0 = isctx ? j * 64 : (j - 4) * 64, len = isctx ? CTXL : SEQ;
#pragma unroll
        for (int i = 0; i < 2; ++i) { const int idx = F.tid + 512 * i, tok = idx >> 4, cg8 = idx & 15; const int ch = h * 128 + cg8 * 8;
            float o[8]; { const f32x4 b0 = *(const f32x4*)(F.in[I_CLB] + ch), b1 = *(const f32x4*)(F.in[I_CLB] + ch + 4);
                o[0] = b0[0]; o[1] = b0[1]; o[2] = b0[2]; o[3] = b0[3]; o[4] = b1[0]; o[5] = b1[1]; o[6] = b1[2]; o[7] = b1[3]; }
#pragma unroll
            for (int k = 0; k < 4; ++k) { const int tt = t0 + tok + k - 2; const float msk = (tt >= 0 && tt < len) ? 1.0f : 0.0f;
                float uv[8]; unpack8(U[i][k], uv);
                const f32x4 w0 = *(const f32x4*)(F.in[I_CLW] + k * 1024 + ch) * msk, w1 = *(const f32x4*)(F.in[I_CLW] + k * 1024 + ch + 4) * msk;
                o[0] += w0[0] * uv[0]; o[1] += w0[1] * uv[1]; o[2] += w0[2] * uv[2]; o[3] += w0[3] * uv[3];
                o[4] += w1[0] * uv[4]; o[5] += w1[1] * uv[5]; o[6] += w1[2] * uv[6]; o[7] += w1[3] * uv[7]; }
            *(LAS u32x4*)(XB + tok * XB_STRIDE + cg8 * 8) = pack8(o); }
        const int Ln = L + F.G;
        lru_load(F, Ln < NU ? Ln : NU - 1, U);
        LDS_BARRIER();
#pragma unroll
        for (int d = 0; d < 2; ++d) {
            const int C = d * 1024 + h * 128 + 16 * w + 4 * fq;
            const f32x4 nba = *(const f32x4*)(F.in[I_BREC] + C) * -1.44269504f, nbx = *(const f32x4*)(F.in[I_BING] + C) * -1.44269504f, k2 = *(const f32x4*)((const float*)(F.ws + WS_K2) + C);
            f32x4 acc[2][4];
#pragma unroll
            for (int g2 = 0; g2 < 2; ++g2)
#pragma unroll
                for (int m = 0; m < 4; ++m) acc[g2][m] = (f32x4){0.f, 0.f, 0.f, 0.f};
#pragma unroll
            for (int m = 0; m < 4; ++m) { bf16x8 Xf[4];
#pragma unroll
                for (int kk = 0; kk < 4; ++kk) Xf[kk] = *(const LAS bf16x8*)(XB + (16 * m + fr) * XB_STRIDE + kk * 32 + fq * 8);
#pragma unroll
                for (int g2 = 0; g2 < 2; ++g2)
#pragma unroll
                    for (int kk = 0; kk < 4; ++kk) acc[g2][m] = __builtin_amdgcn_mfma_f32_16x16x32_bf16(Wf[2 * d + g2][kk], Xf[kk], acc[g2][m], 0, 0, 0); }
#pragma unroll
            for (int m = 0; m < 4; ++m) { const int tok = 16 * m + fr;
                const u32x2 xw = *(const LAS u32x2*)(XB + tok * XB_STRIDE + 16 * w + 4 * fq);
                const f32x4 xc = (f32x4){bf_lo(xw.x), bf_hi(xw.x), bf_lo(xw.y), bf_hi(xw.y)};
                f32x4 av, iv;
#pragma unroll
                for (int q = 0; q < 4; ++q) {
                    const float ea = __builtin_amdgcn_exp2f(fminf(fmaf(acc[0][m][q], -1.44269504f, nba[q]), 60.f)), ex = __builtin_amdgcn_exp2f(fminf(fmaf(acc[1][m][q], -1.44269504f, nbx[q]), 60.f));
                    const float pa = 1.0f + ea, px = 1.0f + ex, t = __builtin_amdgcn_rcpf(pa * px), r = t * px, ig = t * pa;
                    const float la2 = r * k2[q]; const float a = __builtin_amdgcn_exp2f(la2); const float u = la2 * 1.38629436f;
                    const float poly = -u * (1.0f + u * (0.5f + u * 0.16666667f));
                    const float em = u > -0.02f ? poly : fmaf(-a, a, 1.0f);
                    av[q] = a; iv[q] = __builtin_amdgcn_sqrtf(fmaxf(em, 0.f)) * ig * xc[q]; }
                *(LAS f32x4*)(F.lds + (d ? LDS_AB : LDS_AF) + (tok * AR_STRIDE + 16 * w + 4 * fq) * 4) = av;
                *(LAS f32x4*)(F.lds + (d ? LDS_IB : LDS_IF) + (tok * AR_STRIDE + 16 * w + 4 * fq) * 4) = iv; }
            asm volatile("" ::: "memory");
        }
        LDS_BARRIER();
        LAS float* ENDS = (LAS float*)(F.lds + LDS_XB);
        { const int half = F.tid >> 8, d = (F.tid >> 7) & 1, ch = F.tid & 127;
            LAS float* A = (LAS float*)(F.lds + (d ? LDS_AB : LDS_AF)) + ch; LAS float* I = (LAS float*)(F.lds + (d ? LDS_IB : LDS_IF)) + ch;
            float hs = 0.f, P = 1.f;
            if (d == 0) { const int tb = half * 32;
#pragma unroll 8
                for (int t = 0; t < 32; ++t) { const float a = A[(tb + t) * AR_STRIDE], x = I[(tb + t) * AR_STRIDE]; hs = a * hs + x; P *= a; I[(tb + t) * AR_STRIDE] = hs; A[(tb + t) * AR_STRIDE] = P; }
            } else { const int tb = 63 - half * 32;
#pragma unroll 8
                for (int t = 0; t < 32; ++t) { const float a = A[(tb - t) * AR_STRIDE], x = I[(tb - t) * AR_STRIDE]; hs = a * hs + x; P *= a; I[(tb - t) * AR_STRIDE] = hs; A[(tb - t) * AR_STRIDE] = P; }
            }
            ENDS[((d * 2 + half) * 2 + 0) * 128 + ch] = P; ENDS[((d * 2 + half) * 2 + 1) * 128 + ch] = hs; }
        LDS_BARRIER();
        if (F.tid < 256) { const int d = F.tid >> 7, ch = F.tid & 127;
            const float P0 = ENDS[((d * 2 + 0) * 2 + 0) * 128 + ch], H0 = ENDS[((d * 2 + 0) * 2 + 1) * 128 + ch], P1 = ENDS[((d * 2 + 1) * 2 + 0) * 128 + ch], H1 = ENDS[((d * 2 + 1) * 2 + 1) * 128 + ch];
            float* ag = agg + ((size_t)(b * NCHUNK + j) * 4 + d * 2) * 1024 + h * 128 + ch; ag[0] = P0 * P1; ag[1024] = P1 * H0 + H1; }
        if (!isctx) {
#pragma unroll
            for (int i = 0; i < 2; ++i) { const int idx = F.tid + 512 * i, tok = idx >> 4, cg8 = idx & 15; const int o = (tok * AR_STRIDE + cg8 * 8) * 4;
                const bool f2 = tok >= 32, b2 = tok < 32;
                float sv[8], pf[8], pb[8];
#pragma unroll
                for (int hh = 0; hh < 2; ++hh) { const f32x4 x0 = *(const LAS f32x4*)(F.lds + LDS_IF + o + hh * 16), x1 = *(const LAS f32x4*)(F.lds + LDS_IB + o + hh * 16);
                    const f32x4 p0 = *(const LAS f32x4*)(F.lds + LDS_AF + o + hh * 16), p1 = *(const LAS f32x4*)(F.lds + LDS_AB + o + hh * 16);
                    const int c0 = cg8 * 8 + hh * 4;
                    const f32x4 fP = f2 ? *(const LAS f32x4*)(ENDS + 0 * 128 + c0) : (f32x4){1.f, 1.f, 1.f, 1.f}, fH = f2 ? *(const LAS f32x4*)(ENDS + 1 * 128 + c0) : (f32x4){0.f, 0.f, 0.f, 0.f};
                    const f32x4 bP = b2 ? *(const LAS f32x4*)(ENDS + 4 * 128 + c0) : (f32x4){1.f, 1.f, 1.f, 1.f}, bH = b2 ? *(const LAS f32x4*)(ENDS + 5 * 128 + c0) : (f32x4){0.f, 0.f, 0.f, 0.f};
#pragma unroll
                    for (int q = 0; q < 4; ++q) { sv[hh * 4 + q] = (x0[q] + p0[q] * fH[q]) + (x1[q] + p1[q] * bH[q]); pf[hh * 4 + q] = p0[q] * fP[q]; pb[hh * 4 + q] = p1[q] * bP[q]; } }
                const size_t go = (size_t)(rowbase + t0 + tok) * 1024 + h * 128 + cg8 * 8;
                *(u32x4*)(So + go) = pack8(sv); *(u32x4*)(Pfo + go) = pack8(pf); *(u32x4*)(Pbo + go) = pack8(pb); }
        }
        LDS_BARRIER();
        if (Ln >= NU) break;
        L = Ln;
    }
    __syncthreads();
}

__device__ __forceinline__ void alt_phase(const Frame& F) {
    const bf16_t* PQT = (const bf16_t*)(F.ws + WS_PQT); float* y1024 = (float*)(F.ws + WS_Y1024);
    const bf16_t* ct = (const bf16_t*)(F.ws + WS_CTAB);
    const float sc = __uint_as_float(((unsigned)ct[0]) << 16);
    for (int o = F.bid * 8 + F.wave; o < 8192; o += F.G * 8) {
        const int bg = o >> 8, d = o & 255; const bf16_t* p = PQT + (size_t)(bg * 512 + d) * 2048 + F.lane * 32; float s = 0.f;
#pragma unroll
        for (int i = 0; i < 4; ++i) { float v[8]; unpack8(*(const u32x4*)(p + i * 8), v); s += (v[0] - v[1]) + (v[2] - v[3]) + (v[4] - v[5]) + (v[6] - v[7]); }
        s = wave_sum(s);
        if (F.lane == 0) y1024[(bg >> 2) * 1024 + (bg & 3) * 256 + d] = s * sc;
    }
}

__device__ __forceinline__ void assemble_phase(const Frame& F) {
    const float* agg = (const float*)(F.ws + WS_AGG);
    const bf16_t* S = (const bf16_t*)(F.ws + WS_S); const bf16_t* Pf = (const bf16_t*)(F.ws + WS_PF); const bf16_t* Pb = (const bf16_t*)(F.ws + WS_PB); const bf16_t* Ug = (const bf16_t*)(F.ws + WS_UG);
    const bf16_t* cp = (const bf16_t*)(F.ws + WS_CPSQ); const bf16_t* sq = cp + (size_t)8192 * 1024; const float* y1024 = (const float*)(F.ws + WS_Y1024);
    bf16_t* YA = (bf16_t*)(F.ws + WS_YA);
    LAS float* cf = (LAS float*)F.lds; LAS float* cb = cf + 1024;
    for (int L = F.bid; L < 256; L += F.G) {
        const int b = L >> 5, jc = L & 31, jj = jc + 4;
#pragma unroll
        for (int e = 0; e < 2; ++e) { const int ch = F.tid + 512 * e; const float* a0 = agg + (size_t)b * NCHUNK * 4096 + ch;
            float c = 0.f, c2 = 0.f;
#pragma unroll
            for (int i0 = 0; i0 < NCHUNK; i0 += 12) { float fa[12], fh[12], ba[12], bh[12];
#pragma unroll
                for (int k = 0; k < 12; ++k) { const int i = i0 + k; const int ib = i < 4 ? 3 - i : NCHUNK + 3 - i;
                    fa[k] = a0[(size_t)i * 4096]; fh[k] = a0[(size_t)i * 4096 + 1024]; ba[k] = a0[(size_t)ib * 4096 + 2048]; bh[k] = a0[(size_t)ib * 4096 + 3072]; }
#pragma unroll
                for (int k = 0; k < 12; ++k) { const int i = i0 + k; const int ib = i < 4 ? 3 - i : NCHUNK + 3 - i;
                    if (i < jj) c = fa[k] * c + fh[k];
                    if (ib < 4 || ib > jj) c2 = ba[k] * c2 + bh[k]; } }
            cf[ch] = c; cb[ch] = c2; }
        __syncthreads();
        const int row0 = b * SEQ + jc * 64;
        for (int i0 = 0; i0 < 16; i0 += 4) { u32x4 sw[4], fw[4], bw[4], gw[4];
#pragma unroll
            for (int k = 0; k < 4; ++k) { const int idx = F.tid + 512 * (i0 + k), row = idx >> 7, cg8 = idx & 127; const size_t go = (size_t)(row0 + row) * 1024 + cg8 * 8;
                sw[k] = __builtin_nontemporal_load((const u32x4*)(S + go)); fw[k] = __builtin_nontemporal_load((const u32x4*)(Pf + go)); bw[k] = __builtin_nontemporal_load((const u32x4*)(Pb + go)); gw[k] = __builtin_nontemporal_load((const u32x4*)(Ug + go)); }
#pragma unroll
            for (int k = 0; k < 4; ++k) { const int idx = F.tid + 512 * (i0 + k), row = idx >> 7, cg8 = idx & 127;
                float sv[8], pf[8], pb[8], ug[8], o[8]; unpack8(sw[k], sv); unpack8(fw[k], pf); unpack8(bw[k], pb); unpack8(gw[k], ug);
#pragma unroll
                for (int q = 0; q < 8; ++q) o[q] = (sv[q] + pf[q] * cf[cg8 * 8 + q] + pb[q] * cb[cg8 * 8 + q]) * gelu_tanh(ug[q]);
                *(u32x4*)(YA + (size_t)(row0 + row) * D + 1024 + cg8 * 8) = pack8(o); } }
        for (int i0 = 0; i0 < 32; i0 += 8) { u32x2 c4v[8], s4v[8];
#pragma unroll
            for (int k = 0; k < 8; ++k) { const int idx = F.tid + 512 * (i0 + k), row = idx >> 8, c4 = (idx & 255) * 4; const int kk = jc * 64 + row;
                const int ks = kk <= 1024 ? kk : 2048 - kk;
                const size_t o = (size_t)(b * 1024 + (ks < 1024 ? ks : 1023)) * 1024 + c4;
                c4v[k] = __builtin_nontemporal_load((const u32x2*)(cp + o)); s4v[k] = __builtin_nontemporal_load((const u32x2*)(sq + o)); }
#pragma unroll
            for (int k = 0; k < 8; ++k) { const int idx = F.tid + 512 * (i0 + k), row = idx >> 8, c4 = (idx & 255) * 4; const int kk = jc * 64 + row;
                const f32x4 cv = (f32x4){bf_lo(c4v[k].x), bf_hi(c4v[k].x), bf_lo(c4v[k].y), bf_hi(c4v[k].y)}, sv4 = (f32x4){bf_lo(s4v[k].x), bf_hi(s4v[k].x), bf_lo(s4v[k].y), bf_hi(s4v[k].y)};
                f32x4 y = kk < 1024 ? cv - sv4 : cv + sv4;
                if (kk == 1024) y = *(const f32x4*)(y1024 + b * 1024 + c4);
                y += *(const f32x4*)(F.in[I_BFOU] + c4);
                u32x2 w; w.x = cvt_pk_bf16(y[0], y[1]); w.y = cvt_pk_bf16(y[2], y[3]);
                *(u32x2*)(YA + (size_t)(row0 + row) * D + c4) = w; } }
        __syncthreads();
    }
}

__device__ __forceinline__ f32x4 ld_bf4(const bf16_t* p) { const u32x2 w = *(const u32x2*)p; return (f32x4){bf_lo(w.x), bf_hi(w.x), bf_lo(w.y), bf_hi(w.y)}; }
__device__ __forceinline__ void p7_norm2_staged(const Frame& F) {
    const float* pt = (const float*)(F.ws + WS_POS); const float* mod = (const float*)(F.ws + WS_MOD);
    const bf16_t* Y = (const bf16_t*)(F.ws + WS_Y); const float* rss = (const float*)(F.ws + WS_RSS1); bf16_t* H2 = (bf16_t*)(F.ws + WS_H2);
    const float* gpost = F.in[I_GMIXPOST]; const float* gpre = F.in[I_GFFNPRE];
    LAS float* L = (LAS float*)F.lds;
    for (int k0 = 0; k0 < NB; k0 += 2) {
        __syncthreads();
        for (int e = F.tid; e < 2 * 512; e += 512) { const int j = e >> 9, c4 = (e & 511) * 4; const float* mrow = mod + (size_t)(k0 + j) * 12288;
            *(LAS f32x4*)(L + (j * 3 + 0) * 2048 + c4) = *(const f32x4*)(mrow + 4096 + c4) * *(const f32x4*)(gpost + c4);
            *(LAS f32x4*)(L + (j * 3 + 1) * 2048 + c4) = (1.0f + *(const f32x4*)(mrow + 8192 + c4)) * *(const f32x4*)(gpre + c4);
            *(LAS f32x4*)(L + (j * 3 + 2) * 2048 + c4) = *(const f32x4*)(mrow + 6144 + c4); }
        __syncthreads();
        const int t = F.bid * 8 + F.wave;
        f32x4 v[2][8]; u32x2 yw[2][8]; float ssy[2], ss[2] = {0.f, 0.f};
#pragma unroll
        for (int j = 0; j < 2; ++j) { const int r = t + (k0 + j) * 2048; ssy[j] = F.lane < 32 ? rss[(size_t)r * 32 + F.lane] : 0.f;
#pragma unroll
            for (int i = 0; i < 8; ++i) { const int col = (i * 64 + F.lane) * 4; v[j][i] = __builtin_nontemporal_load((const f32x4*)(F.in[I_X] + (size_t)r * D + col)); yw[j][i] = __builtin_nontemporal_load((const u32x2*)(Y + (size_t)r * D + col)); } }
        f32x4 pp[8];
#pragma unroll
        for (int i = 0; i < 8; ++i) pp[i] = pos4(pt, t, (i * 64 + F.lane) * 4);
#pragma unroll
        for (int j = 0; j < 2; ++j) { const float rstdy = rsqrtf(wave_sum(ssy[j]) * (1.0f / D) + EPS);
#pragma unroll
            for (int i = 0; i < 8; ++i) { const int col = (i * 64 + F.lane) * 4;
                const f32x4 yv = (f32x4){bf_lo(yw[j][i].x), bf_hi(yw[j][i].x), bf_lo(yw[j][i].y), bf_hi(yw[j][i].y)};
                v[j][i] = v[j][i] + pp[i] + *(const LAS f32x4*)(L + (j * 3 + 0) * 2048 + col) * (yv * rstdy);
                ss[j] += v[j][i][0] * v[j][i][0] + v[j][i][1] * v[j][i][1] + v[j][i][2] * v[j][i][2] + v[j][i][3] * v[j][i][3]; } }
#pragma unroll
        for (int j = 0; j < 2; ++j) { const int r = t + (k0 + j) * 2048; const float rstd = rsqrtf(wave_sum(ss[j]) * (1.0f / D) + EPS);
#pragma unroll
            for (int i = 0; i < 8; ++i) { const int col = (i * 64 + F.lane) * 4;
                const f32x4 h = (v[j][i] * rstd) * *(const LAS f32x4*)(L + (j * 3 + 1) * 2048 + col) + *(const LAS f32x4*)(L + (j * 3 + 2) * 2048 + col);
                u32x2 w; w.x = cvt_pk_bf16(h[0], h[1]); w.y = cvt_pk_bf16(h[2], h[3]);
                *(u32x2*)(H2 + (size_t)r * D + col) = w; } }
    }
    __syncthreads();
}
__device__ __forceinline__ void p7_norm2(const Frame& F) {
    const float* pt = (const float*)(F.ws + WS_POS); const float* mod = (const float*)(F.ws + WS_MOD);
    const bf16_t* Y = (const bf16_t*)(F.ws + WS_Y); const float* rss = (const float*)(F.ws + WS_RSS1); bf16_t* H2 = (bf16_t*)(F.ws + WS_H2);
    const float* gpost = F.in[I_GMIXPOST]; const float* gpre = F.in[I_GFFNPRE];
    const int nw = F.G * 8;
    for (int r0 = F.bid * 8 + F.wave; r0 < MLAT; r0 += 2 * nw) {
        f32x4 v[2][8]; float ssy[2], ss[2] = {0.f, 0.f};
#pragma unroll
        for (int j = 0; j < 2; ++j) { const int r = r0 + j * nw < MLAT ? r0 + j * nw : r0; ssy[j] = F.lane < 32 ? rss[(size_t)r * 32 + F.lane] : 0.f; }
        u32x2 yw[2][8];
#pragma unroll
        for (int j = 0; j < 2; ++j) { const int r = r0 + j * nw < MLAT ? r0 + j * nw : r0;
#pragma unroll
            for (int i = 0; i < 8; ++i) { const int col = (i * 64 + F.lane) * 4; v[j][i] = *(const f32x4*)(F.in[I_X] + (size_t)r * D + col); yw[j][i] = *(const u32x2*)(Y + (size_t)r * D + col); } }
#pragma unroll
        for (int j = 0; j < 2; ++j) { const int r = r0 + j * nw < MLAT ? r0 + j * nw : r0; const int b = r >> 11, t = r & 2047; const float* mrow = mod + (size_t)b * 12288;
            const float rstdy = rsqrtf(wave_sum(ssy[j]) * (1.0f / D) + EPS);
#pragma unroll
            for (int i = 0; i < 8; ++i) { const int col = (i * 64 + F.lane) * 4;
                const f32x4 yv = (f32x4){bf_lo(yw[j][i].x), bf_hi(yw[j][i].x), bf_lo(yw[j][i].y), bf_hi(yw[j][i].y)}, gp = *(const f32x4*)(gpost + col), gt = *(const f32x4*)(mrow + 4096 + col);
                v[j][i] = v[j][i] + pos4(pt, t, col) + gt * (yv * rstdy * gp);
                ss[j] += v[j][i][0] * v[j][i][0] + v[j][i][1] * v[j][i][1] + v[j][i][2] * v[j][i][2] + v[j][i][3] * v[j][i][3]; } }
#pragma unroll
        for (int j = 0; j < 2; ++j) { const int r = r0 + j * nw; if (r >= MLAT) break; const int b = r >> 11; const float* mrow = mod + (size_t)b * 12288;
            const float rstd = rsqrtf(wave_sum(ss[j]) * (1.0f / D) + EPS);
#pragma unroll
            for (int i = 0; i < 8; ++i) { const int col = (i * 64 + F.lane) * 4; const f32x4 gg = *(const f32x4*)(gpre + col), sh = *(const f32x4*)(mrow + 6144 + col), sc = *(const f32x4*)(mrow + 8192 + col);
                const f32x4 h = (v[j][i] * rstd * gg) * (1.0f + sc) + sh; u32x2 w; w.x = cvt_pk_bf16(h[0], h[1]); w.y = cvt_pk_bf16(h[2], h[3]);
                *(u32x2*)(H2 + (size_t)r * D + col) = w; } }
    }
}

__device__ __forceinline__ void fixup_panel(const Frame& F, int pm) {
    const float* edge = (const float*)(F.ws + WS_EDGE); bf16_t* act = (bf16_t*)(F.ws + WS_ACT);
    const float* cw = F.in[I_CFW]; const float* cb = F.in[I_CFB];
    const int tb = pm & 7;
    for (int idx = F.tid; idx < 2 * 1408; idx += 512) {
        const int e = idx >= 1408, c = (idx - e * 1408) * 4;
        const f32x4 z = (f32x4){0.f, 0.f, 0.f, 0.f};
        f32x4 gp, gc, gn, vp, vc, vn;
        if (e == 0) { const float* pr = edge + ((size_t)(pm - 1) * 4 + 3) * DFF2; const float* cu = edge + ((size_t)pm * 4 + 0) * DFF2; const float* nx = edge + ((size_t)pm * 4 + 1) * DFF2;
            gp = tb ? *(const f32x4*)(pr + c) : z; vp = tb ? *(const f32x4*)(pr + DFF + c) : z; gc = *(const f32x4*)(cu + c); vc = *(const f32x4*)(cu + DFF + c); gn = *(const f32x4*)(nx + c); vn = *(const f32x4*)(nx + DFF + c); }
        else { const float* pr = edge + ((size_t)pm * 4 + 2) * DFF2; const float* cu = edge + ((size_t)pm * 4 + 3) * DFF2; const float* nx = edge + ((size_t)(pm + 1) * 4 + 0) * DFF2;
            gp = *(const f32x4*)(pr + c); vp = *(const f32x4*)(pr + DFF + c); gc = *(const f32x4*)(cu + c); vc = *(const f32x4*)(cu + DFF + c); gn = tb != 7 ? *(const f32x4*)(nx + c) : z; vn = tb != 7 ? *(const f32x4*)(nx + DFF + c) : z; }
        const f32x4 gg = *(const f32x4*)(cb + c) + *(const f32x4*)(cw + c) * gp + *(const f32x4*)(cw + DFF2 + c) * gc + *(const f32x4*)(cw + 2 * DFF2 + c) * gn;
        const f32x4 vv = *(const f32x4*)(cb + DFF + c) + *(const f32x4*)(cw + DFF + c) * vp + *(const f32x4*)(cw + DFF2 + DFF + c) * vc + *(const f32x4*)(cw + 2 * DFF2 + DFF + c) * vn;
        u32x2 w; w.x = cvt_pk_bf16(gelu_tanh(gg[0]) * vv[0], gelu_tanh(gg[1]) * vv[1]); w.y = cvt_pk_bf16(gelu_tanh(gg[2]) * vv[2], gelu_tanh(gg[3]) * vv[3]);
        *(u32x2*)(act + (size_t)(pm * 256 + (e ? 255 : 0)) * DFF + c) = w;
    }
}

__device__ __forceinline__ void final_phase_staged(const Frame& F) {
    const float* pt = (const float*)(F.ws + WS_POS); const float* mod = (const float*)(F.ws + WS_MOD);
    const bf16_t* Y = (const bf16_t*)(F.ws + WS_Y); const bf16_t* Y2 = (const bf16_t*)(F.ws + WS_Y2);
    const float* rss1 = (const float*)(F.ws + WS_RSS1); const float* rss2 = (const float*)(F.ws + WS_RSS2);
    const float* gpost1 = F.in[I_GMIXPOST]; const float* gpost2 = F.in[I_GFFNPOST];
    LAS float* L = (LAS float*)F.lds;
    for (int k0 = 0; k0 < NB; k0 += 2) {
        __syncthreads();
        for (int e = F.tid; e < 2 * 512; e += 512) { const int j = e >> 9, c4 = (e & 511) * 4; const float* mrow = mod + (size_t)(k0 + j) * 12288;
            *(LAS f32x4*)(L + (j * 2 + 0) * 2048 + c4) = *(const f32x4*)(mrow + 4096 + c4) * *(const f32x4*)(gpost1 + c4);
            *(LAS f32x4*)(L + (j * 2 + 1) * 2048 + c4) = *(const f32x4*)(mrow + 10240 + c4) * *(const f32x4*)(gpost2 + c4); }
        __syncthreads();
        const int t = F.bid * 8 + F.wave;
        f32x4 xv[2][8]; u32x2 y1[2][8], y2[2][8]; float s1[2], s2[2];
#pragma unroll
        for (int j = 0; j < 2; ++j) { const int r = t + (k0 + j) * 2048; s1[j] = F.lane < 32 ? rss1[(size_t)r * 32 + F.lane] : 0.f; s2[j] = F.lane < 32 ? rss2[(size_t)r * 32 + F.lane] : 0.f;
#pragma unroll
            for (int i = 0; i < 8; ++i) { const int col = (i * 64 + F.lane) * 4; xv[j][i] = __builtin_nontemporal_load((const f32x4*)(F.in[I_X] + (size_t)r * D + col)); y1[j][i] = __builtin_nontemporal_load((const u32x2*)(Y + (size_t)r * D + col)); y2[j][i] = __builtin_nontemporal_load((const u32x2*)(Y2 + (size_t)r * D + col)); } }
        f32x4 pp[8];
#pragma unroll
        for (int i = 0; i < 8; ++i) pp[i] = pos4(pt, t, (i * 64 + F.lane) * 4);
#pragma unroll
        for (int j = 0; j < 2; ++j) { const int r = t + (k0 + j) * 2048;
            const float rstd1 = rsqrtf(wave_sum(s1[j]) * (1.0f / D) + EPS), rstd2 = rsqrtf(wave_sum(s2[j]) * (1.0f / D) + EPS);
#pragma unroll
            for (int i = 0; i < 8; ++i) { const int col = (i * 64 + F.lane) * 4;
                const f32x4 a1 = (f32x4){bf_lo(y1[j][i].x), bf_hi(y1[j][i].x), bf_lo(y1[j][i].y), bf_hi(y1[j][i].y)}, a2 = (f32x4){bf_lo(y2[j][i].x), bf_hi(y2[j][i].x), bf_lo(y2[j][i].y), bf_hi(y2[j][i].y)};
                __builtin_nontemporal_store(xv[j][i] + pp[i] + *(const LAS f32x4*)(L + (j * 2 + 0) * 2048 + col) * (a1 * rstd1) + *(const LAS f32x4*)(L + (j * 2 + 1) * 2048 + col) * (a2 * rstd2), (f32x4*)(F.out + (size_t)r * D + col)); } }
    }
    __syncthreads();
}
__device__ __forceinline__ void final_phase(const Frame& F) {
    const float* pt = (const float*)(F.ws + WS_POS); const float* mod = (const float*)(F.ws + WS_MOD);
    const bf16_t* Y = (const bf16_t*)(F.ws + WS_Y); const bf16_t* Y2 = (const bf16_t*)(F.ws + WS_Y2);
    const float* rss1 = (const float*)(F.ws + WS_RSS1); const float* rss2 = (const float*)(F.ws + WS_RSS2);
    const float* gpost1 = F.in[I_GMIXPOST]; const float* gpost2 = F.in[I_GFFNPOST];
    for (int r = F.bid * 8 + F.wave; r < MLAT; r += F.G * 8) {
        const int b = r >> 11, t = r & 2047; const float* mrow = mod + (size_t)b * 12288;
        float s1 = F.lane < 32 ? rss1[(size_t)r * 32 + F.lane] : 0.f, s2 = F.lane < 32 ? rss2[(size_t)r * 32 + F.lane] : 0.f;
        s1 = wave_sum(s1); s2 = wave_sum(s2);
        const float rstd1 = rsqrtf(s1 * (1.0f / D) + EPS), rstd2 = rsqrtf(s2 * (1.0f / D) + EPS);
#pragma unroll
        for (int i = 0; i < 8; ++i) { const int col = (i * 64 + F.lane) * 4;
            const f32x4 xv = *(const f32x4*)(F.in[I_X] + (size_t)r * D + col) + pos4(pt, t, col);
            const f32x4 y1 = ld_bf4(Y + (size_t)r * D + col), y2 = ld_bf4(Y2 + (size_t)r * D + col);
            const f32x4 g1 = *(const f32x4*)(gpost1 + col), g2 = *(const f32x4*)(gpost2 + col), gt1 = *(const f32x4*)(mrow + 4096 + col), gt2 = *(const f32x4*)(mrow + 10240 + col);
            __builtin_nontemporal_store(xv + gt1 * (y1 * rstd1 * g1) + gt2 * (y2 * rstd2 * g2), (f32x4*)(F.out + (size_t)r * D + col)); }
    }
}

constexpr int N_PHASES = 13;
__global__ void __launch_bounds__(512, 2) hybrid_fwd(Args args) {
    extern __shared__ __attribute__((aligned(16))) unsigned char lds_raw[];
    Frame F; F.in = args.in; F.out = args.out; F.ws = args.ws; F.lds = (LAS unsigned char*)lds_raw;
    F.tid = threadIdx.x; F.lane = F.tid & 63; F.wave = __builtin_amdgcn_readfirstlane(F.tid >> 6); F.G = gridDim.x; F.bid = blockIdx.x;
    const int lo = args.ph_lo, hi = args.ph_hi;
#ifndef DUP_PHASE
#define DUP_PHASE -1
#endif
#define NREP(k) ((k) == DUP_PHASE ? 2 : 1)
#define IN(k) (lo <= (k) && (k) < hi)
#define SEAM(k) do { if (IN(k) && IN((k) + 1)) xcd_barrier(bar); } while (0)
    unsigned char* ws = args.ws;
    if (lo < 0) cg::this_grid().sync();
    if (F.tid < 16) ((LAS unsigned*)(F.lds + LDS_BAR))[F.tid] = 0u;
    __syncthreads();
    XcdBarrier bar; bar.bar = (unsigned*)ws; bar.x = 0; bar.st = (volatile LAS unsigned*)(F.lds + LDS_BAR);
    if (hi - lo > 1) bar = xcd_barrier_post((unsigned*)ws, (volatile LAS unsigned*)(F.lds + LDS_BAR));
    if (IN(0)) for (int rep_ = 0; rep_ < NREP(0); ++rep_) p0_prologue(F);
    SEAM(0);
    if (IN(1)) p1_norm(F, MLAT, MALL, 0, F.G);
    SEAM(1);
    if (IN(2)) {
        if (F.G >= 64) {
            if (F.bid < 32) { pg8::Gemm g{D, D, D, (size_t)128 * D * 2, (size_t)128 * D * 2};
                SchedWin S{(const bf16_t*)(ws + WS_H), (const bf16_t*)(ws + WS_WIN), 32, F.bid, 768, 800};
                EpiWin E{(bf16_t*)(ws + WS_UF)};
                pg8::gemm_phase(F.lds, g, S, E); }
            else if (((F.G - 32) & 7) == 0) p1_latent_staged(F, 32, F.G - 32); else p1_norm(F, 0, MLAT, 32, F.G - 32);
        } else { p1_norm(F, 0, MLAT, 0, F.G); }
    }
    SEAM(2);
    if (IN(3)) for (int rep_ = 0; rep_ < NREP(3); ++rep_) { pg8::Gemm g{D, D, D, (size_t)128 * D * 2, (size_t)128 * D * 2};
        SchedWin S{(const bf16_t*)(ws + WS_H), (const bf16_t*)(ws + WS_WIN), F.G, F.bid, 0, F.G >= 64 ? 768 : 800};
        EpiWin E{(bf16_t*)(ws + WS_UF)};
        pg8::gemm_phase(F.lds, g, S, E); }
    SEAM(3);
    if (IN(4)) { { pg8::Gemm g{256, 1024, 256, (size_t)128 * 256 * 2, (size_t)128 * 1024 * 2};
        SchedPQ S{(const bf16_t*)(ws + WS_WCS), (const bf16_t*)(ws + WS_UF), F.G, F.bid};
        EpiPQ E{(bf16_t*)(ws + WS_PQT)};
        pg8::gemm_phase(F.lds, g, S, E); }
        lru_phase(F); if (DUP_PHASE == 4) lru_phase(F); }
    SEAM(4);
    if (IN(5)) for (int rep_ = 0; rep_ < NREP(5); ++rep_) { pg8::Gemm g{2048, 2048, 2048, (size_t)128 * 2048 * 2, (size_t)128 * 2048 * 2};
        SchedDFT S{(const bf16_t*)(ws + WS_CTAB), (const bf16_t*)(ws + WS_STAB), (const bf16_t*)(ws + WS_PQT), F.G, F.bid};
        EpiDFT E{(bf16_t*)(ws + WS_CPSQ)};
        pg8::gemm_phase(F.lds, g, S, E);
        alt_phase(F); }
    SEAM(5);
    if (IN(6)) for (int rep_ = 0; rep_ < NREP(6); ++rep_) assemble_phase(F);
    SEAM(6);
    if (IN(7)) for (int rep_ = 0; rep_ < NREP(7); ++rep_) { pg8::Gemm g{D, D, D, (size_t)128 * D * 2, (size_t)128 * D * 2};
        SchedStd S{(const bf16_t*)(ws + WS_YA), (const bf16_t*)(ws + WS_WOUT), 64, 8, D, D, F.G, F.bid, OUTREP};
        EpiY E{(bf16_t*)(ws + WS_Y), (float*)(ws + WS_RSS1)};
        pg8::gemm_phase(F.lds, g, S, E); }
    SEAM(7);
    if (IN(8)) for (int rep_ = 0; rep_ < NREP(8); ++rep_) { if (F.G == 256) p7_norm2_staged(F); else p7_norm2(F); }
    SEAM(8);
    if (IN(9)) for (int rep_ = 0; rep_ < NREP(9); ++rep_) { pg8::Gemm g{D, D, D, (size_t)128 * D * 2, (size_t)DFF * D * 2};
        if (F.tid < 256) { ((LAS float*)(F.lds + LDS_EDGE))[F.tid] = 0.f; ((LAS float*)(F.lds + LDS_EDGE))[9 * 256 + F.tid] = 0.f; }
        __syncthreads();
        SchedUp S{(const bf16_t*)(ws + WS_H2), (const bf16_t*)(ws + WS_WUP), F.G, F.bid};
        EpiUpConv E{(bf16_t*)(ws + WS_ACT), (float*)(ws + WS_EDGE), F.in[I_CFW], F.in[I_CFB], F.lds};
        pg8::gemm_phase(F.lds, g, S, E); }
    if (IN(9) && IN(11)) xcd_barrier(bar);
    if (IN(11)) for (int rep_ = 0; rep_ < NREP(11); ++rep_) { pg8::Gemm g{DFF, DFF, DFF, (size_t)128 * DFF * 2, (size_t)128 * DFF * 2};
        SchedStd S{(const bf16_t*)(ws + WS_ACT), (const bf16_t*)(ws + WS_WDOWN), 64, 8, DFF, DFF, F.G, F.bid, DOWNREP};
        { pg8::Unit u; int last = -1;
          for (int i = 0; S.next(i, u); ++i) if (u.pm != last) { fixup_panel(F, u.pm); last = u.pm; }
          asm volatile("s_waitcnt vmcnt(0)" ::: "memory"); __syncthreads(); }
        EpiY E{(bf16_t*)(ws + WS_Y2), (float*)(ws + WS_RSS2)};
        pg8::gemm_phase(F.lds, g, S, E); }
    SEAM(11);
    if (IN(12)) for (int rep_ = 0; rep_ < NREP(12); ++rep_) { if (F.G == 256) final_phase_staged(F); else final_phase(F); }
#undef IN
#undef SEAM
}

extern "C" void kernel_launch(void* const* d_in, const int* in_sizes, int n_in, void* d_out, int out_size, void* d_ws, size_t ws_size, hipStream_t stream) {
    static int grid = 0;
    if (grid == 0) {
        if (n_in != 25 || out_size != MLAT * D || ws_size < WS_NEED) { fprintf(stderr, "kernel_launch: unexpected shapes n_in %d out %d ws %zu\n", n_in, out_size, ws_size); grid = -1; return; }
        int dev = 0, cus = 0, per_cu = 0;
        hipGetDevice(&dev); hipDeviceGetAttribute(&cus, hipDeviceAttributeMultiprocessorCount, dev);
        if (hipFuncSetAttribute((const void*)hybrid_fwd, hipFuncAttributeMaxDynamicSharedMemorySize, LDS_BYTES) != hipSuccess) { fprintf(stderr, "kernel_launch: hipFuncSetAttribute failed\n"); grid = -1; return; }
        if (hipOccupancyMaxActiveBlocksPerMultiprocessor(&per_cu, (const void*)hybrid_fwd, 512, LDS_BYTES) != hipSuccess || per_cu < 1) { fprintf(stderr, "kernel_launch: occupancy query failed (%d)\n", per_cu); (void)hipGetLastError(); per_cu = 1; }
        grid = cus * 1;
        if (grid % 8 != 0 || grid <= 0) grid = (grid / 8) * 8;
        fprintf(stderr, "kernel_launch: cus %d per_cu %d grid %d\n", cus, per_cu, grid);
    }
    if (grid <= 0) return;
    if (hipMemsetAsync(d_ws, 0, XCD_BAR_WORDS * 4, stream) != hipSuccess) { fprintf(stderr, "kernel_launch: memset of barrier words failed\n"); return; }
    Args a{};
    for (int i = 0; i < 25; ++i) a.in[i] = (const float*)d_in[i];
    a.out = (float*)d_out; a.ws = (unsigned char*)d_ws;
#if N_LAUNCH_MODE == 1
    a.ph_lo = 0; a.ph_hi = N_PHASES;
    void* kargs[] = {&a};
    hipError_t e = hipLaunchCooperativeKernel((const void*)hybrid_fwd, dim3(grid), dim3(512), kargs, LDS_BYTES, stream);
    if (e != hipSuccess) fprintf(stderr, "cooperative launch failed: %s (grid %d)\n", hipGetErrorString(e), grid);
#else
    for (int p = 0; p < N_PHASES; ++p) { a.ph_lo = p; a.ph_hi = p + 1; hipLaunchKernelGGL(hybrid_fwd, dim3(grid), dim3(512), LDS_BYTES, stream, a); }
#endif
}
```
